# Optimizing an MI355X kernel written in HIP

```python
import math
import jax, jax.numpy as jnp
from jax import lax
import numpy as np

D_MODEL = 1024
BATCH = 32
SEQ = 2048
DEPTH = 1

N_ATT_HEADS = 4
HEAD_DIM = 64
V_HEAD_DIM = 2 * HEAD_DIM
QK_WIDTH = N_ATT_HEADS * 2 * HEAD_DIM
ATT_WIDTH = N_ATT_HEADS * V_HEAD_DIM
POOL_WIDTH = D_MODEL // 2
POOL_WINDOWS = (2, 4, 8, 16)
N_POOL_GROUPS = len(POOL_WINDOWS)
POOL_GROUP_DIM = POOL_WIDTH // N_POOL_GROUPS
N_BRANCHES = 2
IN_WIDTH = 2 * QK_WIDTH + ATT_WIDTH + POOL_WIDTH + N_BRANCHES * D_MODEL
D_FF = 2816
ROPE_THETA = 10000.0
Q_BLOCK = 128
LN_EPS = 1e-5
RMS_EPS = 1e-5
DEEPNORM_ALPHA = (2.0 * DEPTH) ** 0.25
DEEPNORM_BETA = (8.0 * DEPTH) ** -0.25

kernel_name = "hybrid_diffattn_multiscale_pool_macaron_deepnorm"


def lambda_init_for(layer_idx):
    return 0.8 - 0.6 * math.exp(-0.3 * layer_idx)


def layer_norm(x, g, b):
    xf = x.astype(jnp.float32)
    mu = jnp.mean(xf, axis=-1, keepdims=True)
    var = jnp.mean(jnp.square(xf - mu), axis=-1, keepdims=True)
    return ((xf - mu) * lax.rsqrt(var + LN_EPS)).astype(x.dtype) * g + b


def swiglu(x, w_gate, w_up, w_down):
    return (jax.nn.silu(x @ w_gate) * (x @ w_up)) @ w_down


def rope_tables(seq, dtype):
    inv = 1.0 / (ROPE_THETA ** (jnp.arange(0, HEAD_DIM, 2, dtype=jnp.float32) / HEAD_DIM))
    ang = jnp.arange(seq, dtype=jnp.float32)[:, None] * inv[None, :]
    return jnp.cos(ang).astype(dtype), jnp.sin(ang).astype(dtype)


def apply_rope(t, cos, sin):
    t1, t2 = jnp.split(t, 2, axis=-1)
    c = cos[None, :, None, None, :]
    s = sin[None, :, None, None, :]
    return jnp.concatenate([t1 * c - t2 * s, t1 * s + t2 * c], axis=-1)


def diff_attention(q, k, v, lam):
    B, S, H, _, Dh = q.shape
    nb = S // Q_BLOCK
    scale = Dh ** -0.5
    qb = q.reshape(B, nb, Q_BLOCK, H, 2, Dh).transpose(1, 0, 2, 3, 4, 5)

    def block(q_blk):
        s = jnp.einsum('bqhmd,bkhmd->bhmqk', q_blk, k,
                       preferred_element_type=jnp.float32) * scale
        p = jax.nn.softmax(s, axis=-1)
        p_diff = p[:, :, 0] - lam * p[:, :, 1]
        return jnp.einsum('bhqk,bkhe->bqhe', p_diff.astype(v.dtype), v)

    o = lax.map(block, qb)
    return o.transpose(1, 0, 2, 3, 4).reshape(B, S, H, v.shape[-1])


def multiscale_pool(u, pool_w, pool_scale):
    B, S, _ = u.shape
    ug = u.reshape(B, S, N_POOL_GROUPS, POOL_GROUP_DIM)
    cs = jnp.cumsum(ug.astype(jnp.float32), axis=1)
    cs = jnp.concatenate([jnp.zeros_like(cs[:, :1]), cs], axis=1)
    pos = jnp.arange(S)
    means = []
    for g, w in enumerate(POOL_WINDOWS):
        lo = jnp.clip(pos - w // 2, 0, S)
        hi = jnp.clip(pos + (w - w // 2), 0, S)
        cnt = (hi - lo).astype(jnp.float32)[None, :, None]
        means.append((cs[:, hi, g] - cs[:, lo, g]) / cnt)
    pooled = jnp.stack(means, axis=2).astype(u.dtype) - ug
    mixed = jnp.einsum('bsgc,gcd->bsgd', pooled, pool_w)
    return mixed.reshape(B, S, POOL_WIDTH) * pool_scale


def hybrid_mixer(x, w_in, lambda_q1, lambda_k1, lambda_q2, lambda_k2, attn_subln_g,
                 pool_w, pool_scale, w_branch_att, w_branch_pool, w_out,
                 lambda_init, cos, sin):
    B, S, _ = x.shape
    h = x @ w_in
    q, k, v, u, gate_logits = jnp.split(
        h, [QK_WIDTH, 2 * QK_WIDTH, 2 * QK_WIDTH + ATT_WIDTH,
            2 * QK_WIDTH + ATT_WIDTH + POOL_WIDTH], axis=-1)

    q = apply_rope(q.reshape(B, S, N_ATT_HEADS, 2, HEAD_DIM), cos, sin)
    k = apply_rope(k.reshape(B, S, N_ATT_HEADS, 2, HEAD_DIM), cos, sin)
    v = v.reshape(B, S, N_ATT_HEADS, V_HEAD_DIM)
    lam = (jnp.exp(jnp.sum(lambda_q1.astype(jnp.float32) * lambda_k1.astype(jnp.float32)))
           - jnp.exp(jnp.sum(lambda_q2.astype(jnp.float32) * lambda_k2.astype(jnp.float32)))
           + lambda_init)
    o = diff_attention(q, k, v, lam).astype(jnp.float32)
    o = o * lax.rsqrt(jnp.mean(jnp.square(o), axis=-1, keepdims=True) + RMS_EPS)
    o = (o * (1.0 - lambda_init)).astype(x.dtype) * attn_subln_g
    y_att = o.reshape(B, S, ATT_WIDTH)

    y_pool = multiscale_pool(u, pool_w, pool_scale)

    g_att, g_pool = jnp.split(jax.nn.sigmoid(gate_logits), N_BRANCHES, axis=-1)
    merged = g_att * (y_att @ w_branch_att) + g_pool * (y_pool @ w_branch_pool)
    return merged @ w_out


def setup_inputs(seed: int = 0) -> dict:
    key = jax.random.key(seed)
    ks = jax.random.split(key, 24)
    f32 = jnp.float32
    L = DEPTH

    def dense(k, shape, fan_in, scale=1.0):
        return jax.random.normal(k, shape, f32) * (fan_in ** -0.5) * scale

    def gain(k, shape):
        return 1.0 + 0.05 * jax.random.normal(k, shape, f32)

    def bias(k, shape):
        return 0.02 * jax.random.normal(k, shape, f32)

    return {
        "x": jax.random.normal(ks[0], (BATCH, SEQ, D_MODEL), f32),
        "ln1_g": gain(ks[1], (L, D_MODEL)),
        "ln1_b": bias(ks[2], (L, D_MODEL)),
        "ffn1_w_gate": dense(ks[3], (L, D_MODEL, D_FF), D_MODEL),
        "ffn1_w_up": dense(ks[4], (L, D_MODEL, D_FF), D_MODEL),
        "ffn1_w_down": dense(ks[5], (L, D_FF, D_MODEL), D_FF, DEEPNORM_BETA),
        "w_in": dense(ks[6], (L, D_MODEL, IN_WIDTH), D_MODEL),
        "lambda_q1": 0.1 * jax.random.normal(ks[7], (L, HEAD_DIM), f32),
        "lambda_k1": 0.1 * jax.random.normal(ks[8], (L, HEAD_DIM), f32),
        "lambda_q2": 0.1 * jax.random.normal(ks[9], (L, HEAD_DIM), f32),
        "lambda_k2": 0.1 * jax.random.normal(ks[10], (L, HEAD_DIM), f32),
        "attn_subln_g": gain(ks[11], (L, V_HEAD_DIM)),
        "pool_w": dense(ks[12], (L, N_POOL_GROUPS, POOL_GROUP_DIM, POOL_GROUP_DIM), POOL_GROUP_DIM),
        "pool_scale": gain(ks[13], (L, POOL_WIDTH)),
        "w_branch_att": dense(ks[14], (L, ATT_WIDTH, D_MODEL), ATT_WIDTH),
        "w_branch_pool": dense(ks[15], (L, POOL_WIDTH, D_MODEL), POOL_WIDTH),
        "w_out": dense(ks[16], (L, D_MODEL, D_MODEL), D_MODEL, DEEPNORM_BETA),
        "ln2_g": gain(ks[17], (L, D_MODEL)),
        "ln2_b": bias(ks[18], (L, D_MODEL)),
        "ffn2_w_gate": dense(ks[19], (L, D_MODEL, D_FF), D_MODEL),
        "ffn2_w_up": dense(ks[20], (L, D_MODEL, D_FF), D_MODEL),
        "ffn2_w_down": dense(ks[21], (L, D_FF, D_MODEL), D_FF, DEEPNORM_BETA),
        "ln3_g": gain(ks[22], (L, D_MODEL)),
        "ln3_b": bias(ks[23], (L, D_MODEL)),
    }


def reference(x, ln1_g, ln1_b, ffn1_w_gate, ffn1_w_up, ffn1_w_down, w_in,
              lambda_q1, lambda_k1, lambda_q2, lambda_k2, attn_subln_g,
              pool_w, pool_scale, w_branch_att, w_branch_pool, w_out,
              ln2_g, ln2_b, ffn2_w_gate, ffn2_w_up, ffn2_w_down, ln3_g, ln3_b):
    cos, sin = rope_tables(x.shape[1], x.dtype)
    for l in range(DEPTH):
        x = layer_norm(DEEPNORM_ALPHA * x
                       + 0.5 * swiglu(x, ffn1_w_gate[l], ffn1_w_up[l], ffn1_w_down[l]),
                       ln1_g[l], ln1_b[l])
        mix = hybrid_mixer(x, w_in[l], lambda_q1[l], lambda_k1[l], lambda_q2[l], lambda_k2[l],
                           attn_subln_g[l], pool_w[l], pool_scale[l], w_branch_att[l],
                           w_branch_pool[l], w_out[l], lambda_init_for(l), cos, sin)
        x = layer_norm(DEEPNORM_ALPHA * x + mix, ln2_g[l], ln2_b[l])
        x = layer_norm(DEEPNORM_ALPHA * x
                       + 0.5 * swiglu(x, ffn2_w_gate[l], ffn2_w_up[l], ffn2_w_down[l]),
                       ln3_g[l], ln3_b[l])
    return x
```

```cpp
#include <hip/hip_runtime.h>
#include <hip/hip_cooperative_groups.h>
#include <cstdio>
#include <cstdint>
namespace cg = cooperative_groups;
namespace pg8 {
#define PG8_LAS __attribute__((address_space(3)))
typedef unsigned short bf16_t;
typedef short bf16x8 __attribute__((ext_vector_type(8)));
typedef float f32x4 __attribute__((ext_vector_type(4)));
typedef unsigned u32x4 __attribute__((ext_vector_type(4)));
constexpr int BM = 256, BK = 64, HALF = 128, HTB = HALF * BK * 2  , STAGE_BYTES = 8 * HTB, NXCD = 8, WGM = 4;

__host__ __device__ __forceinline__ int lds_byte(int r, int c) { const int st = (r >> 4) * 2 + (c >> 5), rr = r & 15, cc = c & 31, ob = rr * 64 + cc * 2; return st * 1024 + (ob ^ (((ob >> 9) & 1) << 5)); }
__host__ __device__ __forceinline__ void stage_rc(int b, int& R, int& C) { const int st = b / 1024, sb = b % 1024, swz = sb ^ (((sb >> 9) & 1) << 5); R = (st >> 1) * 16 + swz / 64; C = (st & 1) * 32 + (swz % 64) / 2; }
__host__ __device__ __forceinline__ int perm32(int rho) { const int n = rho >> 4, i = rho & 15; return 8 * (i >> 2) + 4 * n + (i & 3); }

struct Unit { int pm, pn; };
struct Gemm { const bf16_t* A; const bf16_t* Bt; int M, N, K; };

struct StaticOrder {
    int nM, nN, nwg, G, c;
    __host__ __device__ void init(int M, int N, int G_, int c_) { nM = M / BM; nN = N / BM; nwg = nM * nN; G = G_; c = c_; }
    __host__ __device__ bool next(int i, Unit& u) const {
        const long L = (long)i * G + c; if (L >= nwg) return false;
        int wgid = (int)L; { const int q = nwg / NXCD, r = nwg % NXCD, xcd = wgid % NXCD, off = wgid / NXCD; wgid = (xcd < r ? xcd * (q + 1) : r * (q + 1) + (xcd - r) * q) + off; }
        const int nig = WGM * nN, gid = wgid / nig, fm = gid * WGM, gsz = (nM - fm) < WGM ? (nM - fm) : WGM;
        u.pm = fm + ((wgid % nig) % gsz); u.pn = (wgid % nig) / gsz; return true;
    }
    __device__ __forceinline__ void a_ready(const Unit&) const {}
    __device__ __forceinline__ void done(const Unit&) const {}
};

typedef float cvt_f32x2_t __attribute__((ext_vector_type(2))); typedef __bf16 cvt_bf16x2_t __attribute__((ext_vector_type(2)));
__device__ __forceinline__ unsigned cvt_pk_bf16(float lo, float hi) { cvt_f32x2_t v = {lo, hi}; cvt_bf16x2_t b = __builtin_convertvector(v, cvt_bf16x2_t); return __builtin_bit_cast(unsigned, b); }
typedef float f32x2 __attribute__((ext_vector_type(2)));
struct PanelOrder {
    int pm, npn;
    __device__ __forceinline__ bool next(int i, Unit& u) const { if (i >= npn) return false; int p = pm, q = i; asm volatile("" : "+s"(p), "+s"(q));
        u.pm = p; u.pn = q; return true; }
    __device__ __forceinline__ void a_ready(const Unit&) const {}
    __device__ __forceinline__ void done(const Unit&) const {}
};
__device__ __forceinline__ float fast_sigmoid(float v) { return __builtin_amdgcn_rcpf(1.0f + __builtin_amdgcn_exp2f(v * -1.4426950408889634f)); }
__device__ __forceinline__ u32x4 pack8(const f32x4 a, const f32x4 b) { u32x4 w; w.x = cvt_pk_bf16(a[0], a[1]); w.y = cvt_pk_bf16(a[2], a[3]); w.z = cvt_pk_bf16(b[0], b[1]); w.w = cvt_pk_bf16(b[2], b[3]); return w; }
__device__ __forceinline__ void unpack8(const u32x4 w, f32x4& a, f32x4& b) {
    a[0] = __uint_as_float(w.x << 16); a[1] = __uint_as_float(w.x & 0xffff0000u); a[2] = __uint_as_float(w.y << 16); a[3] = __uint_as_float(w.y & 0xffff0000u);
    b[0] = __uint_as_float(w.z << 16); b[1] = __uint_as_float(w.z & 0xffff0000u); b[2] = __uint_as_float(w.w << 16); b[3] = __uint_as_float(w.w & 0xffff0000u);
}
struct EpiPlain {
    static constexpr bool PERM = true, AFTER_DRAIN = false, MIDHOOK = false;
    bf16_t* O; size_t ldc;
    __device__ __forceinline__ void operator()(const f32x4 (&acc)[2][2][4][2], const Unit& u, int wr, int wc, int fr, int fq) const {
        const int row0 = u.pm * BM + wr * 64 + fr, col0 = u.pn * BM + wc * 32 + 8 * fq;
#pragma unroll
        for (int ai = 0; ai < 2; ++ai)
#pragma unroll
            for (int m = 0; m < 4; ++m) { bf16_t* rowp = O + (size_t)(row0 + ai * HALF + m * 16) * ldc + col0;
#pragma unroll
                for (int bj = 0; bj < 2; ++bj) __builtin_nontemporal_store(pack8(acc[ai][bj][m][0], acc[ai][bj][m][1]), (u32x4*)(rowp + bj * HALF)); }
    }
};
struct EpiSwiglu {
    static constexpr bool PERM = true, AFTER_DRAIN = false, MIDHOOK = false;
    bf16_t* H; int ldh;
    __device__ __forceinline__ void operator()(const f32x4 (&acc)[2][2][4][2], const Unit& u, int wr, int wc, int fr, int fq) const {
        const int row0 = u.pm * BM + wr * 64 + fr, col0 = u.pn * HALF + wc * 32 + 8 * fq;
#pragma unroll
        for (int ai = 0; ai < 2; ++ai)
#pragma unroll
            for (int m = 0; m < 4; ++m) { f32x4 h[2];
#pragma unroll
                for (int n = 0; n < 2; ++n) { const f32x4 g = acc[ai][0][m][n], up = acc[ai][1][m][n];
#pragma unroll
                    for (int e = 0; e < 4; ++e) h[n][e] = g[e] * fast_sigmoid(g[e]) * up[e]; }
                __builtin_nontemporal_store(pack8(h[0], h[1]), (u32x4*)(H + (size_t)(row0 + ai * HALF + m * 16) * ldh + col0)); }
    }
};
struct EpiWin {
    static constexpr bool PERM = true, AFTER_DRAIN = false, MIDHOOK = false;
    bf16_t *Q, *K, *U, *G; const float* cosT; const float* sinT; float qscale;
    __device__ __forceinline__ void operator()(const f32x4 (&acc)[2][2][4][2], const Unit& u, int wr, int wc, int fr, int fq) const {
        const int row0 = u.pm * BM + wr * 64 + fr; const int pn = u.pn;
        if (pn < 4) {
            bf16_t* base = (pn < 2) ? Q : K; const float sc = (pn < 2) ? qscale : 1.0f; const int ct = (pn & 1) * BM + wc * 32 + 8 * fq;
#pragma unroll
            for (int ai = 0; ai < 2; ++ai)
#pragma unroll
                for (int mh = 0; mh < 2; ++mh) {
                    f32x4 cs[2][2], sn[2][2];
#pragma unroll
                    for (int mm = 0; mm < 2; ++mm) { const int pos = (row0 + ai * HALF + (mh * 2 + mm) * 16) & 2047;
#pragma unroll
                        for (int n = 0; n < 2; ++n) { cs[mm][n] = *(const f32x4*)(cosT + pos * 32 + 8 * fq + 4 * n); sn[mm][n] = *(const f32x4*)(sinT + pos * 32 + 8 * fq + 4 * n); } }
#pragma unroll
                    for (int mm = 0; mm < 2; ++mm) { const int m = mh * 2 + mm; const int row = row0 + ai * HALF + m * 16;
                        f32x4 o1[2], o2[2];
#pragma unroll
                        for (int n = 0; n < 2; ++n) { const f32x4 x1 = acc[ai][0][m][n], x2 = acc[ai][1][m][n];
                            o1[n] = (x1 * cs[mm][n] - x2 * sn[mm][n]) * sc; o2[n] = (x1 * sn[mm][n] + x2 * cs[mm][n]) * sc; }
                        bf16_t* rowp = base + (size_t)row * 512 + ct;
                        __builtin_nontemporal_store(pack8(o1[0], o1[1]), (u32x4*)(rowp)); __builtin_nontemporal_store(pack8(o2[0], o2[1]), (u32x4*)(rowp + HALF)); }
                    asm volatile("" ::: "memory"); }
        } else if (pn < 6) {
            const int col0 = (pn - 4) * BM + wc * 32 + 8 * fq;
#pragma unroll
            for (int ai = 0; ai < 2; ++ai)
#pragma unroll
                for (int m = 0; m < 4; ++m) { bf16_t* rowp = U + (size_t)(row0 + ai * HALF + m * 16) * 512 + col0;
#pragma unroll
                    for (int bj = 0; bj < 2; ++bj) __builtin_nontemporal_store(pack8(acc[ai][bj][m][0], acc[ai][bj][m][1]), (u32x4*)(rowp + bj * HALF)); }
        } else {
            const int col0 = (pn - 6) * BM + wc * 32 + 8 * fq;
#pragma unroll
            for (int ai = 0; ai < 2; ++ai)
#pragma unroll
                for (int m = 0; m < 4; ++m) { bf16_t* rowp = G + (size_t)(row0 + ai * HALF + m * 16) * 2048 + col0;
                    f32x4 rt[2], gp[2];
#pragma unroll
                    for (int n = 0; n < 2; ++n)
#pragma unroll
                        for (int e = 0; e < 4; ++e) { const float ea = 1.0f + __builtin_amdgcn_exp2f(acc[ai][0][m][n][e] * -1.4426950408889634f), ep = fminf(1.0f + __builtin_amdgcn_exp2f(acc[ai][1][m][n][e] * -1.4426950408889634f), 1e30f);
                            gp[n][e] = __builtin_amdgcn_rcpf(ep); rt[n][e] = ep * __builtin_amdgcn_rcpf(ea); }
                    __builtin_nontemporal_store(pack8(rt[0], rt[1]), (u32x4*)(rowp)); __builtin_nontemporal_store(pack8(gp[0], gp[1]), (u32x4*)(rowp + HALF)); }
        }
    }
};
struct EpiResid {
    static constexpr bool PERM = true, AFTER_DRAIN = false, MIDHOOK = false;
    const float* X; bf16_t* Y; float alpha, sc;
    __device__ __forceinline__ void operator()(const f32x4 (&acc)[2][2][4][2], const Unit& u, int wr, int wc, int fr, int fq) const {
        const int row0 = u.pm * BM + wr * 64 + fr, col0 = u.pn * BM + wc * 32 + 8 * fq;
#pragma unroll
        for (int ai = 0; ai < 2; ++ai)
#pragma unroll
            for (int mh = 0; mh < 2; ++mh) {
                f32x4 xr[2][2][2];
#pragma unroll
                for (int mm = 0; mm < 2; ++mm)
#pragma unroll
                    for (int bj = 0; bj < 2; ++bj)
#pragma unroll
                        for (int n = 0; n < 2; ++n) xr[mm][bj][n] = *(const f32x4*)(X + (size_t)(row0 + ai * HALF + (mh * 2 + mm) * 16) * 1024 + col0 + bj * HALF + 4 * n);
#pragma unroll
                for (int mm = 0; mm < 2; ++mm) { const int m = mh * 2 + mm; const size_t off = (size_t)(row0 + ai * HALF + m * 16) * 1024 + col0;
#pragma unroll
                    for (int bj = 0; bj < 2; ++bj) __builtin_nontemporal_store(pack8(xr[mm][bj][0] * alpha + acc[ai][bj][m][0] * sc, xr[mm][bj][1] * alpha + acc[ai][bj][m][1] * sc), (u32x4*)(Y + off + bj * HALF)); }
                asm volatile("" ::: "memory"); }
    }
};
struct EpiGate1 {
    static constexpr bool PERM = true, AFTER_DRAIN = false, MIDHOOK = false;
    const bf16_t* G; float* T;
    __device__ __forceinline__ void operator()(const f32x4 (&acc)[2][2][4][2], const Unit& u, int wr, int wc, int fr, int fq) const {
        const int row0 = u.pm * BM + wr * 64 + fr, col0 = u.pn * BM + wc * 32 + 8 * fq;
#pragma unroll
        for (int ai = 0; ai < 2; ++ai)
#pragma unroll
            for (int m = 0; m < 4; ++m) { const size_t row = (size_t)(row0 + ai * HALF + m * 16);
#pragma unroll
                for (int bj = 0; bj < 2; ++bj) { f32x4 ga, gb; unpack8(*(const u32x4*)(G + row * 2048 + col0 + bj * HALF), ga, gb);
                    float* tp = T + row * 1024 + col0 + bj * HALF;
                    *(f32x4*)(tp) = ga * acc[ai][bj][m][0]; *(f32x4*)(tp + 4) = gb * acc[ai][bj][m][1]; }
                asm volatile("" ::: "memory"); }
    }
};
struct EpiGate2 {
    static constexpr bool PERM = true, AFTER_DRAIN = false, MIDHOOK = false;
    const bf16_t* G; const float* T; bf16_t* Mg;
    __device__ __forceinline__ void operator()(const f32x4 (&acc)[2][2][4][2], const Unit& u, int wr, int wc, int fr, int fq) const {
        const int row0 = u.pm * BM + wr * 64 + fr, col0 = u.pn * BM + wc * 32 + 8 * fq;
#pragma unroll
        for (int ai = 0; ai < 2; ++ai)
#pragma unroll
            for (int m = 0; m < 4; ++m) { const size_t row = (size_t)(row0 + ai * HALF + m * 16);
#pragma unroll
                for (int bj = 0; bj < 2; ++bj) { f32x4 ga, gb; unpack8(*(const u32x4*)(G + row * 2048 + 1024 + col0 + bj * HALF), ga, gb);
                    const float* tp = T + row * 1024 + col0 + bj * HALF;
                    const f32x4 t0 = *(const f32x4*)(tp), t1 = *(const f32x4*)(tp + 4);
                    __builtin_nontemporal_store(pack8(t0 + ga * acc[ai][bj][m][0], t1 + gb * acc[ai][bj][m][1]), (u32x4*)(Mg + row * 1024 + col0 + bj * HALF)); }
                asm volatile("" ::: "memory"); }
    }
};
struct EpiVT {
    static constexpr bool PERM = true, AFTER_DRAIN = false, MIDHOOK = false;
    bf16_t* O;
    __device__ __forceinline__ void operator()(const f32x4 (&acc)[2][2][4][2], const Unit& u, int wr, int wc, int fr, int fq) const {
        const int row0 = u.pm * BM + wr * 64 + fr, col0 = u.pn * BM + wc * 32 + 8 * fq;
#pragma unroll
        for (int ai = 0; ai < 2; ++ai)
#pragma unroll
            for (int m = 0; m < 4; ++m) { const int vcol = row0 + ai * HALF + m * 16, h = vcol >> 7, e = vcol & 127;
#pragma unroll
                for (int bj = 0; bj < 2; ++bj) { const int tok = col0 + bj * HALF, b = tok >> 11, sq = tok & 2047, kt = sq >> 6, key = sq & 63;
                    __builtin_nontemporal_store(pack8(acc[ai][bj][m][0], acc[ai][bj][m][1]), (u32x4*)(O + ((size_t)(((b * 4 + h) * 32 + kt) * 128 + e)) * 64 + key)); } }
    }
};
struct EpiGateMid {
    static constexpr bool PERM = true, AFTER_DRAIN = false, MIDHOOK = true;
    const bf16_t* G; bf16_t* Mg;
    __device__ __forceinline__ void mid(f32x4 (&acc)[2][2][4][2], const Unit& u, int wr, int wc, int fr, int fq) const {
        int row0 = u.pm * BM + wr * 64 + fr, gc0 = u.pn * 512 + wc * 32 + 8 * fq;
        asm volatile("" : "+v"(row0), "+v"(gc0));
#pragma unroll
        for (int ai = 0; ai < 2; ++ai) {
            u32x4 rt[4][2];
#pragma unroll
            for (int m = 0; m < 4; ++m)
#pragma unroll
                for (int bj = 0; bj < 2; ++bj) rt[m][bj] = *(const u32x4*)(G + (size_t)(row0 + ai * HALF + m * 16) * 2048 + gc0 + bj * 256);
#pragma unroll
            for (int m = 0; m < 4; ++m)
#pragma unroll
                for (int bj = 0; bj < 2; ++bj) { f32x4 r0, r1; unpack8(rt[m][bj], r0, r1); acc[ai][bj][m][0] *= r0; acc[ai][bj][m][1] *= r1; }
            asm volatile("" ::: "memory"); }
    }
    __device__ __forceinline__ void operator()(const f32x4 (&acc)[2][2][4][2], const Unit& u, int wr, int wc, int fr, int fq) const {
        const int row0 = u.pm * BM + wr * 64 + fr, col0 = u.pn * BM + wc * 32 + 8 * fq, gc0 = u.pn * 512 + wc * 32 + 8 * fq + 128;
#pragma unroll
        for (int ai = 0; ai < 2; ++ai) {
            u32x4 gp[4][2];
#pragma unroll
            for (int m = 0; m < 4; ++m)
#pragma unroll
                for (int bj = 0; bj < 2; ++bj) gp[m][bj] = *(const u32x4*)(G + (size_t)(row0 + ai * HALF + m * 16) * 2048 + gc0 + bj * 256);
#pragma unroll
            for (int m = 0; m < 4; ++m) { const size_t row = (size_t)(row0 + ai * HALF + m * 16);
#pragma unroll
                for (int bj = 0; bj < 2; ++bj) { f32x4 p0, p1; unpack8(gp[m][bj], p0, p1);
                    __builtin_nontemporal_store(pack8(acc[ai][bj][m][0] * p0, acc[ai][bj][m][1] * p1), (u32x4*)(Mg + row * 1024 + col0 + bj * HALF)); } }
            asm volatile("" ::: "memory"); }
    }
};
struct EpiResidB {
    static constexpr bool PERM = true, AFTER_DRAIN = false, MIDHOOK = false;
    const bf16_t* X; bf16_t* Y; float alpha, sc;
    __device__ __forceinline__ void operator()(const f32x4 (&acc)[2][2][4][2], const Unit& u, int wr, int wc, int fr, int fq) const {
        const int row0 = u.pm * BM + wr * 64 + fr, col0 = u.pn * BM + wc * 32 + 8 * fq;
#pragma unroll
        for (int ai = 0; ai < 2; ++ai) {
            u32x4 xr[4][2];
#pragma unroll
            for (int m = 0; m < 4; ++m)
#pragma unroll
                for (int bj = 0; bj < 2; ++bj) xr[m][bj] = *(const u32x4*)(X + (size_t)(row0 + ai * HALF + m * 16) * 1024 + col0 + bj * HALF);
#pragma unroll
            for (int m = 0; m < 4; ++m) { const size_t off = (size_t)(row0 + ai * HALF + m * 16) * 1024 + col0;
#pragma unroll
                for (int bj = 0; bj < 2; ++bj) { f32x4 x0, x1; unpack8(xr[m][bj], x0, x1);
                    __builtin_nontemporal_store(pack8(x0 * alpha + acc[ai][bj][m][0] * sc, x1 * alpha + acc[ai][bj][m][1] * sc), (u32x4*)(Y + off + bj * HALF)); } }
            asm volatile("" ::: "memory"); }
    }
};
template <class Epi, class Sched, bool ALIGN_EPI = false, bool SP2 = false>
__device__ __forceinline__ void gemm_phase(PG8_LAS unsigned char* lds, const Gemm g, const Sched& S, const Epi& E) {
    int tid_ = threadIdx.x; asm volatile("" : "+v"(tid_));
    const int tid = tid_, wid = __builtin_amdgcn_readfirstlane(tid >> 6), lane = tid & 63, wr = wid >> 2, wc = wid & 3, fr = lane & 15, fq = lane >> 4;
    const int K = g.K, nt = K / BK;
    unsigned voffA[2], voffB[2];
#pragma unroll
    for (int i = 0; i < 2; ++i) { int R, C; stage_rc(tid * 16 + i * 8192, R, C); const int Rb = Epi::PERM ? ((R & ~31) + perm32(R & 31)) : R;
        voffA[i] = (unsigned)(R * K + C) * 2u; voffB[i] = (unsigned)(Rb * K + C) * 2u; }
    const size_t kstep = (size_t)(BK * 2);
    const size_t hstep = (size_t)HALF * K * 2;
    const size_t tstep = 2 * hstep;
    const unsigned ldsw = (unsigned)wid * 1024u;
    const int aoff = lds_byte(wr * 64 + fr, fq * 8), boff = lds_byte(wc * 32 + fr, fq * 8);
#define PG8_SA(b, h) (((b) * 2 + (h)) * HTB)
#define PG8_SB(b, h) ((4 + (b) * 2 + (h)) * HTB)
#define PG8_STAGE(bufoff, gbase, voff) do { _Pragma("unroll") for (int _i = 0; _i < 2; ++_i) \
        __builtin_amdgcn_global_load_lds((const unsigned*)((const char*)(gbase) + (voff)[_i]), (PG8_LAS unsigned*)(lds + (bufoff) + ldsw + _i * 8192), 16, 0, 0); } while (0)
#define PG8_LDA(dst, b, h) do { _Pragma("unroll") for (int m = 0; m < 4; ++m) _Pragma("unroll") for (int k = 0; k < 2; ++k) dst[m][k] = *(const PG8_LAS bf16x8*)(lds + PG8_SA(b, h) + aoff + m * 2048 + k * 1024); } while (0)
#define PG8_LDB(dst, b, h) do { _Pragma("unroll") for (int n = 0; n < 2; ++n) _Pragma("unroll") for (int k = 0; k < 2; ++k) dst[n][k] = *(const PG8_LAS bf16x8*)(lds + PG8_SB(b, h) + boff + n * 2048 + k * 1024); } while (0)
#define PG8_MMA(ai, bj, At, Bt) do { __builtin_amdgcn_s_setprio(1); _Pragma("unroll") for (int m = 0; m < 4; ++m) _Pragma("unroll") for (int n = 0; n < 2; ++n) _Pragma("unroll") for (int k = 0; k < 2; ++k) \
        acc[ai][bj][m][n] = __builtin_amdgcn_mfma_f32_16x16x32_bf16(Bt[n][k], At[m][k], acc[ai][bj][m][n], 0, 0, 0); __builtin_amdgcn_s_setprio(0); } while (0)
#define PG8_WAIT_V(n) asm volatile("s_waitcnt vmcnt(" #n ")" ::: "memory")
#define PG8_WAIT_L(n) asm volatile("s_waitcnt lgkmcnt(" #n ")" ::: "memory")
#define PG8_BAR __builtin_amdgcn_s_barrier()
#define PG8_SCHED __builtin_amdgcn_sched_barrier(0)
    Unit cur, nxt; int ui = 0;
    if (!S.next(0, cur)) return;
    f32x4 acc[2][2][4][2];
#pragma unroll
    for (int a = 0; a < 2; ++a)
#pragma unroll
        for (int b = 0; b < 2; ++b)
#pragma unroll
            for (int m = 0; m < 4; ++m)
#pragma unroll
                for (int n = 0; n < 2; ++n) acc[a][b][m][n] = (f32x4){0.f, 0.f, 0.f, 0.f};
    bf16x8 At[4][2], B0[2][2], B1[2][2];
    const char* cA = (const char*)g.A + (size_t)cur.pm * tstep; const char* cB = (const char*)g.Bt + (size_t)cur.pn * tstep;
    S.a_ready(cur);
    if constexpr (SP2) {
        PG8_STAGE(PG8_SB(0, 0), cB, voffB); PG8_STAGE(PG8_SB(0, 1), cB + hstep, voffB); PG8_STAGE(PG8_SA(0, 0), cA, voffA); PG8_STAGE(PG8_SA(0, 1), cA + hstep, voffA);
        if (wr == 1) PG8_BAR;
        PG8_WAIT_V(2); PG8_BAR;
        PG8_STAGE(PG8_SB(1, 0), cB + kstep, voffB); PG8_STAGE(PG8_SA(1, 0), cA + kstep, voffA); PG8_STAGE(PG8_SB(1, 1), cB + hstep + kstep, voffB);
        PG8_WAIT_V(6); PG8_BAR;
    } else {
        PG8_STAGE(PG8_SB(0, 0), cB, voffB); PG8_STAGE(PG8_SA(0, 0), cA, voffA); PG8_STAGE(PG8_SB(0, 1), cB + hstep, voffB); PG8_STAGE(PG8_SA(0, 1), cA + hstep, voffA);
        if (wr == 1) PG8_BAR;
        PG8_WAIT_V(4); PG8_BAR;
        PG8_STAGE(PG8_SB(1, 0), cB + kstep, voffB); PG8_STAGE(PG8_SA(1, 0), cA + kstep, voffA); PG8_STAGE(PG8_SB(1, 1), cB + hstep + kstep, voffB);
        PG8_WAIT_V(6); PG8_BAR;
    }
    for (;;) {
        const bool has_next = S.next(ui + 1, nxt);
        const char* nA = has_next ? (const char*)g.A + (size_t)nxt.pm * tstep : cA; const char* nB = has_next ? (const char*)g.Bt + (size_t)nxt.pn * tstep : cB;
#pragma unroll 1
        for (int t = 0; t < nt; t += 2) {
            if constexpr (Epi::MIDHOOK) { if (t == nt / 2) E.mid(acc, cur, wr, wc, fr, fq); }
            const bool last = (t == nt - 2);
            const char* a1 = cA + (size_t)(t + 1) * kstep;
            const char* a2 = last ? nA : cA + (size_t)(t + 2) * kstep; const char* b2 = last ? nB : cB + (size_t)(t + 2) * kstep;
            const char* a3 = a2 + kstep; const char* b3 = b2 + kstep;
            if (last && has_next) S.a_ready(nxt);
            if constexpr (SP2) {
            PG8_LDB(B0, 0, 0); PG8_LDB(B1, 0, 1); PG8_SCHED; PG8_LDA(At, 0, 0); PG8_STAGE(PG8_SA(1, 1), a1 + hstep, voffA);
            PG8_WAIT_V(8); PG8_WAIT_L(0); PG8_BAR; PG8_MMA(0, 0, At, B0); PG8_MMA(0, 1, At, B1); PG8_BAR; PG8_SCHED;
            PG8_LDA(At, 0, 1); PG8_STAGE(PG8_SB(0, 0), b2, voffB); PG8_STAGE(PG8_SB(0, 1), b2 + hstep, voffB); PG8_STAGE(PG8_SA(0, 0), a2, voffA);
            PG8_WAIT_V(8); PG8_WAIT_L(0); PG8_BAR; PG8_MMA(1, 0, At, B0); PG8_MMA(1, 1, At, B1); PG8_BAR; PG8_SCHED;
            PG8_LDB(B0, 1, 0); PG8_LDB(B1, 1, 1); PG8_SCHED; PG8_LDA(At, 1, 0); PG8_STAGE(PG8_SA(0, 1), a2 + hstep, voffA);
            PG8_WAIT_V(8); PG8_WAIT_L(0); PG8_BAR; PG8_MMA(0, 0, At, B0); PG8_MMA(0, 1, At, B1); PG8_BAR; PG8_SCHED;
            PG8_LDA(At, 1, 1); PG8_STAGE(PG8_SB(1, 0), b3, voffB); PG8_STAGE(PG8_SB(1, 1), b3 + hstep, voffB); PG8_STAGE(PG8_SA(1, 0), a3, voffA);
            PG8_WAIT_V(8); PG8_WAIT_L(0); PG8_BAR; PG8_MMA(1, 0, At, B0); PG8_MMA(1, 1, At, B1); PG8_BAR; PG8_SCHED;
            } else {
            PG8_LDB(B0, 0, 0); PG8_SCHED; PG8_LDA(At, 0, 0); PG8_STAGE(PG8_SA(1, 1), a1 + hstep, voffA);
            PG8_WAIT_L(8); PG8_BAR; PG8_WAIT_L(0); PG8_MMA(0, 0, At, B0); PG8_BAR; PG8_SCHED;
            PG8_LDB(B1, 0, 1); PG8_STAGE(PG8_SB(0, 0), b2, voffB);
            PG8_BAR; PG8_WAIT_L(0); PG8_MMA(0, 1, At, B1); PG8_BAR;
            PG8_LDA(At, 0, 1); PG8_STAGE(PG8_SA(0, 0), a2, voffA);
            PG8_BAR; PG8_WAIT_L(0); PG8_MMA(1, 0, At, B0); PG8_BAR; PG8_SCHED;
            PG8_STAGE(PG8_SB(0, 1), b2 + hstep, voffB);
            PG8_WAIT_V(6); PG8_BAR; PG8_MMA(1, 1, At, B1); PG8_BAR;
            PG8_LDB(B0, 1, 0); PG8_SCHED; PG8_LDA(At, 1, 0); PG8_STAGE(PG8_SA(0, 1), a2 + hstep, voffA);
            PG8_WAIT_L(8); PG8_BAR; PG8_WAIT_L(0); PG8_MMA(0, 0, At, B0); PG8_BAR; PG8_SCHED;
            PG8_LDB(B1, 1, 1); PG8_STAGE(PG8_SB(1, 0), b3, voffB);
            PG8_BAR; PG8_WAIT_L(0); PG8_MMA(0, 1, At, B1); PG8_BAR;
            PG8_LDA(At, 1, 1); PG8_STAGE(PG8_SA(1, 0), a3, voffA);
            PG8_BAR; PG8_WAIT_L(0); PG8_MMA(1, 0, At, B0); PG8_BAR; PG8_SCHED;
            PG8_STAGE(PG8_SB(1, 1), b3 + hstep, voffB);
            PG8_WAIT_V(6); PG8_BAR; PG8_MMA(1, 1, At, B1); PG8_BAR;
            }
        }
        if constexpr (ALIGN_EPI) { if (wr == 0) PG8_BAR; }
        if constexpr (!Epi::AFTER_DRAIN) { E(acc, cur, wr, wc, fr, fq); S.done(cur); }
        if (!has_next) break;
#pragma unroll
        for (int a = 0; a < 2; ++a)
#pragma unroll
            for (int b = 0; b < 2; ++b)
#pragma unroll
                for (int m = 0; m < 4; ++m)
#pragma unroll
                    for (int n = 0; n < 2; ++n) acc[a][b][m][n] = (f32x4){0.f, 0.f, 0.f, 0.f};
        cur = nxt; cA = nA; cB = nB; ++ui;
        if constexpr (ALIGN_EPI) { if (wr == 1) PG8_BAR; }
    }
    PG8_WAIT_V(0);
    if constexpr (!ALIGN_EPI) { if (wr == 0) PG8_BAR; }
    PG8_BAR;
    if constexpr (Epi::AFTER_DRAIN) { E.fused(acc, cur, wr, wc, fr, fq, lds, wid, lane); S.done(cur); }
#undef PG8_SA
#undef PG8_SB
#undef PG8_STAGE
#undef PG8_LDA
#undef PG8_LDB
#undef PG8_MMA
#undef PG8_WAIT_V
#undef PG8_WAIT_L
#undef PG8_BAR
#undef PG8_SCHED
}
}

#define LAS __attribute__((address_space(3)))
typedef unsigned short bf16;
typedef float f32x4 __attribute__((ext_vector_type(4)));
typedef float f32x16 __attribute__((ext_vector_type(16)));
typedef short bf16x8 __attribute__((ext_vector_type(8)));
typedef unsigned u32x4 __attribute__((ext_vector_type(4)));
typedef unsigned u32x2 __attribute__((ext_vector_type(2)));

constexpr int NTOK = 65536, DM = 1024, DFF = 2816, SEQ = 2048, NBATCH = 32;
constexpr int NPAN = NTOK / 256;
constexpr float LN_EPS = 1e-5f, RMS_EPS = 1e-5f;
constexpr float DN_ALPHA = 1.189207115002721f;
constexpr float LAMBDA_INIT = 0.2f;
constexpr float QSCALE = 0.125f * 1.4426950408889634f;

constexpr size_t MiB = 1u << 20;
constexpr size_t WS_WGU1 = 0, WS_WD1 = 11 * MiB, WS_WIN = 17 * MiB, WS_WBA = 25 * MiB, WS_WBP = 26 * MiB, WS_WOUT = 27 * MiB, WS_WGU2 = 29 * MiB, WS_WD2 = 40 * MiB;
constexpr size_t WS_COS = 46 * MiB, WS_SIN = 46 * MiB + 256 * 1024;
constexpr size_t WS_XB = 48 * MiB;
constexpr size_t WS_YATT = WS_XB, WS_POOL = WS_XB + 64 * MiB;
constexpr size_t WS_X1F = 176 * MiB;
constexpr size_t WS_R1 = 432 * MiB;
constexpr size_t WS_Q = WS_R1, WS_K = WS_R1 + 64 * MiB, WS_VT = WS_R1 + 128 * MiB, WS_U = WS_R1 + 192 * MiB;
constexpr size_t WS_R2 = 784 * MiB;
constexpr size_t WS_O1S = 912 * MiB;
constexpr size_t WS_BAR = 944 * MiB;
constexpr size_t WS_END = 976 * MiB;
constexpr int LDS_BYTES = 139264;

__device__ __forceinline__ unsigned f2bf(float f) { unsigned u = __builtin_bit_cast(unsigned, f); return (u + 0x7fffu + ((u >> 16) & 1u)) >> 16; }
__device__ __forceinline__ unsigned pk2(float lo, float hi) { return f2bf(lo) | (f2bf(hi) << 16); }
__device__ __forceinline__ float wave_sum(float v) {
#pragma unroll
    for (int o = 1; o < 64; o <<= 1) v += __shfl_xor(v, o);
    return v;
}
__device__ __forceinline__ float swap_max(float m) { auto rr = __builtin_amdgcn_permlane32_swap(__float_as_uint(m), __float_as_uint(m), false, false); return fmaxf(__uint_as_float(rr[0]), __uint_as_float(rr[1])); }
__device__ __forceinline__ float swap_sum(float m) { auto rr = __builtin_amdgcn_permlane32_swap(__float_as_uint(m), __float_as_uint(m), false, false); return __uint_as_float(rr[0]) + __uint_as_float(rr[1]); }

struct MapOff { int off; __device__ __forceinline__ int operator()(int n) const { return off + n; } };
struct MapGateUp { int half; __device__ __forceinline__ int operator()(int n) const { return 256 * (n >> 7) + (n & 127) + 128 * half; } };
struct MapWin { __device__ __forceinline__ int operator()(int n) const {
    if (n < 1024) { const int t = n >> 8, r = n & 255, s = r >> 6, w = r & 63, hf = w >> 5, i = w & 31; return 256 * t + 128 * hf + 32 * s + i; }
    if (n < 1536) return 3584 + (n - 1024);
    if (n < 2048) return 1024 + (n - 1536);
    { const int c = n - 2048, br = c >> 10, j = c & 1023; return 1536 + 256 * (j >> 7) + 128 * br + (j & 127); } } };
template <class MAP>
__device__ __forceinline__ void transpose_item(const float* __restrict__ W, int K, int N, bf16* __restrict__ WT, const MAP map, LAS float* scr, int item, int lane, int ldw = 0) {
    if (ldw == 0) ldw = K;
    const int nblk = N / 32, kb = item / nblk, nb = item % nblk, k0 = 64 * kb, n0 = 32 * nb;
#pragma unroll 8
    for (int i = 0; i < 32; ++i) { const int kk = 2 * i + (lane >> 5); scr[kk * 33 + (lane & 31)] = W[(size_t)(k0 + kk) * N + n0 + (lane & 31)]; }
    asm volatile("s_waitcnt lgkmcnt(0)" ::: "memory");
    const int c = lane & 7;
#pragma unroll
    for (int j = 0; j < 4; ++j) { const int n = (lane >> 3) + 8 * j; const LAS float* s = scr + (8 * c) * 33 + n;
        u32x4 o; o.x = pk2(s[0 * 33], s[1 * 33]); o.y = pk2(s[2 * 33], s[3 * 33]); o.z = pk2(s[4 * 33], s[5 * 33]); o.w = pk2(s[6 * 33], s[7 * 33]);
        *(u32x4*)(WT + (size_t)map(n0 + n) * ldw + k0 + 8 * c) = o; }
    asm volatile("s_waitcnt lgkmcnt(0)" ::: "memory");
}

#define XB_TMO      128
#define XB_XCNT(j)  (256  + 64 * (j))
#define XB_XSUB(j)  (1280 + 64 * (j))
#define XB_XGEN(j)  (2304 + 64 * (j))
#define XB_TOP      3328
#define XB_TOPGEN   3392
#define XCD_BAR_WORDS 3456
#define XB_SPIN_CAP (1u << 18)

__device__ __forceinline__ unsigned xb_ld(unsigned* p)              { return __hip_atomic_load(p, __ATOMIC_RELAXED, __HIP_MEMORY_SCOPE_AGENT); }
__device__ __forceinline__ unsigned xb_add(unsigned* p, unsigned v) { return __hip_atomic_fetch_add(p, v, __ATOMIC_RELAXED, __HIP_MEMORY_SCOPE_AGENT); }
__device__ __forceinline__ unsigned xb_xcc_id() { return (unsigned)__builtin_amdgcn_s_getreg((3 << 11) | 20) & 0xFu; }
#define XB_SPIN(cond, bar) do { unsigned _sp = 0; while (cond) { __builtin_amdgcn_s_sleep(1); \
    if ((++_sp & 255u) == 0u) { if (xb_ld(&(bar)[XB_TMO])) break; if (_sp > XB_SPIN_CAP) { atomicAdd(&(bar)[XB_TMO], 1u); break; } } } } while (0)

struct XcdBarrier {
    unsigned* bar; unsigned x;
    volatile LAS unsigned* st;
};

__device__ __forceinline__ XcdBarrier xcd_barrier_post(unsigned* bar, volatile LAS unsigned* st) {
    XcdBarrier b; b.bar = bar; b.x = xb_xcc_id(); b.st = st;
    if (threadIdx.x == 0) (void)xb_add(&bar[XB_XCNT(b.x)], 1u);
    return b;
}
__device__ __forceinline__ void xcd_barrier_complete(unsigned* bar, unsigned x, unsigned& nloc, unsigned& nx) {
    const unsigned G = gridDim.x * gridDim.y * gridDim.z;
    unsigned sum, cnt, mine, sp = 0u;
    for (;;) {
        sum = 0u; cnt = 0u; mine = 0u;
#pragma unroll
        for (unsigned j = 0; j < 16; ++j) { const unsigned c = xb_ld(&bar[XB_XCNT(j)]); sum += c; cnt += (c > 0u) ? 1u : 0u; mine = (j == x) ? c : mine; }
        if (sum == G) break;
        __builtin_amdgcn_s_sleep(1);
        if ((++sp & 255u) == 0u) { if (xb_ld(&bar[XB_TMO])) break; if (sp > XB_SPIN_CAP) { atomicAdd(&bar[XB_TMO], 1u); break; } }
    }
    nloc = mine > 0u ? mine : 1u; nx = cnt > 0u ? cnt : 1u;
}

__device__ __forceinline__ void xcd_barrier(const XcdBarrier& b) {
    asm volatile("s_waitcnt vmcnt(0)" ::: "memory");
    __syncthreads();
    if (threadIdx.x == 0) {
        unsigned* bar = b.bar;
        __builtin_amdgcn_s_waitcnt(0);
        unsigned nloc = b.st[0], nx = b.st[1];
        if (nloc == 0u) { xcd_barrier_complete(bar, b.x, nloc, nx); b.st[0] = nloc; b.st[1] = nx; }
        const unsigned old = xb_add(&bar[XB_XSUB(b.x)], 1u);
        const unsigned gen = old / nloc;
        if (old + 1u == (gen + 1u) * nloc) {
            __builtin_amdgcn_fence(__ATOMIC_RELEASE, "agent");
            asm volatile("s_waitcnt vmcnt(0)" ::: "memory");
            const unsigned og = xb_add(&bar[XB_TOP], 1u);
            const unsigned tg = og / nx;
            if (og + 1u == (tg + 1u) * nx) xb_add(&bar[XB_TOPGEN], 1u);
            else XB_SPIN(xb_ld(&bar[XB_TOPGEN]) == tg, bar);
            __builtin_amdgcn_fence(__ATOMIC_ACQUIRE, "agent");
            xb_add(&bar[XB_XGEN(b.x)], 1u);
            asm volatile("s_waitcnt vmcnt(0)" ::: "memory");
        } else {
            XB_SPIN(xb_ld(&bar[XB_XGEN(b.x)]) == gen, bar);
            __builtin_amdgcn_fence(__ATOMIC_ACQUIRE, "agent");
            asm volatile("s_waitcnt vmcnt(0)" ::: "memory");
        }
    }
    __syncthreads();
}

struct Args { const float* in[24]; float* out; unsigned char* ws; int ph_lo, ph_hi, rep_mask, pad; };

__device__ __forceinline__ void ln_panel(const bf16* Y, float* Xf, bf16* Xb, const float* g, const float* bta, int pm, int wid, int lane) {
    asm volatile("" : "+s"(g), "+s"(bta));
    f32x4 gv[4], bv[4];
#pragma unroll
    for (int j = 0; j < 2; ++j)
#pragma unroll
        for (int n = 0; n < 2; ++n) { gv[2 * j + n] = *(const f32x4*)(g + 8 * lane + 512 * j + 4 * n); bv[2 * j + n] = *(const f32x4*)(bta + 8 * lane + 512 * j + 4 * n); }
    constexpr int RB = 4;
#pragma unroll 1
    for (int r = 0; r < 32; r += RB) {
        const size_t row0 = (size_t)pm * 256 + wid * 32 + r;
        u32x4 raw[RB][2]; f32x4 v[RB][4]; float s[RB];
#pragma unroll
        for (int q = 0; q < RB; ++q)
#pragma unroll
            for (int j = 0; j < 2; ++j) raw[q][j] = *(const u32x4*)(Y + (row0 + q) * 1024 + 8 * lane + 512 * j);
#pragma unroll
        for (int q = 0; q < RB; ++q) { s[q] = 0.f;
#pragma unroll
            for (int j = 0; j < 2; ++j) pg8::unpack8(raw[q][j], v[q][2 * j], v[q][2 * j + 1]);
#pragma unroll
            for (int j = 0; j < 4; ++j) s[q] += (v[q][j][0] + v[q][j][1]) + (v[q][j][2] + v[q][j][3]); }
#pragma unroll
        for (int o = 1; o < 64; o <<= 1)
#pragma unroll
            for (int q = 0; q < RB; ++q) s[q] += __shfl_xor(s[q], o);
        float s2[RB];
#pragma unroll
        for (int q = 0; q < RB; ++q) { const float mean = s[q] * (1.0f / 1024.0f); s2[q] = 0.f;
#pragma unroll
            for (int j = 0; j < 4; ++j) { v[q][j] = v[q][j] - mean; s2[q] += (v[q][j][0] * v[q][j][0] + v[q][j][1] * v[q][j][1]) + (v[q][j][2] * v[q][j][2] + v[q][j][3] * v[q][j][3]); } }
#pragma unroll
        for (int o = 1; o < 64; o <<= 1)
#pragma unroll
            for (int q = 0; q < RB; ++q) s2[q] += __shfl_xor(s2[q], o);
#pragma unroll
        for (int q = 0; q < RB; ++q) { const float rstd = 1.0f / sqrtf(s2[q] * (1.0f / 1024.0f) + LN_EPS); const size_t row = row0 + q;
#pragma unroll
            for (int j = 0; j < 2; ++j) { const f32x4 o0 = v[q][2 * j] * rstd * gv[2 * j] + bv[2 * j], o1 = v[q][2 * j + 1] * rstd * gv[2 * j + 1] + bv[2 * j + 1];
                if (Xf) { *(f32x4*)(Xf + row * 1024 + 8 * lane + 512 * j) = o0; *(f32x4*)(Xf + row * 1024 + 8 * lane + 512 * j + 4) = o1; }
                if (Xb) __builtin_nontemporal_store(pg8::pack8(o0, o1), (u32x4*)(Xb + row * 1024 + 8 * lane + 512 * j)); } }
    }
}

struct AttnState { float mrun, l; };
#define DSR128(dst, addr, off) asm volatile("ds_read_b128 %0, %1 offset:%2" : "=&v"(dst) : "v"(addr), "i"(off))
template <bool FIRST, bool HAS_PREV>
__device__ __forceinline__ void attn_step(f32x16& c0, f32x16& c1, f32x16 (&o)[4], bf16x8 (&pbp)[4], const bf16x8 (&qr)[4], AttnState& st,
                                          const LAS unsigned char* kfr, const LAS unsigned char* vfr, const int (&kofs)[4], const int (&vofs)[4]) {
    const unsigned kb_ = (unsigned)(unsigned long)kfr, vb_ = (unsigned)(unsigned long)vfr;
    unsigned ka[4], va[4];
#pragma unroll
    for (int k = 0; k < 4; ++k) { ka[k] = kb_ + (unsigned)kofs[k]; va[k] = vb_ + (unsigned)vofs[k]; }
    bf16x8 kf[4], vA[4], vB[4];
    { const float nm = FIRST ? 0.f : -st.mrun;
#pragma unroll
      for (int i = 0; i < 16; ++i) { c0[i] = nm; c1[i] = nm; } }
#pragma unroll
    for (int ks = 0; ks < 2; ++ks) { DSR128(kf[2 * ks], ka[ks], 0); DSR128(kf[2 * ks + 1], ka[ks], 4096); }
    asm volatile("s_waitcnt lgkmcnt(0)" : "+v"(kf[0]), "+v"(kf[1]), "+v"(kf[2]), "+v"(kf[3]));
#pragma unroll
    for (int ks = 0; ks < 2; ++ks) {
        c0 = __builtin_amdgcn_mfma_f32_32x32x16_bf16(kf[2 * ks], qr[ks], c0, 0, 0, 0);
        c1 = __builtin_amdgcn_mfma_f32_32x32x16_bf16(kf[2 * ks + 1], qr[ks], c1, 0, 0, 0);
    }
    __builtin_amdgcn_sched_barrier(0);
    { bf16x8 kg[4];
#pragma unroll
      for (int ks = 0; ks < 2; ++ks) { DSR128(kg[2 * ks], ka[2 + ks], 0); DSR128(kg[2 * ks + 1], ka[2 + ks], 4096); }
      asm volatile("s_waitcnt lgkmcnt(0)" : "+v"(kg[0]), "+v"(kg[1]), "+v"(kg[2]), "+v"(kg[3]));
#pragma unroll
      for (int ks = 0; ks < 2; ++ks) {
          c0 = __builtin_amdgcn_mfma_f32_32x32x16_bf16(kg[2 * ks], qr[2 + ks], c0, 0, 0, 0);
          c1 = __builtin_amdgcn_mfma_f32_32x32x16_bf16(kg[2 * ks + 1], qr[2 + ks], c1, 0, 0, 0);
      } }
    __builtin_amdgcn_sched_barrier(0);
    if (HAS_PREV) {
#pragma unroll
        for (int e = 0; e < 4; ++e) DSR128(vA[e], va[0], e * 4096);
    }
    float mx = fmaxf(c0[0], c1[0]);
#pragma unroll
    for (int i = 1; i < 16; ++i) mx = fmaxf(mx, fmaxf(c0[i], c1[i]));
    mx = swap_max(mx);
    float a = 1.0f;
    { const float dl = FIRST ? mx : ((mx > 8.0f) ? mx : 0.f);
      if (FIRST || __any(dl != 0.f)) {
#pragma unroll
          for (int i = 0; i < 16; ++i) { c0[i] -= dl; c1[i] -= dl; }
          st.mrun += dl; if (!FIRST) a = __builtin_amdgcn_exp2f(-dl);
      } }
    float ps = 0.f;
#define ATT_EXPS(E) do { _Pragma("unroll") for (int j = 0; j < 8; ++j) { const int i = (E) * 8 + j; \
        if (i < 16) { c0[i] = __builtin_amdgcn_exp2f(c0[i]); ps += c0[i]; } else { c1[i - 16] = __builtin_amdgcn_exp2f(c1[i - 16]); ps += c1[i - 16]; } } \
        asm volatile("" : "+v"(c0), "+v"(c1), "+v"(ps)); __builtin_amdgcn_sched_barrier(0); } while (0)
#define ATT_PV(KK, VF) do { _Pragma("unroll") for (int e = 0; e < 4; ++e) o[e] = __builtin_amdgcn_mfma_f32_32x32x16_bf16(VF[e], pbp[KK], o[e], 0, 0, 0); } while (0)
#define ATT_TIE(N, VF) asm volatile("s_waitcnt lgkmcnt(" #N ")" : "+v"(VF[0]), "+v"(VF[1]), "+v"(VF[2]), "+v"(VF[3]))
    if (HAS_PREV) {
        __builtin_amdgcn_sched_barrier(0);
#pragma unroll
        for (int e = 0; e < 4; ++e) DSR128(vB[e], va[1], e * 4096);
        ATT_TIE(4, vA); ATT_PV(0, vA); ATT_EXPS(0);
#pragma unroll
        for (int e = 0; e < 4; ++e) DSR128(vA[e], va[2], e * 4096);
        ATT_TIE(4, vB); ATT_PV(1, vB); ATT_EXPS(1);
#pragma unroll
        for (int e = 0; e < 4; ++e) DSR128(vB[e], va[3], e * 4096);
        ATT_TIE(4, vA); ATT_PV(2, vA); ATT_EXPS(2);
        ATT_TIE(0, vB); ATT_PV(3, vB); ATT_EXPS(3);
    } else {
#pragma unroll
        for (int i = 0; i < 16; ++i) { c0[i] = __builtin_amdgcn_exp2f(c0[i]); ps += c0[i]; c1[i] = __builtin_amdgcn_exp2f(c1[i]); ps += c1[i]; }
    }
#undef ATT_EXPS
#undef ATT_PV
#undef ATT_TIE
    st.l = st.l * a + ps;
    if (!FIRST) { if (__any(a != 1.0f)) {
#pragma unroll
        for (int e = 0; e < 4; ++e)
#pragma unroll
            for (int i = 0; i < 16; ++i) o[e][i] *= a; } }
    { u32x4 w;
      w.x = pg8::cvt_pk_bf16(c0[0], c0[1]); w.y = pg8::cvt_pk_bf16(c0[2], c0[3]); w.z = pg8::cvt_pk_bf16(c0[4], c0[5]); w.w = pg8::cvt_pk_bf16(c0[6], c0[7]); pbp[0] = __builtin_bit_cast(bf16x8, w);
      w.x = pg8::cvt_pk_bf16(c0[8], c0[9]); w.y = pg8::cvt_pk_bf16(c0[10], c0[11]); w.z = pg8::cvt_pk_bf16(c0[12], c0[13]); w.w = pg8::cvt_pk_bf16(c0[14], c0[15]); pbp[1] = __builtin_bit_cast(bf16x8, w);
      w.x = pg8::cvt_pk_bf16(c1[0], c1[1]); w.y = pg8::cvt_pk_bf16(c1[2], c1[3]); w.z = pg8::cvt_pk_bf16(c1[4], c1[5]); w.w = pg8::cvt_pk_bf16(c1[6], c1[7]); pbp[2] = __builtin_bit_cast(bf16x8, w);
      w.x = pg8::cvt_pk_bf16(c1[8], c1[9]); w.y = pg8::cvt_pk_bf16(c1[10], c1[11]); w.z = pg8::cvt_pk_bf16(c1[12], c1[13]); w.w = pg8::cvt_pk_bf16(c1[14], c1[15]); pbp[3] = __builtin_bit_cast(bf16x8, w); }
}
__device__ __forceinline__ void attn_unit(LAS unsigned char* lds, const bf16* __restrict__ Qb, const bf16* __restrict__ Kb, const bf16* __restrict__ VT, bf16* __restrict__ Y,
                                          const float* __restrict__ gsub, float lam, int b, int h, int qb, float* o1scr) {
    int tid_ = threadIdx.x; asm volatile("" : "+v"(tid_));
    const int tid = tid_, lane = tid & 63, wid = __builtin_amdgcn_readfirstlane(tid >> 6), r32 = lane & 31, hi = lane >> 5;
    const size_t tok0 = (size_t)b * SEQ;
    constexpr int KSL = 8192, VSL = 16384, VB0 = 3 * KSL;
    const int kap = 16 * ((r32 >> 4) & 1) + 8 * ((r32 >> 2) & 1) + 4 * ((r32 >> 3) & 1) + (r32 & 3);
    int kofs[4], vofs[4];
#pragma unroll
    for (int k = 0; k < 4; ++k) { kofs[k] = kap * 128 + (((2 * k + hi) ^ ((kap >> 1) & 7)) << 4); vofs[k] = r32 * 128 + (((2 * k + hi) ^ ((r32 >> 1) & 7)) << 4); }
    const int lrow = tid >> 3, lc = (tid & 7) ^ ((lrow >> 1) & 7);
    const int kcol = (lc < 4) ? 8 * lc : 128 + 8 * (lc - 4);
    const unsigned wofs = (unsigned)wid * 1024u;
    f32x16 o[4]; float inv = 0.f;
#define ATT_WAITBAR(N) do { asm volatile("s_waitcnt vmcnt(" #N ") lgkmcnt(0)" ::: "memory"); __builtin_amdgcn_s_barrier(); asm volatile("" ::: "memory"); } while (0)
#define ATT_DMA(src, ldsoff) __builtin_amdgcn_global_load_lds((const unsigned*)(src), (LAS unsigned*)(lds + (ldsoff) + wofs), 16, 0, 0)
#pragma unroll 1
    for (int mp = 0; mp < 2; ++mp) {
        const int c1 = 256 * (h >> 1) + 32 * (2 * (h & 1) + mp);
        const bf16* qp = Qb + (tok0 + (size_t)qb * 256 + wid * 32 + r32) * 512 + c1 + 8 * hi;
        bf16x8 qr[4];
        qr[0] = *(const bf16x8*)(qp); qr[1] = *(const bf16x8*)(qp + 16); qr[2] = *(const bf16x8*)(qp + 128); qr[3] = *(const bf16x8*)(qp + 144);
        const bf16* kp = Kb + (tok0 + lrow) * 512 + c1 + kcol;
        const bf16* vp = VT + ((size_t)((b * 4 + h) * 32) * 128 + lrow) * 64 + lc * 8;
        ATT_DMA(kp, 0); ATT_DMA(vp, VB0); ATT_DMA(vp + 4096, VB0 + 8192); ATT_DMA(kp + (size_t)64 * 512, KSL);
        ATT_WAITBAR(0);
#pragma unroll
        for (int e = 0; e < 4; ++e)
#pragma unroll
            for (int i = 0; i < 16; ++i) o[e][i] = 0.f;
        AttnState st; st.mrun = 0.f; st.l = 0.f;
        bf16x8 pbp[4];
        f32x16 sA, sB;
        int s0 = 0, s1 = 1, s2 = 2;
#define ATT_STEP(T, FIRST, HASP) do { const int t_ = (T); \
        if (t_ + 2 < 32) ATT_DMA(kp + (size_t)(t_ + 2) * 64 * 512, s2 * KSL); \
        if (t_ + 1 < 32) { ATT_DMA(vp + (size_t)(t_ + 1) * 8192, VB0 + s1 * VSL); ATT_DMA(vp + (size_t)(t_ + 1) * 8192 + 4096, VB0 + s1 * VSL + 8192); } \
        attn_step<FIRST, HASP>(sA, sB, o, pbp, qr, st, lds + s0 * KSL, lds + VB0 + s2 * VSL, kofs, vofs); \
        if (t_ + 2 < 32) ATT_WAITBAR(3); else ATT_WAITBAR(0); \
        { const int tmp_ = s0; s0 = s1; s1 = s2; s2 = tmp_; } } while (0)
        ATT_STEP(0, true, false);
#pragma unroll 1
        for (int t = 1; t < 32; ++t) ATT_STEP(t, false, true);
#undef ATT_STEP
        { const LAS unsigned char* vb = lds + VB0 + 1 * VSL;
#pragma unroll
          for (int e = 0; e < 4; ++e)
#pragma unroll
              for (int kk = 0; kk < 4; ++kk) { const bf16x8 vf = *(const LAS bf16x8*)(vb + e * 4096 + vofs[kk]);
                  o[e] = __builtin_amdgcn_mfma_f32_32x32x16_bf16(vf, pbp[kk], o[e], 0, 0, 0); } }
        ATT_WAITBAR(0);
        inv = 1.0f / swap_sum(st.l);
        if (mp == 0) {
#pragma unroll
            for (int e = 0; e < 4; ++e)
#pragma unroll
                for (int a = 0; a < 4; ++a) { f32x4 v = {o[e][4 * a] * inv, o[e][4 * a + 1] * inv, o[e][4 * a + 2] * inv, o[e][4 * a + 3] * inv};
                    *(f32x4*)(o1scr + ((size_t)(e * 4 + a) * 512 + tid) * 4) = v; }
        }
    }
#undef ATT_WAITBAR
#undef ATT_DMA
    {
        const float li = lam * inv; float ss = 0.f;
#pragma unroll
        for (int e = 0; e < 4; ++e)
#pragma unroll
            for (int a = 0; a < 4; ++a) { const f32x4 v1 = *(const f32x4*)(o1scr + ((size_t)(e * 4 + a) * 512 + tid) * 4);
#pragma unroll
                for (int k = 0; k < 4; ++k) { const float v = v1[k] - li * o[e][4 * a + k]; o[e][4 * a + k] = v; ss += v * v; } }
        ss = swap_sum(ss);
        const float rs = (1.0f - LAMBDA_INIT) / sqrtf(ss * (1.0f / 128.0f) + RMS_EPS);
        bf16* yp = Y + (tok0 + (size_t)qb * 256 + wid * 32 + r32) * 1024 + h * 128 + 4 * hi;
#pragma unroll
        for (int e = 0; e < 4; ++e)
#pragma unroll
            for (int a = 0; a < 4; ++a) { const f32x4 gg = *(const f32x4*)(gsub + 32 * e + 8 * a + 4 * hi);
                u32x2 w; w.x = pk2(o[e][4 * a] * rs * gg[0], o[e][4 * a + 1] * rs * gg[1]); w.y = pk2(o[e][4 * a + 2] * rs * gg[2], o[e][4 * a + 3] * rs * gg[3]);
                *(u32x2*)(yp + 32 * e + 8 * a) = w; }
    }
}

constexpr int NPHASE = 12;
__global__ void __launch_bounds__(512, 2) fwd_mega(Args a) {
    extern __shared__ __attribute__((aligned(16))) unsigned char lds_raw[];
    LAS unsigned char* lds = (LAS unsigned char*)lds_raw;
    cg::grid_group grid = cg::this_grid();
    const int tid = threadIdx.x, lane = tid & 63, wid = __builtin_amdgcn_readfirstlane(tid >> 6);
    const int G = gridDim.x, bx = blockIdx.x;
    const int lo = a.ph_lo, hi = a.ph_hi;
    const bool fused = (hi - lo) > 1;
    volatile LAS unsigned* MISC = (volatile LAS unsigned*)(lds + 131072 + 512);
    if (tid < 4) MISC[tid] = 0u;
    __syncthreads();
    XcdBarrier xbar; xbar.bar = (unsigned*)(a.ws + WS_BAR); xbar.x = 0; xbar.st = MISC;
    if (fused) xbar = xcd_barrier_post((unsigned*)(a.ws + WS_BAR), MISC);
    if (a.ph_lo < 0) grid.sync();
    unsigned char* ws = a.ws;
    const float* x = a.in[0];
    bf16* Wgu1 = (bf16*)(ws + WS_WGU1); bf16* Wd1 = (bf16*)(ws + WS_WD1); bf16* Win = (bf16*)(ws + WS_WIN); bf16* Wba = (bf16*)(ws + WS_WBA); bf16* Wbp = (bf16*)(ws + WS_WBP);
    bf16* Wout = (bf16*)(ws + WS_WOUT); bf16* Wgu2 = (bf16*)(ws + WS_WGU2); bf16* Wd2 = (bf16*)(ws + WS_WD2);
    float* cosT = (float*)(ws + WS_COS); float* sinT = (float*)(ws + WS_SIN);
    bf16* XB = (bf16*)(ws + WS_XB); bf16* YATT = (bf16*)(ws + WS_YATT); bf16* POOL = (bf16*)(ws + WS_POOL);
    bf16* Y1 = (bf16*)(ws + WS_X1F);
    bf16* X1B = (bf16*)a.out;
    bf16* HB = (bf16*)(ws + WS_R1); bf16* QB = (bf16*)(ws + WS_Q); bf16* KB = (bf16*)(ws + WS_K); bf16* VTB = (bf16*)(ws + WS_VT); bf16* UB = (bf16*)(ws + WS_U);
    bf16* TB = (bf16*)(ws + WS_R1);
    bf16* MG = (bf16*)(ws + WS_R2);
    float* O1S = (float*)(ws + WS_O1S) + (size_t)bx * (512 * 64);
    bf16* GATE = (bf16*)(ws + WS_X1F);
    float* OUT = a.out;
#ifndef PHM
#define PHM 4095
#endif
#define IN_PH(k) ((((PHM) >> (k)) & 1) && lo <= (k) && (k) < hi)
#define REPS(k) (IN_PH(k) ? 1 + ((a.rep_mask >> (k)) & 1) : 0)
#define SEAM(k) do { if (lo <= (k) && (k) + 1 < hi) { xcd_barrier(xbar); } } while (0)
#define WG_HANDOFF() do { asm volatile("s_waitcnt vmcnt(0) lgkmcnt(0)" ::: "memory"); __syncthreads(); __builtin_amdgcn_fence(__ATOMIC_ACQUIRE, "agent"); asm volatile("s_waitcnt vmcnt(0)" ::: "memory"); } while (0)

    if (IN_PH(0)) {
        LAS float* scr = (LAS float*)(lds + wid * 16384);
        const int gw = bx * 8 + wid, NGW = G * 8;
        constexpr int I_GU = (DM / 64) * (DFF / 32), I_DN = (DFF / 64) * (DM / 32), I_IN = (DM / 64) * (4096 / 32), I_BA = (512 / 64) * (DM / 32), I_OUT = (DM / 64) * (DM / 32);
        constexpr int NITEMS = 4 * I_GU + 2 * I_DN + I_IN + I_BA + I_OUT;
        for (int it = gw; it < NITEMS; it += NGW) {
            int r = it;
            if (r < I_GU) { transpose_item(a.in[3], DM, DFF, Wgu1, MapGateUp{0}, scr, r, lane); continue; } r -= I_GU;
            if (r < I_GU) { transpose_item(a.in[4], DM, DFF, Wgu1, MapGateUp{1}, scr, r, lane); continue; } r -= I_GU;
            if (r < I_GU) { transpose_item(a.in[19], DM, DFF, Wgu2, MapGateUp{0}, scr, r, lane); continue; } r -= I_GU;
            if (r < I_GU) { transpose_item(a.in[20], DM, DFF, Wgu2, MapGateUp{1}, scr, r, lane); continue; } r -= I_GU;
            if (r < I_DN) { transpose_item(a.in[5], DFF, DM, Wd1, MapOff{0}, scr, r, lane); continue; } r -= I_DN;
            if (r < I_DN) { transpose_item(a.in[21], DFF, DM, Wd2, MapOff{0}, scr, r, lane); continue; } r -= I_DN;
            if (r < I_IN) { transpose_item(a.in[6], DM, 4096, Win, MapWin{}, scr, r, lane); continue; } r -= I_IN;
            if (r < I_BA) { transpose_item(a.in[14], 512, DM, Wba, MapOff{0}, scr, r, lane, 1024); continue; } r -= I_BA;
            transpose_item(a.in[16], DM, DM, Wout, MapOff{0}, scr, r, lane);
        }
        const size_t gt = (size_t)bx * 512 + tid, NT = (size_t)G * 512;
        { const float* pw = a.in[12]; const float* psc = a.in[13]; const float* wbp = a.in[15];
          for (int w = gw; w < 1024 * 8; w += NGW) { const int n = w & 1023, gc = (w >> 10) * 64 + lane, g = gc >> 7;
              float acc = 0.f;
              for (int d = 0; d < 128; ++d) acc += pw[(size_t)gc * 128 + d] * psc[g * 128 + d] * wbp[(size_t)(g * 128 + d) * 1024 + n];
              Wba[(size_t)n * 1024 + 512 + gc] = (bf16)f2bf(acc); } }
        for (size_t idx = gt; idx < (size_t)SEQ * 32; idx += NT) { const int i = (int)(idx & 31), pos = (int)(idx >> 5);
            const float inv = 1.0f / powf(10000.0f, (float)(2 * i) / 64.0f); const float ang = (float)pos * inv;
            cosT[idx] = cosf(ang); sinT[idx] = sinf(ang); }
#pragma unroll 4
        for (size_t idx = gt; idx < (size_t)NTOK * DM / 8; idx += NT) { const f32x4 v0 = *(const f32x4*)(x + idx * 8), v1 = *(const f32x4*)(x + idx * 8 + 4);
            u32x4 w; w.x = pk2(v0[0], v0[1]); w.y = pk2(v0[2], v0[3]); w.z = pk2(v1[0], v1[1]); w.w = pk2(v1[2], v1[3]); *(u32x4*)(XB + idx * 8) = w; }
        __syncthreads();
    }
    SEAM(0);
    if (IN_PH(1)) {
        pg8::Gemm g{XB, Wgu1, NTOK, 2 * DFF, DM}; pg8::StaticOrder S; S.init(NTOK, 2 * DFF, G, bx);
        pg8::EpiSwiglu E{HB, DFF};
        pg8::gemm_phase<pg8::EpiSwiglu, pg8::StaticOrder, true, true>(lds, g, S, E);
    }
    SEAM(1);
    if (IN_PH(2)) {
        pg8::Gemm g{HB, Wd1, NTOK, DM, DFF}; pg8::StaticOrder S; S.init(NTOK, DM, G, bx);
        pg8::EpiResid E{x, Y1, DN_ALPHA, 0.5f};
        pg8::gemm_phase<pg8::EpiResid, pg8::StaticOrder, true, true>(lds, g, S, E);
    }
    SEAM(2);
    if (IN_PH(3)) {
        for (int pm = bx; pm < NPAN; pm += G) ln_panel(Y1, nullptr, X1B, a.in[1], a.in[2], pm, wid, lane);
        __syncthreads();
    }
    SEAM(3);
    if (IN_PH(4)) {
        { pg8::Gemm g{X1B, Win, NTOK, 3584, DM}; pg8::StaticOrder S; S.init(NTOK, 3584, G, bx);
          pg8::EpiWin E{QB, KB, UB, GATE, cosT, sinT, QSCALE};
          pg8::gemm_phase<pg8::EpiWin, pg8::StaticOrder, true, true>(lds, g, S, E); }
        { pg8::Gemm g{Win + (size_t)3584 * DM, X1B, 512, NTOK, DM}; pg8::StaticOrder S; S.init(512, NTOK, G, bx);
          pg8::EpiVT E{VTB};
          pg8::gemm_phase<pg8::EpiVT, pg8::StaticOrder, true, true>(lds, g, S, E); }
    }
    SEAM(4);
    if (IN_PH(5)) {
        for (int item = bx * 512 + tid; item < NBATCH * 64 * 64; item += G * 512) {
            const int c8 = item & 63, seg = (item >> 6) & 63, bb = item >> 12;
            const int ch = c8 * 8, hw = 1 << (ch >> 7);
            const bf16* base = UB + (size_t)bb * SEQ * 512 + ch;
            bf16* obase = XB + (size_t)bb * SEQ * 1024 + 512 + ch;
            const int s0 = seg * 32;
            f32x4 w0 = {0.f, 0.f, 0.f, 0.f}, w1 = {0.f, 0.f, 0.f, 0.f};
            { const int jlo = (s0 - hw) > 0 ? (s0 - hw) : 0, jhi = (s0 + hw) < SEQ ? (s0 + hw) : SEQ;
              for (int j = jlo; j < jhi; ++j) { f32x4 a0, a1; pg8::unpack8(*(const u32x4*)(base + (size_t)j * 512), a0, a1); w0 += a0; w1 += a1; } }
#pragma unroll 4
            for (int s = s0; s < s0 + 32; ++s) {
                f32x4 u0, u1; pg8::unpack8(*(const u32x4*)(base + (size_t)s * 512), u0, u1);
                const int jlo = (s - hw) > 0 ? (s - hw) : 0, jhi = (s + hw) < SEQ ? (s + hw) : SEQ;
                const float rc = 1.0f / (float)(jhi - jlo);
                __builtin_nontemporal_store(pg8::pack8(w0 * rc - u0, w1 * rc - u1), (u32x4*)(obase + (size_t)s * 1024));
                if (s + hw < SEQ) { f32x4 a0, a1; pg8::unpack8(*(const u32x4*)(base + (size_t)(s + hw) * 512), a0, a1); w0 += a0; w1 += a1; }
                if (s - hw >= 0) { f32x4 a0, a1; pg8::unpack8(*(const u32x4*)(base + (size_t)(s - hw) * 512), a0, a1); w0 -= a0; w1 -= a1; }
            }
        }
        float lam;
        { const float p1 = a.in[7][lane] * a.in[8][lane], p2 = a.in[9][lane] * a.in[10][lane];
          lam = expf(wave_sum(p1)) - expf(wave_sum(p2)) + LAMBDA_INIT; }
        if (G == 256) {
            const int xc = bx & 7, j = bx >> 3;
            for (int i = 0; i < 4; ++i) { const int bh = i * 32 + xc * 4 + (j >> 3), qb = j & 7;
                attn_unit(lds, QB, KB, VTB, YATT, a.in[11], lam, bh >> 2, bh & 3, qb, O1S); }
        } else {
            for (int u = bx; u < 1024; u += G) attn_unit(lds, QB, KB, VTB, YATT, a.in[11], lam, (u >> 3) >> 2, (u >> 3) & 3, u & 7, O1S);
        }
    }
    SEAM(5);
    if (IN_PH(6)) {
        pg8::Gemm g{XB, Wba, NTOK, DM, DM}; pg8::StaticOrder S; S.init(NTOK, DM, G, bx);
        pg8::EpiGateMid E{GATE, MG};
        pg8::gemm_phase<pg8::EpiGateMid, pg8::StaticOrder, true, true>(lds, g, S, E);
    }
    SEAM(6);
    if (IN_PH(7)) {
        pg8::Gemm g{MG, Wout, NTOK, DM, DM}; pg8::StaticOrder S; S.init(NTOK, DM, G, bx);
        pg8::EpiResidB E{X1B, TB, DN_ALPHA, 1.0f};
        pg8::gemm_phase<pg8::EpiResidB, pg8::StaticOrder, true, true>(lds, g, S, E);
    }
    SEAM(7);
    if (IN_PH(8)) {
        for (int pm = bx; pm < NPAN; pm += G) ln_panel(TB, nullptr, MG, a.in[17], a.in[18], pm, wid, lane);
        __syncthreads();
    }
    SEAM(8);
    if (IN_PH(9)) {
        pg8::Gemm g{MG, Wgu2, NTOK, 2 * DFF, DM}; pg8::StaticOrder S; S.init(NTOK, 2 * DFF, G, bx);
        pg8::EpiSwiglu E{HB, DFF};
        pg8::gemm_phase<pg8::EpiSwiglu, pg8::StaticOrder, true, true>(lds, g, S, E);
    }
    SEAM(9);
    if (IN_PH(10)) {
        pg8::Gemm g{HB, Wd2, NTOK, DM, DFF}; pg8::StaticOrder S; S.init(NTOK, DM, G, bx);
        pg8::EpiResidB E{MG, Y1, DN_ALPHA, 0.5f};
        pg8::gemm_phase<pg8::EpiResidB, pg8::StaticOrder, true, true>(lds, g, S, E);
    }
    SEAM(10);
    if (IN_PH(11)) {
        for (int pm = bx; pm < NPAN; pm += G) ln_panel(Y1, OUT, nullptr, a.in[22], a.in[23], pm, wid, lane);
    }
}

#ifndef REP_MASK
#define REP_MASK 0
#endif
#ifndef MK_N_LAUNCHES
#define MK_N_LAUNCHES 1
#endif
extern "C" void kernel_launch(void* const* d_in, const int* in_sizes, int n_in, void* d_out, int out_size, void* d_ws, size_t ws_size, hipStream_t stream) {
    static int grid = 0;
    if (grid == 0) {
        if (n_in != 24 || in_sizes[0] != NTOK * DM || out_size != NTOK * DM || ws_size < WS_END) { fprintf(stderr, "kernel_launch: unexpected shapes (n_in %d, ws %zu)\n", n_in, ws_size); grid = -1; return; }
        int dev = 0, cus = 0, per_cu = 0;
        hipGetDevice(&dev); hipDeviceGetAttribute(&cus, hipDeviceAttributeMultiprocessorCount, dev);
        if (hipFuncSetAttribute((const void*)fwd_mega, hipFuncAttributeMaxDynamicSharedMemorySize, LDS_BYTES) != hipSuccess) { fprintf(stderr, "kernel_launch: hipFuncSetAttribute failed\n"); grid = -1; return; }
        if (hipOccupancyMaxActiveBlocksPerMultiprocessor(&per_cu, (const void*)fwd_mega, 512, LDS_BYTES) != hipSuccess || per_cu < 1) { fprintf(stderr, "kernel_launch: occupancy query says %d\n", per_cu); per_cu = 1; }
        (void)hipGetLastError();
        grid = cus * per_cu;
    }
    if (grid < 0) return;
    Args a{};
    for (int i = 0; i < 24; ++i) a.in[i] = (const float*)d_in[i];
    a.out = (float*)d_out; a.ws = (unsigned char*)d_ws;
    (void)hipMemsetAsync((unsigned char*)d_ws + WS_BAR, 0, 16384, stream);
#if MK_N_LAUNCHES == 1
    a.ph_lo = 0; a.ph_hi = NPHASE; a.rep_mask = REP_MASK;
    void* args[] = {&a};
    hipError_t e = hipLaunchCooperativeKernel((const void*)fwd_mega, dim3(grid), dim3(512), args, LDS_BYTES, stream);
    if (e != hipSuccess) fprintf(stderr, "cooperative launch failed: %s (grid %d)\n", hipGetErrorString(e), grid);
#else
    for (int p = 0; p < NPHASE; ++p) { a.ph_lo = p; a.ph_hi = p + 1; hipLaunchKernelGGL(fwd_mega, dim3(grid), dim3(512), LDS_BYTES, stream, a); }
#endif
}
```

```cpp
#include <hip/hip_runtime.h>
#include <hip/hip_cooperative_groups.h>
#include <cstdio>
#include <cstdint>
namespace cg = cooperative_groups;
namespace pg8 {
#define PG8_LAS __attribute__((address_space(3)))
typedef unsigned short bf16_t;
typedef short bf16x8 __attribute__((ext_vector_type(8)));
typedef float f32x4 __attribute__((ext_vector_type(4)));
typedef unsigned u32x4 __attribute__((ext_vector_type(4)));
constexpr int BM = 256, BK = 64, HALF = 128, HTB = HALF * BK * 2  , STAGE_BYTES = 8 * HTB, NXCD = 8, WGM = 4;

__host__ __device__ __forceinline__ int lds_byte(int r, int c) { const int st = (r >> 4) * 2 + (c >> 5), rr = r & 15, cc = c & 31, ob = rr * 64 + cc * 2; return st * 1024 + (ob ^ (((ob >> 9) & 1) << 5)); }
__host__ __device__ __forceinline__ void stage_rc(int b, int& R, int& C) { const int st = b / 1024, sb = b % 1024, swz = sb ^ (((sb >> 9) & 1) << 5); R = (st >> 1) * 16 + swz / 64; C = (st & 1) * 32 + (swz % 64) / 2; }
__host__ __device__ __forceinline__ int perm32(int rho) { const int n = rho >> 4, i = rho & 15; return 8 * (i >> 2) + 4 * n + (i & 3); }

struct Unit { int pm, pn; };
struct Gemm { const bf16_t* A; const bf16_t* Bt; int M, N, K; };

struct StaticOrder {
    int nM, nN, nwg, G, c;
    __host__ __device__ void init(int M, int N, int G_, int c_) { nM = M / BM; nN = N / BM; nwg = nM * nN; G = G_; c = c_; }
    __host__ __device__ bool next(int i, Unit& u) const {
        const long L = (long)i * G + c; if (L >= nwg) return false;
        int wgid = (int)L; { const int q = nwg / NXCD, r = nwg % NXCD, xcd = wgid % NXCD, off = wgid / NXCD; wgid = (xcd < r ? xcd * (q + 1) : r * (q + 1) + (xcd - r) * q) + off; }
        const int nig = WGM * nN, gid = wgid / nig, fm = gid * WGM, gsz = (nM - fm) < WGM ? (nM - fm) : WGM;
        u.pm = fm + ((wgid % nig) % gsz); u.pn = (wgid % nig) / gsz; return true;
    }
    __device__ __forceinline__ void a_ready(const Unit&) const {}
    __device__ __forceinline__ void done(const Unit&) const {}
};

typedef float cvt_f32x2_t __attribute__((ext_vector_type(2))); typedef __bf16 cvt_bf16x2_t __attribute__((ext_vector_type(2)));
__device__ __forceinline__ unsigned cvt_pk_bf16(float lo, float hi) { cvt_f32x2_t v = {lo, hi}; cvt_bf16x2_t b = __builtin_convertvector(v, cvt_bf16x2_t); return __builtin_bit_cast(unsigned, b); }
typedef float f32x2 __attribute__((ext_vector_type(2)));
struct PanelOrder {
    int pm, npn;
    __device__ __forceinline__ bool next(int i, Unit& u) const { if (i >= npn) return false; int p = pm, q = i; asm volatile("" : "+s"(p), "+s"(q));
        u.pm = p; u.pn = q; return true; }
    __device__ __forceinline__ void a_ready(const Unit&) const {}
    __device__ __forceinline__ void done(const Unit&) const {}
};
__device__ __forceinline__ float fast_sigmoid(float v) { return __builtin_amdgcn_rcpf(1.0f + __builtin_amdgcn_exp2f(v * -1.4426950408889634f)); }
__device__ __forceinline__ u32x4 pack8(const f32x4 a, const f32x4 b) { u32x4 w; w.x = cvt_pk_bf16(a[0], a[1]); w.y = cvt_pk_bf16(a[2], a[3]); w.z = cvt_pk_bf16(b[0], b[1]); w.w = cvt_pk_bf16(b[2], b[3]); return w; }
__device__ __forceinline__ void unpack8(const u32x4 w, f32x4& a, f32x4& b) {
    a[0] = __uint_as_float(w.x << 16); a[1] = __uint_as_float(w.x & 0xffff0000u); a[2] = __uint_as_float(w.y << 16); a[3] = __uint_as_float(w.y & 0xffff0000u);
    b[0] = __uint_as_float(w.z << 16); b[1] = __uint_as_float(w.z & 0xffff0000u); b[2] = __uint_as_float(w.w << 16); b[3] = __uint_as_float(w.w & 0xffff0000u);
}
struct EpiPlain {
    static constexpr bool PERM = true, AFTER_DRAIN = false, MIDHOOK = false;
    bf16_t* O; size_t ldc;
    __device__ __forceinline__ void operator()(const f32x4 (&acc)[2][2][4][2], const Unit& u, int wr, int wc, int fr, int fq) const {
        const int row0 = u.pm * BM + wr * 64 + fr, col0 = u.pn * BM + wc * 32 + 8 * fq;
#pragma unroll
        for (int ai = 0; ai < 2; ++ai)
#pragma unroll
            for (int m = 0; m < 4; ++m) { bf16_t* rowp = O + (size_t)(row0 + ai * HALF + m * 16) * ldc + col0;
#pragma unroll
                for (int bj = 0; bj < 2; ++bj) *(u32x4*)(rowp + bj * HALF) = pack8(acc[ai][bj][m][0], acc[ai][bj][m][1]); }
    }
};
struct EpiSwiglu {
    static constexpr bool PERM = true, AFTER_DRAIN = false, MIDHOOK = false;
    bf16_t* H; int ldh;
    __device__ __forceinline__ void operator()(const f32x4 (&acc)[2][2][4][2], const Unit& u, int wr, int wc, int fr, int fq) const {
        const int row0 = u.pm * BM + wr * 64 + fr, col0 = u.pn * HALF + wc * 32 + 8 * fq;
#pragma unroll
        for (int ai = 0; ai < 2; ++ai)
#pragma unroll
            for (int m = 0; m < 4; ++m) { f32x4 h[2];
#pragma unroll
                for (int n = 0; n < 2; ++n) { const f32x4 g = acc[ai][0][m][n], up = acc[ai][1][m][n];
#pragma unroll
                    for (int e = 0; e < 4; ++e) h[n][e] = g[e] * fast_sigmoid(g[e]) * up[e]; }
                __builtin_nontemporal_store(pack8(h[0], h[1]), (u32x4*)(H + (size_t)(row0 + ai * HALF + m * 16) * ldh + col0)); }
    }
};
struct EpiWin {
    static constexpr bool PERM = true, AFTER_DRAIN = false, MIDHOOK = false;
    bf16_t *Q, *K, *U, *G; const float* cosT; const float* sinT; float qscale;
    __device__ __forceinline__ void operator()(const f32x4 (&acc)[2][2][4][2], const Unit& u, int wr, int wc, int fr, int fq) const {
        const int row0 = u.pm * BM + wr * 64 + fr; const int pn = u.pn;
        if (pn < 4) {
            bf16_t* base = (pn < 2) ? Q : K; const float sc = (pn < 2) ? qscale : 1.0f; const int ct = (pn & 1) * BM + wc * 32 + 8 * fq;
#pragma unroll
            for (int ai = 0; ai < 2; ++ai)
#pragma unroll
                for (int mh = 0; mh < 2; ++mh) {
                    f32x4 cs[2][2], sn[2][2];
#pragma unroll
                    for (int mm = 0; mm < 2; ++mm) { const int pos = (row0 + ai * HALF + (mh * 2 + mm) * 16) & 2047;
#pragma unroll
                        for (int n = 0; n < 2; ++n) { cs[mm][n] = *(const f32x4*)(cosT + pos * 32 + 8 * fq + 4 * n); sn[mm][n] = *(const f32x4*)(sinT + pos * 32 + 8 * fq + 4 * n); } }
#pragma unroll
                    for (int mm = 0; mm < 2; ++mm) { const int m = mh * 2 + mm; const int row = row0 + ai * HALF + m * 16;
                        f32x4 o1[2], o2[2];
#pragma unroll
                        for (int n = 0; n < 2; ++n) { const f32x4 x1 = acc[ai][0][m][n], x2 = acc[ai][1][m][n];
                            o1[n] = (x1 * cs[mm][n] - x2 * sn[mm][n]) * sc; o2[n] = (x1 * sn[mm][n] + x2 * cs[mm][n]) * sc; }
                        bf16_t* rowp = base + (size_t)row * 512 + ct;
                        *(u32x4*)(rowp) = pack8(o1[0], o1[1]); *(u32x4*)(rowp + HALF) = pack8(o2[0], o2[1]); }
                    asm volatile("" ::: "memory"); }
        } else if (pn < 6) {
            const int col0 = (pn - 4) * BM + wc * 32 + 8 * fq;
#pragma unroll
            for (int ai = 0; ai < 2; ++ai)
#pragma unroll
                for (int m = 0; m < 4; ++m) { bf16_t* rowp = U + (size_t)(row0 + ai * HALF + m * 16) * 512 + col0;
#pragma unroll
                    for (int bj = 0; bj < 2; ++bj) *(u32x4*)(rowp + bj * HALF) = pack8(acc[ai][bj][m][0], acc[ai][bj][m][1]); }
        } else {
            const int col0 = (pn - 6) * BM + wc * 32 + 8 * fq;
#pragma unroll
            for (int ai = 0; ai < 2; ++ai)
#pragma unroll
                for (int m = 0; m < 4; ++m) { bf16_t* rowp = G + (size_t)(row0 + ai * HALF + m * 16) * 2048 + col0;
                    f32x4 rt[2], gp[2];
#pragma unroll
                    for (int n = 0; n < 2; ++n)
#pragma unroll
                        for (int e = 0; e < 4; ++e) { const float ea = 1.0f + __builtin_amdgcn_exp2f(acc[ai][0][m][n][e] * -1.4426950408889634f), ep = fminf(1.0f + __builtin_amdgcn_exp2f(acc[ai][1][m][n][e] * -1.4426950408889634f), 1e30f);
                            gp[n][e] = __builtin_amdgcn_rcpf(ep); rt[n][e] = ep * __builtin_amdgcn_rcpf(ea); }
                    __builtin_nontemporal_store(pack8(rt[0], rt[1]), (u32x4*)(rowp)); __builtin_nontemporal_store(pack8(gp[0], gp[1]), (u32x4*)(rowp + HALF)); }
        }
    }
};
struct EpiResid {
    static constexpr bool PERM = true, AFTER_DRAIN = false, MIDHOOK = false;
    const float* X; bf16_t* Y; float alpha, sc;
    __device__ __forceinline__ void operator()(const f32x4 (&acc)[2][2][4][2], const Unit& u, int wr, int wc, int fr, int fq) const {
        const int row0 = u.pm * BM + wr * 64 + fr, col0 = u.pn * BM + wc * 32 + 8 * fq;
#pragma unroll
        for (int ai = 0; ai < 2; ++ai)
#pragma unroll
            for (int mh = 0; mh < 2; ++mh) {
                f32x4 xr[2][2][2];
#pragma unroll
                for (int mm = 0; mm < 2; ++mm)
#pragma unroll
                    for (int bj = 0; bj < 2; ++bj)
#pragma unroll
                        for (int n = 0; n < 2; ++n) xr[mm][bj][n] = *(const f32x4*)(X + (size_t)(row0 + ai * HALF + (mh * 2 + mm) * 16) * 1024 + col0 + bj * HALF + 4 * n);
#pragma unroll
                for (int mm = 0; mm < 2; ++mm) { const int m = mh * 2 + mm; const size_t off = (size_t)(row0 + ai * HALF + m * 16) * 1024 + col0;
#pragma unroll
                    for (int bj = 0; bj < 2; ++bj) *(u32x4*)(Y + off + bj * HALF) = pack8(xr[mm][bj][0] * alpha + acc[ai][bj][m][0] * sc, xr[mm][bj][1] * alpha + acc[ai][bj][m][1] * sc); }
                asm volatile("" ::: "memory"); }
    }
};
struct EpiGate1 {
    static constexpr bool PERM = true, AFTER_DRAIN = false, MIDHOOK = false;
    const bf16_t* G; float* T;
    __device__ __forceinline__ void operator()(const f32x4 (&acc)[2][2][4][2], const Unit& u, int wr, int wc, int fr, int fq) const {
        const int row0 = u.pm * BM + wr * 64 + fr, col0 = u.pn * BM + wc * 32 + 8 * fq;
#pragma unroll
        for (int ai = 0; ai < 2; ++ai)
#pragma unroll
            for (int m = 0; m < 4; ++m) { const size_t row = (size_t)(row0 + ai * HALF + m * 16);
#pragma unroll
                for (int bj = 0; bj < 2; ++bj) { f32x4 ga, gb; unpack8(*(const u32x4*)(G + row * 2048 + col0 + bj * HALF), ga, gb);
                    float* tp = T + row * 1024 + col0 + bj * HALF;
                    *(f32x4*)(tp) = ga * acc[ai][bj][m][0]; *(f32x4*)(tp + 4) = gb * acc[ai][bj][m][1]; }
                asm volatile("" ::: "memory"); }
    }
};
struct EpiGate2 {
    static constexpr bool PERM = true, AFTER_DRAIN = false, MIDHOOK = false;
    const bf16_t* G; const float* T; bf16_t* Mg;
    __device__ __forceinline__ void operator()(const f32x4 (&acc)[2][2][4][2], const Unit& u, int wr, int wc, int fr, int fq) const {
        const int row0 = u.pm * BM + wr * 64 + fr, col0 = u.pn * BM + wc * 32 + 8 * fq;
#pragma unroll
        for (int ai = 0; ai < 2; ++ai)
#pragma unroll
            for (int m = 0; m < 4; ++m) { const size_t row = (size_t)(row0 + ai * HALF + m * 16);
#pragma unroll
                for (int bj = 0; bj < 2; ++bj) { f32x4 ga, gb; unpack8(*(const u32x4*)(G + row * 2048 + 1024 + col0 + bj * HALF), ga, gb);
                    const float* tp = T + row * 1024 + col0 + bj * HALF;
                    const f32x4 t0 = *(const f32x4*)(tp), t1 = *(const f32x4*)(tp + 4);
                    *(u32x4*)(Mg + row * 1024 + col0 + bj * HALF) = pack8(t0 + ga * acc[ai][bj][m][0], t1 + gb * acc[ai][bj][m][1]); }
                asm volatile("" ::: "memory"); }
    }
};
struct EpiVT {
    static constexpr bool PERM = true, AFTER_DRAIN = false, MIDHOOK = false;
    bf16_t* O;
    __device__ __forceinline__ void operator()(const f32x4 (&acc)[2][2][4][2], const Unit& u, int wr, int wc, int fr, int fq) const {
        const int row0 = u.pm * BM + wr * 64 + fr, col0 = u.pn * BM + wc * 32 + 8 * fq;
#pragma unroll
        for (int ai = 0; ai < 2; ++ai)
#pragma unroll
            for (int m = 0; m < 4; ++m) { const int vcol = row0 + ai * HALF + m * 16, h = vcol >> 7, e = vcol & 127;
#pragma unroll
                for (int bj = 0; bj < 2; ++bj) { const int tok = col0 + bj * HALF, b = tok >> 11, sq = tok & 2047, kt = sq >> 6, key = sq & 63;
                    *(u32x4*)(O + ((size_t)(((b * 4 + h) * 32 + kt) * 128 + e)) * 64 + key) = pack8(acc[ai][bj][m][0], acc[ai][bj][m][1]); } }
    }
};
struct EpiGateMid {
    static constexpr bool PERM = true, AFTER_DRAIN = false, MIDHOOK = true;
    const bf16_t* G; bf16_t* Mg;
    __device__ __forceinline__ void mid(f32x4 (&acc)[2][2][4][2], const Unit& u, int wr, int wc, int fr, int fq) const {
        int row0 = u.pm * BM + wr * 64 + fr, gc0 = u.pn * 512 + wc * 32 + 8 * fq;
        asm volatile("" : "+v"(row0), "+v"(gc0));
#pragma unroll
        for (int ai = 0; ai < 2; ++ai) {
            u32x4 rt[4][2];
#pragma unroll
            for (int m = 0; m < 4; ++m)
#pragma unroll
                for (int bj = 0; bj < 2; ++bj) rt[m][bj] = *(const u32x4*)(G + (size_t)(row0 + ai * HALF + m * 16) * 2048 + gc0 + bj * 256);
#pragma unroll
            for (int m = 0; m < 4; ++m)
#pragma unroll
                for (int bj = 0; bj < 2; ++bj) { f32x4 r0, r1; unpack8(rt[m][bj], r0, r1); acc[ai][bj][m][0] *= r0; acc[ai][bj][m][1] *= r1; }
            asm volatile("" ::: "memory"); }
    }
    __device__ __forceinline__ void operator()(const f32x4 (&acc)[2][2][4][2], const Unit& u, int wr, int wc, int fr, int fq) const {
        const int row0 = u.pm * BM + wr * 64 + fr, col0 = u.pn * BM + wc * 32 + 8 * fq, gc0 = u.pn * 512 + wc * 32 + 8 * fq + 128;
#pragma unroll
        for (int ai = 0; ai < 2; ++ai) {
            u32x4 gp[4][2];
#pragma unroll
            for (int m = 0; m < 4; ++m)
#pragma unroll
                for (int bj = 0; bj < 2; ++bj) gp[m][bj] = *(const u32x4*)(G + (size_t)(row0 + ai * HALF + m * 16) * 2048 + gc0 + bj * 256);
#pragma unroll
            for (int m = 0; m < 4; ++m) { const size_t row = (size_t)(row0 + ai * HALF + m * 16);
#pragma unroll
                for (int bj = 0; bj < 2; ++bj) { f32x4 p0, p1; unpack8(gp[m][bj], p0, p1);
                    *(u32x4*)(Mg + row * 1024 + col0 + bj * HALF) = pack8(acc[ai][bj][m][0] * p0, acc[ai][bj][m][1] * p1); } }
            asm volatile("" ::: "memory"); }
    }
};
struct EpiResidB {
    static constexpr bool PERM = true, AFTER_DRAIN = false, MIDHOOK = false;
    const bf16_t* X; bf16_t* Y; float alpha, sc;
    __device__ __forceinline__ void operator()(const f32x4 (&acc)[2][2][4][2], const Unit& u, int wr, int wc, int fr, int fq) const {
        const int row0 = u.pm * BM + wr * 64 + fr, col0 = u.pn * BM + wc * 32 + 8 * fq;
#pragma unroll
        for (int ai = 0; ai < 2; ++ai) {
            u32x4 xr[4][2];
#pragma unroll
            for (int m = 0; m < 4; ++m)
#pragma unroll
                for (int bj = 0; bj < 2; ++bj) xr[m][bj] = *(const u32x4*)(X + (size_t)(row0 + ai * HALF + m * 16) * 1024 + col0 + bj * HALF);
#pragma unroll
            for (int m = 0; m < 4; ++m) { const size_t off = (size_t)(row0 + ai * HALF + m * 16) * 1024 + col0;
#pragma unroll
                for (int bj = 0; bj < 2; ++bj) { f32x4 x0, x1; unpack8(xr[m][bj], x0, x1);
                    *(u32x4*)(Y + off + bj * HALF) = pack8(x0 * alpha + acc[ai][bj][m][0] * sc, x1 * alpha + acc[ai][bj][m][1] * sc); } }
            asm volatile("" ::: "memory"); }
    }
};
template <class Epi, class Sched, bool ALIGN_EPI = false, bool SP2 = false>
__device__ __forceinline__ void gemm_phase(PG8_LAS unsigned char* lds, const Gemm g, const Sched& S, const Epi& E) {
    int tid_ = threadIdx.x; asm volatile("" : "+v"(tid_));
    const int tid = tid_, wid = __builtin_amdgcn_readfirstlane(tid >> 6), lane = tid & 63, wr = wid >> 2, wc = wid & 3, fr = lane & 15, fq = lane >> 4;
    const int K = g.K, nt = K / BK;
    unsigned voffA[2], voffB[2];
#pragma unroll
    for (int i = 0; i < 2; ++i) { int R, C; stage_rc(tid * 16 + i * 8192, R, C); const int Rb = Epi::PERM ? ((R & ~31) + perm32(R & 31)) : R;
        voffA[i] = (unsigned)(R * K + C) * 2u; voffB[i] = (unsigned)(Rb * K + C) * 2u; }
    const size_t kstep = (size_t)(BK * 2);
    const size_t hstep = (size_t)HALF * K * 2;
    const size_t tstep = 2 * hstep;
    const unsigned ldsw = (unsigned)wid * 1024u;
    const int aoff = lds_byte(wr * 64 + fr, fq * 8), boff = lds_byte(wc * 32 + fr, fq * 8);
#define PG8_SA(b, h) (((b) * 2 + (h)) * HTB)
#define PG8_SB(b, h) ((4 + (b) * 2 + (h)) * HTB)
#define PG8_STAGE(bufoff, gbase, voff) do { _Pragma("unroll") for (int _i = 0; _i < 2; ++_i) \
        __builtin_amdgcn_global_load_lds((const unsigned*)((const char*)(gbase) + (voff)[_i]), (PG8_LAS unsigned*)(lds + (bufoff) + ldsw + _i * 8192), 16, 0, 0); } while (0)
#define PG8_LDA(dst, b, h) do { _Pragma("unroll") for (int m = 0; m < 4; ++m) _Pragma("unroll") for (int k = 0; k < 2; ++k) dst[m][k] = *(const PG8_LAS bf16x8*)(lds + PG8_SA(b, h) + aoff + m * 2048 + k * 1024); } while (0)
#define PG8_LDB(dst, b, h) do { _Pragma("unroll") for (int n = 0; n < 2; ++n) _Pragma("unroll") for (int k = 0; k < 2; ++k) dst[n][k] = *(const PG8_LAS bf16x8*)(lds + PG8_SB(b, h) + boff + n * 2048 + k * 1024); } while (0)
#define PG8_MMA(ai, bj, At, Bt) do { __builtin_amdgcn_s_setprio(1); _Pragma("unroll") for (int m = 0; m < 4; ++m) _Pragma("unroll") for (int n = 0; n < 2; ++n) _Pragma("unroll") for (int k = 0; k < 2; ++k) \
        acc[ai][bj][m][n] = __builtin_amdgcn_mfma_f32_16x16x32_bf16(Bt[n][k], At[m][k], acc[ai][bj][m][n], 0, 0, 0); __builtin_amdgcn_s_setprio(0); } while (0)
#define PG8_WAIT_V(n) asm volatile("s_waitcnt vmcnt(" #n ")" ::: "memory")
#define PG8_WAIT_L(n) asm volatile("s_waitcnt lgkmcnt(" #n ")" ::: "memory")
#define PG8_BAR __builtin_amdgcn_s_barrier()
#define PG8_SCHED __builtin_amdgcn_sched_barrier(0)
    Unit cur, nxt; int ui = 0;
    if (!S.next(0, cur)) return;
    f32x4 acc[2][2][4][2];
#pragma unroll
    for (int a = 0; a < 2; ++a)
#pragma unroll
        for (int b = 0; b < 2; ++b)
#pragma unroll
            for (int m = 0; m < 4; ++m)
#pragma unroll
                for (int n = 0; n < 2; ++n) acc[a][b][m][n] = (f32x4){0.f, 0.f, 0.f, 0.f};
    bf16x8 At[4][2], B0[2][2], B1[2][2];
    const char* cA = (const char*)g.A + (size_t)cur.pm * tstep; const char* cB = (const char*)g.Bt + (size_t)cur.pn * tstep;
    S.a_ready(cur);
    if constexpr (SP2) {
        PG8_STAGE(PG8_SB(0, 0), cB, voffB); PG8_STAGE(PG8_SB(0, 1), cB + hstep, voffB); PG8_STAGE(PG8_SA(0, 0), cA, voffA); PG8_STAGE(PG8_SA(0, 1), cA + hstep, voffA);
        if (wr == 1) PG8_BAR;
        PG8_WAIT_V(2); PG8_BAR;
        PG8_STAGE(PG8_SB(1, 0), cB + kstep, voffB); PG8_STAGE(PG8_SA(1, 0), cA + kstep, voffA); PG8_STAGE(PG8_SB(1, 1), cB + hstep + kstep, voffB);
        PG8_WAIT_V(6); PG8_BAR;
    } else {
        PG8_STAGE(PG8_SB(0, 0), cB, voffB); PG8_STAGE(PG8_SA(0, 0), cA, voffA); PG8_STAGE(PG8_SB(0, 1), cB + hstep, voffB); PG8_STAGE(PG8_SA(0, 1), cA + hstep, voffA);
        if (wr == 1) PG8_BAR;
        PG8_WAIT_V(4); PG8_BAR;
        PG8_STAGE(PG8_SB(1, 0), cB + kstep, voffB); PG8_STAGE(PG8_SA(1, 0), cA + kstep, voffA); PG8_STAGE(PG8_SB(1, 1), cB + hstep + kstep, voffB);
        PG8_WAIT_V(6); PG8_BAR;
    }
    for (;;) {
        const bool has_next = S.next(ui + 1, nxt);
        const char* nA = has_next ? (const char*)g.A + (size_t)nxt.pm * tstep : cA; const char* nB = has_next ? (const char*)g.Bt + (size_t)nxt.pn * tstep : cB;
#pragma unroll 1
        for (int t = 0; t < nt; t += 2) {
            if constexpr (Epi::MIDHOOK) { if (t == nt / 2) E.mid(acc, cur, wr, wc, fr, fq); }
            const bool last = (t == nt - 2);
            const char* a1 = cA + (size_t)(t + 1) * kstep;
            const char* a2 = last ? nA : cA + (size_t)(t + 2) * kstep; const char* b2 = last ? nB : cB + (size_t)(t + 2) * kstep;
            const char* a3 = a2 + kstep; const char* b3 = b2 + kstep;
            if (last && has_next) S.a_ready(nxt);
            if constexpr (SP2) {
            PG8_LDB(B0, 0, 0); PG8_LDB(B1, 0, 1); PG8_SCHED; PG8_LDA(At, 0, 0); PG8_STAGE(PG8_SA(1, 1), a1 + hstep, voffA);
            PG8_WAIT_V(8); PG8_WAIT_L(0); PG8_BAR; PG8_MMA(0, 0, At, B0); PG8_MMA(0, 1, At, B1); PG8_BAR; PG8_SCHED;
            PG8_LDA(At, 0, 1); PG8_STAGE(PG8_SB(0, 0), b2, voffB); PG8_STAGE(PG8_SB(0, 1), b2 + hstep, voffB); PG8_STAGE(PG8_SA(0, 0), a2, voffA);
            PG8_WAIT_V(8); PG8_WAIT_L(0); PG8_BAR; PG8_MMA(1, 0, At, B0); PG8_MMA(1, 1, At, B1); PG8_BAR; PG8_SCHED;
            PG8_LDB(B0, 1, 0); PG8_LDB(B1, 1, 1); PG8_SCHED; PG8_LDA(At, 1, 0); PG8_STAGE(PG8_SA(0, 1), a2 + hstep, voffA);
            PG8_WAIT_V(8); PG8_WAIT_L(0); PG8_BAR; PG8_MMA(0, 0, At, B0); PG8_MMA(0, 1, At, B1); PG8_BAR; PG8_SCHED;
            PG8_LDA(At, 1, 1); PG8_STAGE(PG8_SB(1, 0), b3, voffB); PG8_STAGE(PG8_SB(1, 1), b3 + hstep, voffB); PG8_STAGE(PG8_SA(1, 0), a3, voffA);
            PG8_WAIT_V(8); PG8_WAIT_L(0); PG8_BAR; PG8_MMA(1, 0, At, B0); PG8_MMA(1, 1, At, B1); PG8_BAR; PG8_SCHED;
            } else {
            PG8_LDB(B0, 0, 0); PG8_SCHED; PG8_LDA(At, 0, 0); PG8_STAGE(PG8_SA(1, 1), a1 + hstep, voffA);
            PG8_WAIT_L(8); PG8_BAR; PG8_WAIT_L(0); PG8_MMA(0, 0, At, B0); PG8_BAR; PG8_SCHED;
            PG8_LDB(B1, 0, 1); PG8_STAGE(PG8_SB(0, 0), b2, voffB);
            PG8_BAR; PG8_WAIT_L(0); PG8_MMA(0, 1, At, B1); PG8_BAR;
            PG8_LDA(At, 0, 1); PG8_STAGE(PG8_SA(0, 0), a2, voffA);
            PG8_BAR; PG8_WAIT_L(0); PG8_MMA(1, 0, At, B0); PG8_BAR; PG8_SCHED;
            PG8_STAGE(PG8_SB(0, 1), b2 + hstep, voffB);
            PG8_WAIT_V(6); PG8_BAR; PG8_MMA(1, 1, At, B1); PG8_BAR;
            PG8_LDB(B0, 1, 0); PG8_SCHED; PG8_LDA(At, 1, 0); PG8_STAGE(PG8_SA(0, 1), a2 + hstep, voffA);
            PG8_WAIT_L(8); PG8_BAR; PG8_WAIT_L(0); PG8_MMA(0, 0, At, B0); PG8_BAR; PG8_SCHED;
            PG8_LDB(B1, 1, 1); PG8_STAGE(PG8_SB(1, 0), b3, voffB);
            PG8_BAR; PG8_WAIT_L(0); PG8_MMA(0, 1, At, B1); PG8_BAR;
            PG8_LDA(At, 1, 1); PG8_STAGE(PG8_SA(1, 0), a3, voffA);
            PG8_BAR; PG8_WAIT_L(0); PG8_MMA(1, 0, At, B0); PG8_BAR; PG8_SCHED;
            PG8_STAGE(PG8_SB(1, 1), b3 + hstep, voffB);
            PG8_WAIT_V(6); PG8_BAR; PG8_MMA(1, 1, At, B1); PG8_BAR;
            }
        }
        if constexpr (ALIGN_EPI) { if (wr == 0) PG8_BAR; }
        if constexpr (!Epi::AFTER_DRAIN) { E(acc, cur, wr, wc, fr, fq); S.done(cur); }
        if (!has_next) break;
#pragma unroll
        for (int a = 0; a < 2; ++a)
#pragma unroll
            for (int b = 0; b < 2; ++b)
#pragma unroll
                for (int m = 0; m < 4; ++m)
#pragma unroll
                    for (int n = 0; n < 2; ++n) acc[a][b][m][n] = (f32x4){0.f, 0.f, 0.f, 0.f};
        cur = nxt; cA = nA; cB = nB; ++ui;
        if constexpr (ALIGN_EPI) { if (wr == 1) PG8_BAR; }
    }
    PG8_WAIT_V(0);
    if constexpr (!ALIGN_EPI) { if (wr == 0) PG8_BAR; }
    PG8_BAR;
    if constexpr (Epi::AFTER_DRAIN) { E.fused(acc, cur, wr, wc, fr, fq, lds, wid, lane); S.done(cur); }
#undef PG8_SA
#undef PG8_SB
#undef PG8_STAGE
#undef PG8_LDA
#undef PG8_LDB
#undef PG8_MMA
#undef PG8_WAIT_V
#undef PG8_WAIT_L
#undef PG8_BAR
#undef PG8_SCHED
}
}

#define LAS __attribute__((address_space(3)))
typedef unsigned short bf16;
typedef float f32x4 __attribute__((ext_vector_type(4)));
typedef float f32x16 __attribute__((ext_vector_type(16)));
typedef short bf16x8 __attribute__((ext_vector_type(8)));
typedef unsigned u32x4 __attribute__((ext_vector_type(4)));
typedef unsigned u32x2 __attribute__((ext_vector_type(2)));

constexpr int NTOK = 65536, DM = 1024, DFF = 2816, SEQ = 2048, NBATCH = 32;
constexpr int NPAN = NTOK / 256;
constexpr float LN_EPS = 1e-5f, RMS_EPS = 1e-5f;
constexpr float DN_ALPHA = 1.189207115002721f;
constexpr float LAMBDA_INIT = 0.2f;
constexpr float QSCALE = 0.125f * 1.4426950408889634f;

constexpr size_t MiB = 1u << 20;
constexpr size_t WS_WGU1 = 0, WS_WD1 = 11 * MiB, WS_WIN = 17 * MiB, WS_WBA = 25 * MiB, WS_WBP = 26 * MiB, WS_WOUT = 27 * MiB, WS_WGU2 = 29 * MiB, WS_WD2 = 40 * MiB;
constexpr size_t WS_COS = 46 * MiB, WS_SIN = 46 * MiB + 256 * 1024;
constexpr size_t WS_XB = 48 * MiB;
constexpr size_t WS_YATT = WS_XB, WS_POOL = WS_XB + 64 * MiB;
constexpr size_t WS_X1F = 176 * MiB;
constexpr size_t WS_R1 = 432 * MiB;
constexpr size_t WS_Q = WS_R1, WS_K = WS_R1 + 64 * MiB, WS_VT = WS_R1 + 128 * MiB, WS_U = WS_R1 + 192 * MiB;
constexpr size_t WS_R2 = 784 * MiB;
constexpr size_t WS_O1S = 912 * MiB;
constexpr size_t WS_BAR = 944 * MiB;
constexpr size_t WS_END = 976 * MiB;
constexpr int LDS_BYTES = 139264;

__device__ __forceinline__ unsigned f2bf(float f) { unsigned u = __builtin_bit_cast(unsigned, f); return (u + 0x7fffu + ((u >> 16) & 1u)) >> 16; }
__device__ __forceinline__ unsigned pk2(float lo, float hi) { return f2bf(lo) | (f2bf(hi) << 16); }
__device__ __forceinline__ float wave_sum(float v) {
#pragma unroll
    for (int o = 1; o < 64; o <<= 1) v += __shfl_xor(v, o);
    return v;
}
__device__ __forceinline__ float swap_max(float m) { auto rr = __builtin_amdgcn_permlane32_swap(__float_as_uint(m), __float_as_uint(m), false, false); return fmaxf(__uint_as_float(rr[0]), __uint_as_float(rr[1])); }
__device__ __forceinline__ float swap_sum(float m) { auto rr = __builtin_amdgcn_permlane32_swap(__float_as_uint(m), __float_as_uint(m), false, false); return __uint_as_float(rr[0]) + __uint_as_float(rr[1]); }

struct MapOff { int off; __device__ __forceinline__ int operator()(int n) const { return off + n; } };
struct MapGateUp { int half; __device__ __forceinline__ int operator()(int n) const { return 256 * (n >> 7) + (n & 127) + 128 * half; } };
struct MapWin { __device__ __forceinline__ int operator()(int n) const {
    if (n < 1024) { const int t = n >> 8, r = n & 255, s = r >> 6, w = r & 63, hf = w >> 5, i = w & 31; return 256 * t + 128 * hf + 32 * s + i; }
    if (n < 1536) return 3584 + (n - 1024);
    if (n < 2048) return 1024 + (n - 1536);
    { const int c = n - 2048, br = c >> 10, j = c & 1023; return 1536 + 256 * (j >> 7) + 128 * br + (j & 127); } } };
template <class MAP>
__device__ __forceinline__ void transpose_item(const float* __restrict__ W, int K, int N, bf16* __restrict__ WT, const MAP map, LAS float* scr, int item, int lane, int ldw = 0) {
    if (ldw == 0) ldw = K;
    const int nblk = N / 32, kb = item / nblk, nb = item % nblk, k0 = 64 * kb, n0 = 32 * nb;
#pragma unroll 8
    for (int i = 0; i < 32; ++i) { const int kk = 2 * i + (lane >> 5); scr[kk * 33 + (lane & 31)] = W[(size_t)(k0 + kk) * N + n0 + (lane & 31)]; }
    asm volatile("s_waitcnt lgkmcnt(0)" ::: "memory");
    const int c = lane & 7;
#pragma unroll
    for (int j = 0; j < 4; ++j) { const int n = (lane >> 3) + 8 * j; const LAS float* s = scr + (8 * c) * 33 + n;
        u32x4 o; o.x = pk2(s[0 * 33], s[1 * 33]); o.y = pk2(s[2 * 33], s[3 * 33]); o.z = pk2(s[4 * 33], s[5 * 33]); o.w = pk2(s[6 * 33], s[7 * 33]);
        *(u32x4*)(WT + (size_t)map(n0 + n) * ldw + k0 + 8 * c) = o; }
    asm volatile("s_waitcnt lgkmcnt(0)" ::: "memory");
}

#define XB_TMO      128
#define XB_XCNT(j)  (256  + 64 * (j))
#define XB_XSUB(j)  (1280 + 64 * (j))
#define XB_XGEN(j)  (2304 + 64 * (j))
#define XB_TOP      3328
#define XB_TOPGEN   3392
#define XCD_BAR_WORDS 3456
#define XB_SPIN_CAP (1u << 18)

__device__ __forceinline__ unsigned xb_ld(unsigned* p)              { return __hip_atomic_load(p, __ATOMIC_RELAXED, __HIP_MEMORY_SCOPE_AGENT); }
__device__ __forceinline__ unsigned xb_add(unsigned* p, unsigned v) { return __hip_atomic_fetch_add(p, v, __ATOMIC_RELAXED, __HIP_MEMORY_SCOPE_AGENT); }
__device__ __forceinline__ unsigned xb_xcc_id() { return (unsigned)__builtin_amdgcn_s_getreg((3 << 11) | 20) & 0xFu; }
#define XB_SPIN(cond, bar) do { unsigned _sp = 0; while (cond) { __builtin_amdgcn_s_sleep(1); \
    if ((++_sp & 255u) == 0u) { if (xb_ld(&(bar)[XB_TMO])) break; if (_sp > XB_SPIN_CAP) { atomicAdd(&(bar)[XB_TMO], 1u); break; } } } } while (0)

struct XcdBarrier {
    unsigned* bar; unsigned x;
    volatile LAS unsigned* st;
};

__device__ __forceinline__ XcdBarrier xcd_barrier_post(unsigned* bar, volatile LAS unsigned* st) {
    XcdBarrier b; b.bar = bar; b.x = xb_xcc_id(); b.st = st;
    if (threadIdx.x == 0) (void)xb_add(&bar[XB_XCNT(b.x)], 1u);
    return b;
}
__device__ __forceinline__ void xcd_barrier_complete(unsigned* bar, unsigned x, unsigned& nloc, unsigned& nx) {
    const unsigned G = gridDim.x * gridDim.y * gridDim.z;
    unsigned sum, cnt, mine, sp = 0u;
    for (;;) {
        sum = 0u; cnt = 0u; mine = 0u;
#pragma unroll
        for (unsigned j = 0; j < 16; ++j) { const unsigned c = xb_ld(&bar[XB_XCNT(j)]); sum += c; cnt += (c > 0u) ? 1u : 0u; mine = (j == x) ? c : mine; }
        if (sum == G) break;
        __builtin_amdgcn_s_sleep(1);
        if ((++sp & 255u) == 0u) { if (xb_ld(&bar[XB_TMO])) break; if (sp > XB_SPIN_CAP) { atomicAdd(&bar[XB_TMO], 1u); break; } }
    }
    nloc = mine > 0u ? mine : 1u; nx = cnt > 0u ? cnt : 1u;
}

__device__ __forceinline__ void xcd_barrier(const XcdBarrier& b) {
    asm volatile("s_waitcnt vmcnt(0)" ::: "memory");
    __syncthreads();
    if (threadIdx.x == 0) {
        unsigned* bar = b.bar;
        __builtin_amdgcn_s_waitcnt(0);
        unsigned nloc = b.st[0], nx = b.st[1];
        if (nloc == 0u) { xcd_barrier_complete(bar, b.x, nloc, nx); b.st[0] = nloc; b.st[1] = nx; }
        const unsigned old = xb_add(&bar[XB_XSUB(b.x)], 1u);
        const unsigned gen = old / nloc;
        if (old + 1u == (gen + 1u) * nloc) {
            __builtin_amdgcn_fence(__ATOMIC_RELEASE, "agent");
            asm volatile("s_waitcnt vmcnt(0)" ::: "memory");
            const unsigned og = xb_add(&bar[XB_TOP], 1u);
            const unsigned tg = og / nx;
            if (og + 1u == (tg + 1u) * nx) xb_add(&bar[XB_TOPGEN], 1u);
            else XB_SPIN(xb_ld(&bar[XB_TOPGEN]) == tg, bar);
            __builtin_amdgcn_fence(__ATOMIC_ACQUIRE, "agent");
            xb_add(&bar[XB_XGEN(b.x)], 1u);
            asm volatile("s_waitcnt vmcnt(0)" ::: "memory");
        } else {
            XB_SPIN(xb_ld(&bar[XB_XGEN(b.x)]) == gen, bar);
            __builtin_amdgcn_fence(__ATOMIC_ACQUIRE, "agent");
            asm volatile("s_waitcnt vmcnt(0)" ::: "memory");
        }
    }
    __syncthreads();
}

struct Args { const float* in[24]; float* out; unsigned char* ws; int ph_lo, ph_hi, rep_mask, pad; };

__device__ __forceinline__ void ln_panel(const bf16* Y, float* Xf, bf16* Xb, const float* g, const float* bta, int pm, int wid, int lane) {
    asm volatile("" : "+s"(g), "+s"(bta));
    f32x4 gv[4], bv[4];
#pragma unroll
    for (int j = 0; j < 2; ++j)
#pragma unroll
        for (int n = 0; n < 2; ++n) { gv[2 * j + n] = *(const f32x4*)(g + 8 * lane + 512 * j + 4 * n); bv[2 * j + n] = *(const f32x4*)(bta + 8 * lane + 512 * j + 4 * n); }
    constexpr int RB = 4;
#pragma unroll 1
    for (int r = 0; r < 32; r += RB) {
        const size_t row0 = (size_t)pm * 256 + wid * 32 + r;
        u32x4 raw[RB][2]; f32x4 v[RB][4]; float s[RB];
#pragma unroll
        for (int q = 0; q < RB; ++q)
#pragma unroll
            for (int j = 0; j < 2; ++j) raw[q][j] = *(const u32x4*)(Y + (row0 + q) * 1024 + 8 * lane + 512 * j);
#pragma unroll
        for (int q = 0; q < RB; ++q) { s[q] = 0.f;
#pragma unroll
            for (int j = 0; j < 2; ++j) pg8::unpack8(raw[q][j], v[q][2 * j], v[q][2 * j + 1]);
#pragma unroll
            for (int j = 0; j < 4; ++j) s[q] += (v[q][j][0] + v[q][j][1]) + (v[q][j][2] + v[q][j][3]); }
#pragma unroll
        for (int o = 1; o < 64; o <<= 1)
#pragma unroll
            for (int q = 0; q < RB; ++q) s[q] += __shfl_xor(s[q], o);
        float s2[RB];
#pragma unroll
        for (int q = 0; q < RB; ++q) { const float mean = s[q] * (1.0f / 1024.0f); s2[q] = 0.f;
#pragma unroll
            for (int j = 0; j < 4; ++j) { v[q][j] = v[q][j] - mean; s2[q] += (v[q][j][0] * v[q][j][0] + v[q][j][1] * v[q][j][1]) + (v[q][j][2] * v[q][j][2] + v[q][j][3] * v[q][j][3]); } }
#pragma unroll
        for (int o = 1; o < 64; o <<= 1)
#pragma unroll
            for (int q = 0; q < RB; ++q) s2[q] += __shfl_xor(s2[q], o);
#pragma unroll
        for (int q = 0; q < RB; ++q) { const float rstd = 1.0f / sqrtf(s2[q] * (1.0f / 1024.0f) + LN_EPS); const size_t row = row0 + q;
#pragma unroll
            for (int j = 0; j < 2; ++j) { const f32x4 o0 = v[q][2 * j] * rstd * gv[2 * j] + bv[2 * j], o1 = v[q][2 * j + 1] * rstd * gv[2 * j + 1] + bv[2 * j + 1];
                if (Xf) { *(f32x4*)(Xf + row * 1024 + 8 * lane + 512 * j) = o0; *(f32x4*)(Xf + row * 1024 + 8 * lane + 512 * j + 4) = o1; }
                if (Xb) *(u32x4*)(Xb + row * 1024 + 8 * lane + 512 * j) = pg8::pack8(o0, o1); } }
    }
}

struct AttnState { float mrun, l; };
#define DSR128(dst, addr, off) asm volatile("ds_read_b128 %0, %1 offset:%2" : "=&v"(dst) : "v"(addr), "i"(off))
template <bool FIRST, bool HAS_PREV>
__device__ __forceinline__ void attn_step(f32x16& c0, f32x16& c1, f32x16 (&o)[4], bf16x8 (&pbp)[4], const bf16x8 (&qr)[4], AttnState& st,
                                          const LAS unsigned char* kfr, const LAS unsigned char* vfr, const int (&kofs)[4], const int (&vofs)[4]) {
    const unsigned kb_ = (unsigned)(unsigned long)kfr, vb_ = (unsigned)(unsigned long)vfr;
    unsigned ka[4], va[4];
#pragma unroll
    for (int k = 0; k < 4; ++k) { ka[k] = kb_ + (unsigned)kofs[k]; va[k] = vb_ + (unsigned)vofs[k]; }
    bf16x8 kf[4], vA[4], vB[4];
    { const float nm = FIRST ? 0.f : -st.mrun;
#pragma unroll
      for (int i = 0; i < 16; ++i) { c0[i] = nm; c1[i] = nm; } }
#pragma unroll
    for (int ks = 0; ks < 2; ++ks) { DSR128(kf[2 * ks], ka[ks], 0); DSR128(kf[2 * ks + 1], ka[ks], 4096); }
    asm volatile("s_waitcnt lgkmcnt(0)" : "+v"(kf[0]), "+v"(kf[1]), "+v"(kf[2]), "+v"(kf[3]));
#pragma unroll
    for (int ks = 0; ks < 2; ++ks) {
        c0 = __builtin_amdgcn_mfma_f32_32x32x16_bf16(kf[2 * ks], qr[ks], c0, 0, 0, 0);
        c1 = __builtin_amdgcn_mfma_f32_32x32x16_bf16(kf[2 * ks + 1], qr[ks], c1, 0, 0, 0);
    }
    __builtin_amdgcn_sched_barrier(0);
    { bf16x8 kg[4];
#pragma unroll
      for (int ks = 0; ks < 2; ++ks) { DSR128(kg[2 * ks], ka[2 + ks], 0); DSR128(kg[2 * ks + 1], ka[2 + ks], 4096); }
      asm volatile("s_waitcnt lgkmcnt(0)" : "+v"(kg[0]), "+v"(kg[1]), "+v"(kg[2]), "+v"(kg[3]));
#pragma unroll
      for (int ks = 0; ks < 2; ++ks) {
          c0 = __builtin_amdgcn_mfma_f32_32x32x16_bf16(kg[2 * ks], qr[2 + ks], c0, 0, 0, 0);
          c1 = __builtin_amdgcn_mfma_f32_32x32x16_bf16(kg[2 * ks + 1], qr[2 + ks], c1, 0, 0, 0);
      } }
    __builtin_amdgcn_sched_barrier(0);
    if (HAS_PREV) {
#pragma unroll
        for (int e = 0; e < 4; ++e) DSR128(vA[e], va[0], e * 4096);
    }
    float mx = fmaxf(c0[0], c1[0]);
#pragma unroll
    for (int i = 1; i < 16; ++i) mx = fmaxf(mx, fmaxf(c0[i], c1[i]));
    mx = swap_max(mx);
    float a = 1.0f;
    { const float dl = FIRST ? mx : ((mx > 8.0f) ? mx : 0.f);
      if (FIRST || __any(dl != 0.f)) {
#pragma unroll
          for (int i = 0; i < 16; ++i) { c0[i] -= dl; c1[i] -= dl; }
          st.mrun += dl; if (!FIRST) a = __builtin_amdgcn_exp2f(-dl);
      } }
    float ps = 0.f;
#define ATT_EXPS(E) do { _Pragma("unroll") for (int j = 0; j < 8; ++j) { const int i = (E) * 8 + j; \
        if (i < 16) { c0[i] = __builtin_amdgcn_exp2f(c0[i]); ps += c0[i]; } else { c1[i - 16] = __builtin_amdgcn_exp2f(c1[i - 16]); ps += c1[i - 16]; } } \
        asm volatile("" : "+v"(c0), "+v"(c1), "+v"(ps)); __builtin_amdgcn_sched_barrier(0); } while (0)
#define ATT_PV(KK, VF) do { _Pragma("unroll") for (int e = 0; e < 4; ++e) o[e] = __builtin_amdgcn_mfma_f32_32x32x16_bf16(VF[e], pbp[KK], o[e], 0, 0, 0); } while (0)
#define ATT_TIE(N, VF) asm volatile("s_waitcnt lgkmcnt(" #N ")" : "+v"(VF[0]), "+v"(VF[1]), "+v"(VF[2]), "+v"(VF[3]))
    if (HAS_PREV) {
        __builtin_amdgcn_sched_barrier(0);
#pragma unroll
        for (int e = 0; e < 4; ++e) DSR128(vB[e], va[1], e * 4096);
        ATT_TIE(4, vA); ATT_PV(0, vA); ATT_EXPS(0);
#pragma unroll
        for (int e = 0; e < 4; ++e) DSR128(vA[e], va[2], e * 4096);
        ATT_TIE(4, vB); ATT_PV(1, vB); ATT_EXPS(1);
#pragma unroll
        for (int e = 0; e < 4; ++e) DSR128(vB[e], va[3], e * 4096);
        ATT_TIE(4, vA); ATT_PV(2, vA); ATT_EXPS(2);
        ATT_TIE(0, vB); ATT_PV(3, vB); ATT_EXPS(3);
    } else {
#pragma unroll
        for (int i = 0; i < 16; ++i) { c0[i] = __builtin_amdgcn_exp2f(c0[i]); ps += c0[i]; c1[i] = __builtin_amdgcn_exp2f(c1[i]); ps += c1[i]; }
    }
#undef ATT_EXPS
#undef ATT_PV
#undef ATT_TIE
    st.l = st.l * a + ps;
    if (!FIRST) { if (__any(a != 1.0f)) {
#pragma unroll
        for (int e = 0; e < 4; ++e)
#pragma unroll
            for (int i = 0; i < 16; ++i) o[e][i] *= a; } }
    { u32x4 w;
      w.x = pg8::cvt_pk_bf16(c0[0], c0[1]); w.y = pg8::cvt_pk_bf16(c0[2], c0[3]); w.z = pg8::cvt_pk_bf16(c0[4], c0[5]); w.w = pg8::cvt_pk_bf16(c0[6], c0[7]); pbp[0] = __builtin_bit_cast(bf16x8, w);
      w.x = pg8::cvt_pk_bf16(c0[8], c0[9]); w.y = pg8::cvt_pk_bf16(c0[10], c0[11]); w.z = pg8::cvt_pk_bf16(c0[12], c0[13]); w.w = pg8::cvt_pk_bf16(c0[14], c0[15]); pbp[1] = __builtin_bit_cast(bf16x8, w);
      w.x = pg8::cvt_pk_bf16(c1[0], c1[1]); w.y = pg8::cvt_pk_bf16(c1[2], c1[3]); w.z = pg8::cvt_pk_bf16(c1[4], c1[5]); w.w = pg8::cvt_pk_bf16(c1[6], c1[7]); pbp[2] = __builtin_bit_cast(bf16x8, w);
      w.x = pg8::cvt_pk_bf16(c1[8], c1[9]); w.y = pg8::cvt_pk_bf16(c1[10], c1[11]); w.z = pg8::cvt_pk_bf16(c1[12], c1[13]); w.w = pg8::cvt_pk_bf16(c1[14], c1[15]); pbp[3] = __builtin_bit_cast(bf16x8, w); }
}
__device__ __forceinline__ void attn_unit(LAS unsigned char* lds, const bf16* __restrict__ Qb, const bf16* __restrict__ Kb, const bf16* __restrict__ VT, bf16* __restrict__ Y,
                                          const float* __restrict__ gsub, float lam, int b, int h, int qb, float* o1scr) {
    int tid_ = threadIdx.x; asm volatile("" : "+v"(tid_));
    const int tid = tid_, lane = tid & 63, wid = __builtin_amdgcn_readfirstlane(tid >> 6), r32 = lane & 31, hi = lane >> 5;
    const size_t tok0 = (size_t)b * SEQ;
    constexpr int KSL = 8192, VSL = 16384, VB0 = 3 * KSL;
    const int kap = 16 * ((r32 >> 4) & 1) + 8 * ((r32 >> 2) & 1) + 4 * ((r32 >> 3) & 1) + (r32 & 3);
    int kofs[4], vofs[4];
#pragma unroll
    for (int k = 0; k < 4; ++k) { kofs[k] = kap * 128 + (((2 * k + hi) ^ ((kap >> 1) & 7)) << 4); vofs[k] = r32 * 128 + (((2 * k + hi) ^ ((r32 >> 1) & 7)) << 4); }
    const int lrow = tid >> 3, lc = (tid & 7) ^ ((lrow >> 1) & 7);
    const int kcol = (lc < 4) ? 8 * lc : 128 + 8 * (lc - 4);
    const unsigned wofs = (unsigned)wid * 1024u;
    f32x16 o[4]; float inv = 0.f;
#define ATT_WAITBAR(N) do { asm volatile("s_waitcnt vmcnt(" #N ") lgkmcnt(0)" ::: "memory"); __builtin_amdgcn_s_barrier(); asm volatile("" ::: "memory"); } while (0)
#define ATT_DMA(src, ldsoff) __builtin_amdgcn_global_load_lds((const unsigned*)(src), (LAS unsigned*)(lds + (ldsoff) + wofs), 16, 0, 0)
#pragma unroll 1
    for (int mp = 0; mp < 2; ++mp) {
        const int c1 = 256 * (h >> 1) + 32 * (2 * (h & 1) + mp);
        const bf16* qp = Qb + (tok0 + (size_t)qb * 256 + wid * 32 + r32) * 512 + c1 + 8 * hi;
        bf16x8 qr[4];
        qr[0] = *(const bf16x8*)(qp); qr[1] = *(const bf16x8*)(qp + 16); qr[2] = *(const bf16x8*)(qp + 128); qr[3] = *(const bf16x8*)(qp + 144);
        const bf16* kp = Kb + (tok0 + lrow) * 512 + c1 + kcol;
        const bf16* vp = VT + ((size_t)((b * 4 + h) * 32) * 128 + lrow) * 64 + lc * 8;
        ATT_DMA(kp, 0); ATT_DMA(vp, VB0); ATT_DMA(vp + 4096, VB0 + 8192); ATT_DMA(kp + (size_t)64 * 512, KSL);
        ATT_WAITBAR(0);
#pragma unroll
        for (int e = 0; e < 4; ++e)
#pragma unroll
            for (int i = 0; i < 16; ++i) o[e][i] = 0.f;
        AttnState st; st.mrun = 0.f; st.l = 0.f;
        bf16x8 pbp[4];
        f32x16 sA, sB;
        int s0 = 0, s1 = 1, s2 = 2;
#define ATT_STEP(T, FIRST, HASP) do { const int t_ = (T); \
        if (t_ + 2 < 32) ATT_DMA(kp + (size_t)(t_ + 2) * 64 * 512, s2 * KSL); \
        if (t_ + 1 < 32) { ATT_DMA(vp + (size_t)(t_ + 1) * 8192, VB0 + s1 * VSL); ATT_DMA(vp + (size_t)(t_ + 1) * 8192 + 4096, VB0 + s1 * VSL + 8192); } \
        attn_step<FIRST, HASP>(sA, sB, o, pbp, qr, st, lds + s0 * KSL, lds + VB0 + s2 * VSL, kofs, vofs); \
        if (t_ + 2 < 32) ATT_WAITBAR(3); else ATT_WAITBAR(0); \
        { const int tmp_ = s0; s0 = s1; s1 = s2; s2 = tmp_; } } while (0)
        ATT_STEP(0, true, false);
#pragma unroll 1
        for (int t = 1; t < 32; ++t) ATT_STEP(t, false, true);
#undef ATT_STEP
        { const LAS unsigned char* vb = lds + VB0 + 1 * VSL;
#pragma unroll
          for (int e = 0; e < 4; ++e)
#pragma unroll
              for (int kk = 0; kk < 4; ++kk) { const bf16x8 vf = *(const LAS bf16x8*)(vb + e * 4096 + vofs[kk]);
                  o[e] = __builtin_amdgcn_mfma_f32_32x32x16_bf16(vf, pbp[kk], o[e], 0, 0, 0); } }
        ATT_WAITBAR(0);
        inv = 1.0f / swap_sum(st.l);
        if (mp == 0) {
#pragma unroll
            for (int e = 0; e < 4; ++e)
#pragma unroll
                for (int a = 0; a < 4; ++a) { f32x4 v = {o[e][4 * a] * inv, o[e][4 * a + 1] * inv, o[e][4 * a + 2] * inv, o[e][4 * a + 3] * inv};
                    *(f32x4*)(o1scr + ((size_t)(e * 4 + a) * 512 + tid) * 4) = v; }
        }
    }
#undef ATT_WAITBAR
#undef ATT_DMA
    {
        const float li = lam * inv; float ss = 0.f;
#pragma unroll
        for (int e = 0; e < 4; ++e)
#pragma unroll
            for (int a = 0; a < 4; ++a) { const f32x4 v1 = *(const f32x4*)(o1scr + ((size_t)(e * 4 + a) * 512 + tid) * 4);
#pragma unroll
                for (int k = 0; k < 4; ++k) { const float v = v1[k] - li * o[e][4 * a + k]; o[e][4 * a + k] = v; ss += v * v; } }
        ss = swap_sum(ss);
        const float rs = (1.0f - LAMBDA_INIT) / sqrtf(ss * (1.0f / 128.0f) + RMS_EPS);
        bf16* yp = Y + (tok0 + (size_t)qb * 256 + wid * 32 + r32) * 1024 + h * 128 + 4 * hi;
#pragma unroll
        for (int e = 0; e < 4; ++e)
#pragma unroll
            for (int a = 0; a < 4; ++a) { const f32x4 gg = *(const f32x4*)(gsub + 32 * e + 8 * a + 4 * hi);
                u32x2 w; w.x = pk2(o[e][4 * a] * rs * gg[0], o[e][4 * a + 1] * rs * gg[1]); w.y = pk2(o[e][4 * a + 2] * rs * gg[2], o[e][4 * a + 3] * rs * gg[3]);
                *(u32x2*)(yp + 32 * e + 8 * a) = w; }
    }
}

constexpr int NPHASE = 12;
__global__ void __launch_bounds__(512, 2) fwd_mega(Args a) {
    extern __shared__ __attribute__((aligned(16))) unsigned char lds_raw[];
    LAS unsigned char* lds = (LAS unsigned char*)lds_raw;
    cg::grid_group grid = cg::this_grid();
    const int tid = threadIdx.x, lane = tid & 63, wid = __builtin_amdgcn_readfirstlane(tid >> 6);
    const int G = gridDim.x, bx = blockIdx.x;
    const int lo = a.ph_lo, hi = a.ph_hi;
    const bool fused = (hi - lo) > 1;
    volatile LAS unsigned* MISC = (volatile LAS unsigned*)(lds + 131072 + 512);
    if (tid < 4) MISC[tid] = 0u;
    __syncthreads();
    XcdBarrier xbar; xbar.bar = (unsigned*)(a.ws + WS_BAR); xbar.x = 0; xbar.st = MISC;
    if (fused) xbar = xcd_barrier_post((unsigned*)(a.ws + WS_BAR), MISC);
    if (a.ph_lo < 0) grid.sync();
    unsigned char* ws = a.ws;
    const float* x = a.in[0];
    bf16* Wgu1 = (bf16*)(ws + WS_WGU1); bf16* Wd1 = (bf16*)(ws + WS_WD1); bf16* Win = (bf16*)(ws + WS_WIN); bf16* Wba = (bf16*)(ws + WS_WBA); bf16* Wbp = (bf16*)(ws + WS_WBP);
    bf16* Wout = (bf16*)(ws + WS_WOUT); bf16* Wgu2 = (bf16*)(ws + WS_WGU2); bf16* Wd2 = (bf16*)(ws + WS_WD2);
    float* cosT = (float*)(ws + WS_COS); float* sinT = (float*)(ws + WS_SIN);
    bf16* XB = (bf16*)(ws + WS_XB); bf16* YATT = (bf16*)(ws + WS_YATT); bf16* POOL = (bf16*)(ws + WS_POOL);
    bf16* Y1 = (bf16*)(ws + WS_X1F);
    bf16* X1B = (bf16*)a.out;
    bf16* HB = (bf16*)(ws + WS_R1); bf16* QB = (bf16*)(ws + WS_Q); bf16* KB = (bf16*)(ws + WS_K); bf16* VTB = (bf16*)(ws + WS_VT); bf16* UB = (bf16*)(ws + WS_U);
    bf16* TB = (bf16*)(ws + WS_R1);
    bf16* MG = (bf16*)(ws + WS_R2);
    float* O1S = (float*)(ws + WS_O1S) + (size_t)bx * (512 * 64);
    bf16* GATE = (bf16*)(ws + WS_X1F);
    float* OUT = a.out;
#ifndef PHM
#define PHM 4095
#endif
#define IN_PH(k) ((((PHM) >> (k)) & 1) && lo <= (k) && (k) < hi)
#define REPS(k) (IN_PH(k) ? 1 + ((a.rep_mask >> (k)) & 1) : 0)
#define SEAM(k) do { if (lo <= (k) && (k) + 1 < hi) { xcd_barrier(xbar); } } while (0)
#define WG_HANDOFF() do { asm volatile("s_waitcnt vmcnt(0) lgkmcnt(0)" ::: "memory"); __syncthreads(); __builtin_amdgcn_fence(__ATOMIC_ACQUIRE, "agent"); asm volatile("s_waitcnt vmcnt(0)" ::: "memory"); } while (0)

    if (IN_PH(0)) {
        LAS float* scr = (LAS float*)(lds + wid * 16384);
        const int gw = bx * 8 + wid, NGW = G * 8;
        constexpr int I_GU = (DM / 64) * (DFF / 32), I_DN = (DFF / 64) * (DM / 32), I_IN = (DM / 64) * (4096 / 32), I_BA = (512 / 64) * (DM / 32), I_OUT = (DM / 64) * (DM / 32);
        constexpr int NITEMS = 4 * I_GU + 2 * I_DN + I_IN + I_BA + I_OUT;
        for (int it = gw; it < NITEMS; it += NGW) {
            int r = it;
            if (r < I_GU) { transpose_item(a.in[3], DM, DFF, Wgu1, MapGateUp{0}, scr, r, lane); continue; } r -= I_GU;
            if (r < I_GU) { transpose_item(a.in[4], DM, DFF, Wgu1, MapGateUp{1}, scr, r, lane); continue; } r -= I_GU;
            if (r < I_GU) { transpose_item(a.in[19], DM, DFF, Wgu2, MapGateUp{0}, scr, r, lane); continue; } r -= I_GU;
            if (r < I_GU) { transpose_item(a.in[20], DM, DFF, Wgu2, MapGateUp{1}, scr, r, lane); continue; } r -= I_GU;
            if (r < I_DN) { transpose_item(a.in[5], DFF, DM, Wd1, MapOff{0}, scr, r, lane); continue; } r -= I_DN;
            if (r < I_DN) { transpose_item(a.in[21], DFF, DM, Wd2, MapOff{0}, scr, r, lane); continue; } r -= I_DN;
            if (r < I_IN) { transpose_item(a.in[6], DM, 4096, Win, MapWin{}, scr, r, lane); continue; } r -= I_IN;
            if (r < I_BA) { transpose_item(a.in[14], 512, DM, Wba, MapOff{0}, scr, r, lane, 1024); continue; } r -= I_BA;
            transpose_item(a.in[16], DM, DM, Wout, MapOff{0}, scr, r, lane);
        }
        const size_t gt = (size_t)bx * 512 + tid, NT = (size_t)G * 512;
        { const float* pw = a.in[12]; const float* psc = a.in[13]; const float* wbp = a.in[15];
          for (int w = gw; w < 1024 * 8; w += NGW) { const int n = w & 1023, gc = (w >> 10) * 64 + lane, g = gc >> 7;
              float acc = 0.f;
              for (int d = 0; d < 128; ++d) acc += pw[(size_t)gc * 128 + d] * psc[g * 128 + d] * wbp[(size_t)(g * 128 + d) * 1024 + n];
              Wba[(size_t)n * 1024 + 512 + gc] = (bf16)f2bf(acc); } }
        for (size_t idx = gt; idx < (size_t)SEQ * 32; idx += NT) { const int i = (int)(idx & 31), pos = (int)(idx >> 5);
            const float inv = 1.0f / powf(10000.0f, (float)(2 * i) / 64.0f); const float ang = (float)pos * inv;
            cosT[idx] = cosf(ang); sinT[idx] = sinf(ang); }
#pragma unroll 4
        for (size_t idx = gt; idx < (size_t)NTOK * DM / 8; idx += NT) { const f32x4 v0 = *(const f32x4*)(x + idx * 8), v1 = *(const f32x4*)(x + idx * 8 + 4);
            u32x4 w; w.x = pk2(v0[0], v0[1]); w.y = pk2(v0[2], v0[3]); w.z = pk2(v1[0], v1[1]); w.w = pk2(v1[2], v1[3]); *(u32x4*)(XB + idx * 8) = w; }
        __syncthreads();
    }
    SEAM(0);
    if (IN_PH(1)) {
        pg8::Gemm g{XB, Wgu1, NTOK, 2 * DFF, DM}; pg8::StaticOrder S; S.init(NTOK, 2 * DFF, G, bx);
        pg8::EpiSwiglu E{HB, DFF};
        pg8::gemm_phase<pg8::EpiSwiglu, pg8::StaticOrder, true, true>(lds, g, S, E);
    }
    SEAM(1);
    if (IN_PH(2)) {
        pg8::Gemm g{HB, Wd1, NTOK, DM, DFF}; pg8::StaticOrder S; S.init(NTOK, DM, G, bx);
        pg8::EpiResid E{x, Y1, DN_ALPHA, 0.5f};
        pg8::gemm_phase<pg8::EpiResid, pg8::StaticOrder, true, true>(lds, g, S, E);
    }
    SEAM(2);
    if (IN_PH(3)) {
        for (int pm = bx; pm < NPAN; pm += G) ln_panel(Y1, nullptr, X1B, a.in[1], a.in[2], pm, wid, lane);
        __syncthreads();
    }
    SEAM(3);
    if (IN_PH(4)) {
        { pg8::Gemm g{X1B, Win, NTOK, 3584, DM}; pg8::StaticOrder S; S.init(NTOK, 3584, G, bx);
          pg8::EpiWin E{QB, KB, UB, GATE, cosT, sinT, QSCALE};
          pg8::gemm_phase<pg8::EpiWin, pg8::StaticOrder, true, true>(lds, g, S, E); }
        { pg8::Gemm g{Win + (size_t)3584 * DM, X1B, 512, NTOK, DM}; pg8::StaticOrder S; S.init(512, NTOK, G, bx);
          pg8::EpiVT E{VTB};
          pg8::gemm_phase<pg8::EpiVT, pg8::StaticOrder, true, true>(lds, g, S, E); }
    }
    SEAM(4);
    if (IN_PH(5)) {
        for (int item = bx * 512 + tid; item < NBATCH * 64 * 64; item += G * 512) {
            const int c8 = item & 63, seg = (item >> 6) & 63, bb = item >> 12;
            const int ch = c8 * 8, hw = 1 << (ch >> 7);
            const bf16* base = UB + (size_t)bb * SEQ * 512 + ch;
            bf16* obase = XB + (size_t)bb * SEQ * 1024 + 512 + ch;
            const int s0 = seg * 32;
            f32x4 w0 = {0.f, 0.f, 0.f, 0.f}, w1 = {0.f, 0.f, 0.f, 0.f};
            { const int jlo = (s0 - hw) > 0 ? (s0 - hw) : 0, jhi = (s0 + hw) < SEQ ? (s0 + hw) : SEQ;
              for (int j = jlo; j < jhi; ++j) { f32x4 a0, a1; pg8::unpack8(*(const u32x4*)(base + (size_t)j * 512), a0, a1); w0 += a0; w1 += a1; } }
#pragma unroll 4
            for (int s = s0; s < s0 + 32; ++s) {
                f32x4 u0, u1; pg8::unpack8(*(const u32x4*)(base + (size_t)s * 512), u0, u1);
                const int jlo = (s - hw) > 0 ? (s - hw) : 0, jhi = (s + hw) < SEQ ? (s + hw) : SEQ;
                const float rc = 1.0f / (float)(jhi - jlo);
                *(u32x4*)(obase + (size_t)s * 1024) = pg8::pack8(w0 * rc - u0, w1 * rc - u1);
                if (s + hw < SEQ) { f32x4 a0, a1; pg8::unpack8(*(const u32x4*)(base + (size_t)(s + hw) * 512), a0, a1); w0 += a0; w1 += a1; }
                if (s - hw >= 0) { f32x4 a0, a1; pg8::unpack8(*(const u32x4*)(base + (size_t)(s - hw) * 512), a0, a1); w0 -= a0; w1 -= a1; }
            }
        }
        float lam;
        { const float p1 = a.in[7][lane] * a.in[8][lane], p2 = a.in[9][lane] * a.in[10][lane];
          lam = expf(wave_sum(p1)) - expf(wave_sum(p2)) + LAMBDA_INIT; }
        if (G == 256) {
            const int xc = bx & 7, j = bx >> 3;
            for (int i = 0; i < 4; ++i) { const int bh = i * 32 + xc * 4 + (j >> 3), qb = j & 7;
                attn_unit(lds, QB, KB, VTB, YATT, a.in[11], lam, bh >> 2, bh & 3, qb, O1S); }
        } else {
            for (int u = bx; u < 1024; u += G) attn_unit(lds, QB, KB, VTB, YATT, a.in[11], lam, (u >> 3) >> 2, (u >> 3) & 3, u & 7, O1S);
        }
    }
    SEAM(5);
    if (IN_PH(6)) {
        pg8::Gemm g{XB, Wba, NTOK, DM, DM}; pg8::StaticOrder S; S.init(NTOK, DM, G, bx);
        pg8::EpiGateMid E{GATE, MG};
        pg8::gemm_phase<pg8::EpiGateMid, pg8::StaticOrder, true, true>(lds, g, S, E);
    }
    SEAM(6);
    if (IN_PH(7)) {
        pg8::Gemm g{MG, Wout, NTOK, DM, DM}; pg8::StaticOrder S; S.init(NTOK, DM, G, bx);
        pg8::EpiResidB E{X1B, TB, DN_ALPHA, 1.0f};
        pg8::gemm_phase<pg8::EpiResidB, pg8::StaticOrder, true, true>(lds, g, S, E);
    }
    SEAM(7);
    if (IN_PH(8)) {
        for (int pm = bx; pm < NPAN; pm += G) ln_panel(TB, nullptr, MG, a.in[17], a.in[18], pm, wid, lane);
        __syncthreads();
    }
    SEAM(8);
    if (IN_PH(9)) {
        pg8::Gemm g{MG, Wgu2, NTOK, 2 * DFF, DM}; pg8::StaticOrder S; S.init(NTOK, 2 * DFF, G, bx);
        pg8::EpiSwiglu E{HB, DFF};
        pg8::gemm_phase<pg8::EpiSwiglu, pg8::StaticOrder, true, true>(lds, g, S, E);
    }
    SEAM(9);
    if (IN_PH(10)) {
        pg8::Gemm g{HB, Wd2, NTOK, DM, DFF}; pg8::StaticOrder S; S.init(NTOK, DM, G, bx);
        pg8::EpiResidB E{MG, Y1, DN_ALPHA, 0.5f};
        pg8::gemm_phase<pg8::EpiResidB, pg8::StaticOrder, true, true>(lds, g, S, E);
    }
    SEAM(10);
    if (IN_PH(11)) {
        for (int pm = bx; pm < NPAN; pm += G) ln_panel(Y1, OUT, nullptr, a.in[22], a.in[23], pm, wid, lane);
    }
}

#ifndef REP_MASK
#define REP_MASK 0
#endif
#ifndef MK_N_LAUNCHES
#define MK_N_LAUNCHES 1
#endif
extern "C" void kernel_launch(void* const* d_in, const int* in_sizes, int n_in, void* d_out, int out_size, void* d_ws, size_t ws_size, hipStream_t stream) {
    static int grid = 0;
    if (grid == 0) {
        if (n_in != 24 || in_sizes[0] != NTOK * DM || out_size != NTOK * DM || ws_size < WS_END) { fprintf(stderr, "kernel_launch: unexpected shapes (n_in %d, ws %zu)\n", n_in, ws_size); grid = -1; return; }
        int dev = 0, cus = 0, per_cu = 0;
        hipGetDevice(&dev); hipDeviceGetAttribute(&cus, hipDeviceAttributeMultiprocessorCount, dev);
        if (hipFuncSetAttribute((const void*)fwd_mega, hipFuncAttributeMaxDynamicSharedMemorySize, LDS_BYTES) != hipSuccess) { fprintf(stderr, "kernel_launch: hipFuncSetAttribute failed\n"); grid = -1; return; }
        if (hipOccupancyMaxActiveBlocksPerMultiprocessor(&per_cu, (const void*)fwd_mega, 512, LDS_BYTES) != hipSuccess || per_cu < 1) { fprintf(stderr, "kernel_launch: occupancy query says %d\n", per_cu); per_cu = 1; }
        (void)hipGetLastError();
        grid = cus * per_cu;
    }
    if (grid < 0) return;
    Args a{};
    for (int i = 0; i < 24; ++i) a.in[i] = (const float*)d_in[i];
    a.out = (float*)d_out; a.ws = (unsigned char*)d_ws;
    (void)hipMemsetAsync((unsigned char*)d_ws + WS_BAR, 0, 16384, stream);
#if MK_N_LAUNCHES == 1
    a.ph_lo = 0; a.ph_hi = NPHASE; a.rep_mask = REP_MASK;
    void* args[] = {&a};
    hipError_t e = hipLaunchCooperativeKernel((const void*)fwd_mega, dim3(grid), dim3(512), args, LDS_BYTES, stream);
    if (e != hipSuccess) fprintf(stderr, "cooperative launch failed: %s (grid %d)\n", hipGetErrorString(e), grid);
#else
    for (int p = 0; p < NPHASE; ++p) { a.ph_lo = p; a.ph_hi = p + 1; hipLaunchKernelGGL(fwd_mega, dim3(grid), dim3(512), LDS_BYTES, stream, a); }
#endif
}
```

```cpp
#include <hip/hip_runtime.h>
#include <hip/hip_cooperative_groups.h>
#include <cstdio>
#include <cstdint>
namespace cg = cooperative_groups;
namespace pg8 {
#define PG8_LAS __attribute__((address_space(3)))
typedef unsigned short bf16_t;
typedef short bf16x8 __attribute__((ext_vector_type(8)));
typedef float f32x4 __attribute__((ext_vector_type(4)));
typedef unsigned u32x4 __attribute__((ext_vector_type(4)));
constexpr int BM = 256, BK = 64, HALF = 128, HTB = HALF * BK * 2  , STAGE_BYTES = 8 * HTB, NXCD = 8, WGM = 4;

__host__ __device__ __forceinline__ int lds_byte(int r, int c) { const int st = (r >> 4) * 2 + (c >> 5), rr = r & 15, cc = c & 31, ob = rr * 64 + cc * 2; return st * 1024 + (ob ^ (((ob >> 9) & 1) << 5)); }
__host__ __device__ __forceinline__ void stage_rc(int b, int& R, int& C) { const int st = b / 1024, sb = b % 1024, swz = sb ^ (((sb >> 9) & 1) << 5); R = (st >> 1) * 16 + swz / 64; C = (st & 1) * 32 + (swz % 64) / 2; }
__host__ __device__ __forceinline__ int perm32(int rho) { const int n = rho >> 4, i = rho & 15; return 8 * (i >> 2) + 4 * n + (i & 3); }

struct Unit { int pm, pn; };
struct Gemm { const bf16_t* A; const bf16_t* Bt; int M, N, K; };

struct StaticOrder {
    int nM, nN, nwg, G, c;
    __host__ __device__ void init(int M, int N, int G_, int c_) { nM = M / BM; nN = N / BM; nwg = nM * nN; G = G_; c = c_; }
    __host__ __device__ bool next(int i, Unit& u) const {
        const long L = (long)i * G + c; if (L >= nwg) return false;
        int wgid = (int)L; { const int q = nwg / NXCD, r = nwg % NXCD, xcd = wgid % NXCD, off = wgid / NXCD; wgid = (xcd < r ? xcd * (q + 1) : r * (q + 1) + (xcd - r) * q) + off; }
        const int nig = WGM * nN, gid = wgid / nig, fm = gid * WGM, gsz = (nM - fm) < WGM ? (nM - fm) : WGM;
        u.pm = fm + ((wgid % nig) % gsz); u.pn = (wgid % nig) / gsz; return true;
    }
    __device__ __forceinline__ void a_ready(const Unit&) const {}
    __device__ __forceinline__ void done(const Unit&) const {}
};

typedef float cvt_f32x2_t __attribute__((ext_vector_type(2))); typedef __bf16 cvt_bf16x2_t __attribute__((ext_vector_type(2)));
__device__ __forceinline__ unsigned cvt_pk_bf16(float lo, float hi) { cvt_f32x2_t v = {lo, hi}; cvt_bf16x2_t b = __builtin_convertvector(v, cvt_bf16x2_t); return __builtin_bit_cast(unsigned, b); }
typedef float f32x2 __attribute__((ext_vector_type(2)));
struct PanelOrder {
    int pm, npn;
    __device__ __forceinline__ bool next(int i, Unit& u) const { if (i >= npn) return false; int p = pm, q = i; asm volatile("" : "+s"(p), "+s"(q));
        u.pm = p; u.pn = q; return true; }
    __device__ __forceinline__ void a_ready(const Unit&) const {}
    __device__ __forceinline__ void done(const Unit&) const {}
};
__device__ __forceinline__ float fast_sigmoid(float v) { return __builtin_amdgcn_rcpf(1.0f + __builtin_amdgcn_exp2f(v * -1.4426950408889634f)); }
__device__ __forceinline__ u32x4 pack8(const f32x4 a, const f32x4 b) { u32x4 w; w.x = cvt_pk_bf16(a[0], a[1]); w.y = cvt_pk_bf16(a[2], a[3]); w.z = cvt_pk_bf16(b[0], b[1]); w.w = cvt_pk_bf16(b[2], b[3]); return w; }
__device__ __forceinline__ void unpack8(const u32x4 w, f32x4& a, f32x4& b) {
    a[0] = __uint_as_float(w.x << 16); a[1] = __uint_as_float(w.x & 0xffff0000u); a[2] = __uint_as_float(w.y << 16); a[3] = __uint_as_float(w.y & 0xffff0000u);
    b[0] = __uint_as_float(w.z << 16); b[1] = __uint_as_float(w.z & 0xffff0000u); b[2] = __uint_as_float(w.w << 16); b[3] = __uint_as_float(w.w & 0xffff0000u);
}
struct EpiPlain {
    static constexpr bool PERM = true, AFTER_DRAIN = false, MIDHOOK = false;
    bf16_t* O; size_t ldc;
    __device__ __forceinline__ void operator()(const f32x4 (&acc)[2][2][4][2], const Unit& u, int wr, int wc, int fr, int fq) const {
        const int row0 = u.pm * BM + wr * 64 + fr, col0 = u.pn * BM + wc * 32 + 8 * fq;
#pragma unroll
        for (int ai = 0; ai < 2; ++ai)
#pragma unroll
            for (int m = 0; m < 4; ++m) { bf16_t* rowp = O + (size_t)(row0 + ai * HALF + m * 16) * ldc + col0;
#pragma unroll
                for (int bj = 0; bj < 2; ++bj) *(u32x4*)(rowp + bj * HALF) = pack8(acc[ai][bj][m][0], acc[ai][bj][m][1]); }
    }
};
struct EpiSwiglu {
    static constexpr bool PERM = true, AFTER_DRAIN = false, MIDHOOK = false;
    bf16_t* H; int ldh;
    __device__ __forceinline__ void operator()(const f32x4 (&acc)[2][2][4][2], const Unit& u, int wr, int wc, int fr, int fq) const {
        const int row0 = u.pm * BM + wr * 64 + fr, col0 = u.pn * HALF + wc * 32 + 8 * fq;
#pragma unroll
        for (int ai = 0; ai < 2; ++ai)
#pragma unroll
            for (int m = 0; m < 4; ++m) { f32x4 h[2];
#pragma unroll
                for (int n = 0; n < 2; ++n) { const f32x4 g = acc[ai][0][m][n], up = acc[ai][1][m][n];
#pragma unroll
                    for (int e = 0; e < 4; ++e) h[n][e] = g[e] * fast_sigmoid(g[e]) * up[e]; }
                __builtin_nontemporal_store(pack8(h[0], h[1]), (u32x4*)(H + (size_t)(row0 + ai * HALF + m * 16) * ldh + col0)); }
    }
};
struct EpiWin {
    static constexpr bool PERM = true, AFTER_DRAIN = false, MIDHOOK = false;
    bf16_t *Q, *K, *U, *G; const float* cosT; const float* sinT; float qscale;
    __device__ __forceinline__ void operator()(const f32x4 (&acc)[2][2][4][2], const Unit& u, int wr, int wc, int fr, int fq) const {
        const int row0 = u.pm * BM + wr * 64 + fr; const int pn = u.pn;
        if (pn < 4) {
            bf16_t* base = (pn < 2) ? Q : K; const float sc = (pn < 2) ? qscale : 1.0f; const int ct = (pn & 1) * BM + wc * 32 + 8 * fq;
#pragma unroll
            for (int ai = 0; ai < 2; ++ai)
#pragma unroll
                for (int mh = 0; mh < 2; ++mh) {
                    f32x4 cs[2][2], sn[2][2];
#pragma unroll
                    for (int mm = 0; mm < 2; ++mm) { const int pos = (row0 + ai * HALF + (mh * 2 + mm) * 16) & 2047;
#pragma unroll
                        for (int n = 0; n < 2; ++n) { cs[mm][n] = *(const f32x4*)(cosT + pos * 32 + 8 * fq + 4 * n); sn[mm][n] = *(const f32x4*)(sinT + pos * 32 + 8 * fq + 4 * n); } }
#pragma unroll
                    for (int mm = 0; mm < 2; ++mm) { const int m = mh * 2 + mm; const int row = row0 + ai * HALF + m * 16;
                        f32x4 o1[2], o2[2];
#pragma unroll
                        for (int n = 0; n < 2; ++n) { const f32x4 x1 = acc[ai][0][m][n], x2 = acc[ai][1][m][n];
                            o1[n] = (x1 * cs[mm][n] - x2 * sn[mm][n]) * sc; o2[n] = (x1 * sn[mm][n] + x2 * cs[mm][n]) * sc; }
                        bf16_t* rowp = base + (size_t)row * 512 + ct;
                        *(u32x4*)(rowp) = pack8(o1[0], o1[1]); *(u32x4*)(rowp + HALF) = pack8(o2[0], o2[1]); }
                    asm volatile("" ::: "memory"); }
        } else if (pn < 6) {
            const int col0 = (pn - 4) * BM + wc * 32 + 8 * fq;
#pragma unroll
            for (int ai = 0; ai < 2; ++ai)
#pragma unroll
                for (int m = 0; m < 4; ++m) { bf16_t* rowp = U + (size_t)(row0 + ai * HALF + m * 16) * 512 + col0;
#pragma unroll
                    for (int bj = 0; bj < 2; ++bj) *(u32x4*)(rowp + bj * HALF) = pack8(acc[ai][bj][m][0], acc[ai][bj][m][1]); }
        } else {
            const int col0 = (pn - 6) * BM + wc * 32 + 8 * fq;
#pragma unroll
            for (int ai = 0; ai < 2; ++ai)
#pragma unroll
                for (int m = 0; m < 4; ++m) { bf16_t* rowp = G + (size_t)(row0 + ai * HALF + m * 16) * 2048 + col0;
                    f32x4 rt[2], gp[2];
#pragma unroll
                    for (int n = 0; n < 2; ++n)
#pragma unroll
                        for (int e = 0; e < 4; ++e) { const float ea = 1.0f + __builtin_amdgcn_exp2f(acc[ai][0][m][n][e] * -1.4426950408889634f), ep = fminf(1.0f + __builtin_amdgcn_exp2f(acc[ai][1][m][n][e] * -1.4426950408889634f), 1e30f);
                            gp[n][e] = __builtin_amdgcn_rcpf(ep); rt[n][e] = ep * __builtin_amdgcn_rcpf(ea); }
                    *(u32x4*)(rowp) = pack8(rt[0], rt[1]); *(u32x4*)(rowp + HALF) = pack8(gp[0], gp[1]); }
        }
    }
};
struct EpiResid {
    static constexpr bool PERM = true, AFTER_DRAIN = false, MIDHOOK = false;
    const float* X; bf16_t* Y; float alpha, sc;
    __device__ __forceinline__ void operator()(const f32x4 (&acc)[2][2][4][2], const Unit& u, int wr, int wc, int fr, int fq) const {
        const int row0 = u.pm * BM + wr * 64 + fr, col0 = u.pn * BM + wc * 32 + 8 * fq;
#pragma unroll
        for (int ai = 0; ai < 2; ++ai)
#pragma unroll
            for (int mh = 0; mh < 2; ++mh) {
                f32x4 xr[2][2][2];
#pragma unroll
                for (int mm = 0; mm < 2; ++mm)
#pragma unroll
                    for (int bj = 0; bj < 2; ++bj)
#pragma unroll
                        for (int n = 0; n < 2; ++n) xr[mm][bj][n] = __builtin_nontemporal_load((const f32x4*)(X + (size_t)(row0 + ai * HALF + (mh * 2 + mm) * 16) * 1024 + col0 + bj * HALF + 4 * n));
#pragma unroll
                for (int mm = 0; mm < 2; ++mm) { const int m = mh * 2 + mm; const size_t off = (size_t)(row0 + ai * HALF + m * 16) * 1024 + col0;
#pragma unroll
                    for (int bj = 0; bj < 2; ++bj) *(u32x4*)(Y + off + bj * HALF) = pack8(xr[mm][bj][0] * alpha + acc[ai][bj][m][0] * sc, xr[mm][bj][1] * alpha + acc[ai][bj][m][1] * sc); }
                asm volatile("" ::: "memory"); }
    }
};
struct EpiGate1 {
    static constexpr bool PERM = true, AFTER_DRAIN = false, MIDHOOK = false;
    const bf16_t* G; float* T;
    __device__ __forceinline__ void operator()(const f32x4 (&acc)[2][2][4][2], const Unit& u, int wr, int wc, int fr, int fq) const {
        const int row0 = u.pm * BM + wr * 64 + fr, col0 = u.pn * BM + wc * 32 + 8 * fq;
#pragma unroll
        for (int ai = 0; ai < 2; ++ai)
#pragma unroll
            for (int m = 0; m < 4; ++m) { const size_t row = (size_t)(row0 + ai * HALF + m * 16);
#pragma unroll
                for (int bj = 0; bj < 2; ++bj) { f32x4 ga, gb; unpack8(*(const u32x4*)(G + row * 2048 + col0 + bj * HALF), ga, gb);
                    float* tp = T + row * 1024 + col0 + bj * HALF;
                    *(f32x4*)(tp) = ga * acc[ai][bj][m][0]; *(f32x4*)(tp + 4) = gb * acc[ai][bj][m][1]; }
                asm volatile("" ::: "memory"); }
    }
};
struct EpiGate2 {
    static constexpr bool PERM = true, AFTER_DRAIN = false, MIDHOOK = false;
    const bf16_t* G; const float* T; bf16_t* Mg;
    __device__ __forceinline__ void operator()(const f32x4 (&acc)[2][2][4][2], const Unit& u, int wr, int wc, int fr, int fq) const {
        const int row0 = u.pm * BM + wr * 64 + fr, col0 = u.pn * BM + wc * 32 + 8 * fq;
#pragma unroll
        for (int ai = 0; ai < 2; ++ai)
#pragma unroll
            for (int m = 0; m < 4; ++m) { const size_t row = (size_t)(row0 + ai * HALF + m * 16);
#pragma unroll
                for (int bj = 0; bj < 2; ++bj) { f32x4 ga, gb; unpack8(*(const u32x4*)(G + row * 2048 + 1024 + col0 + bj * HALF), ga, gb);
                    const float* tp = T + row * 1024 + col0 + bj * HALF;
                    const f32x4 t0 = *(const f32x4*)(tp), t1 = *(const f32x4*)(tp + 4);
                    *(u32x4*)(Mg + row * 1024 + col0 + bj * HALF) = pack8(t0 + ga * acc[ai][bj][m][0], t1 + gb * acc[ai][bj][m][1]); }
                asm volatile("" ::: "memory"); }
    }
};
struct EpiVT {
    static constexpr bool PERM = true, AFTER_DRAIN = false, MIDHOOK = false;
    bf16_t* O;
    __device__ __forceinline__ void operator()(const f32x4 (&acc)[2][2][4][2], const Unit& u, int wr, int wc, int fr, int fq) const {
        const int row0 = u.pm * BM + wr * 64 + fr, col0 = u.pn * BM + wc * 32 + 8 * fq;
#pragma unroll
        for (int ai = 0; ai < 2; ++ai)
#pragma unroll
            for (int m = 0; m < 4; ++m) { const int vcol = row0 + ai * HALF + m * 16, h = vcol >> 7, e = vcol & 127;
#pragma unroll
                for (int bj = 0; bj < 2; ++bj) { const int tok = col0 + bj * HALF, b = tok >> 11, sq = tok & 2047, kt = sq >> 6, key = sq & 63;
                    *(u32x4*)(O + ((size_t)(((b * 4 + h) * 32 + kt) * 128 + e)) * 64 + key) = pack8(acc[ai][bj][m][0], acc[ai][bj][m][1]); } }
    }
};
struct EpiGateMid {
    static constexpr bool PERM = true, AFTER_DRAIN = false, MIDHOOK = true;
    const bf16_t* G; bf16_t* Mg;
    __device__ __forceinline__ void mid(f32x4 (&acc)[2][2][4][2], const Unit& u, int wr, int wc, int fr, int fq) const {
        int row0 = u.pm * BM + wr * 64 + fr, gc0 = u.pn * 512 + wc * 32 + 8 * fq;
        asm volatile("" : "+v"(row0), "+v"(gc0));
#pragma unroll
        for (int ai = 0; ai < 2; ++ai) {
            u32x4 rt[4][2];
#pragma unroll
            for (int m = 0; m < 4; ++m)
#pragma unroll
                for (int bj = 0; bj < 2; ++bj) rt[m][bj] = *(const u32x4*)(G + (size_t)(row0 + ai * HALF + m * 16) * 2048 + gc0 + bj * 256);
#pragma unroll
            for (int m = 0; m < 4; ++m)
#pragma unroll
                for (int bj = 0; bj < 2; ++bj) { f32x4 r0, r1; unpack8(rt[m][bj], r0, r1); acc[ai][bj][m][0] *= r0; acc[ai][bj][m][1] *= r1; }
            asm volatile("" ::: "memory"); }
    }
    __device__ __forceinline__ void operator()(const f32x4 (&acc)[2][2][4][2], const Unit& u, int wr, int wc, int fr, int fq) const {
        const int row0 = u.pm * BM + wr * 64 + fr, col0 = u.pn * BM + wc * 32 + 8 * fq, gc0 = u.pn * 512 + wc * 32 + 8 * fq + 128;
#pragma unroll
        for (int ai = 0; ai < 2; ++ai) {
            u32x4 gp[4][2];
#pragma unroll
            for (int m = 0; m < 4; ++m)
#pragma unroll
                for (int bj = 0; bj < 2; ++bj) gp[m][bj] = *(const u32x4*)(G + (size_t)(row0 + ai * HALF + m * 16) * 2048 + gc0 + bj * 256);
#pragma unroll
            for (int m = 0; m < 4; ++m) { const size_t row = (size_t)(row0 + ai * HALF + m * 16);
#pragma unroll
                for (int bj = 0; bj < 2; ++bj) { f32x4 p0, p1; unpack8(gp[m][bj], p0, p1);
                    *(u32x4*)(Mg + row * 1024 + col0 + bj * HALF) = pack8(acc[ai][bj][m][0] * p0, acc[ai][bj][m][1] * p1); } }
            asm volatile("" ::: "memory"); }
    }
};
struct EpiResidB {
    static constexpr bool PERM = true, AFTER_DRAIN = false, MIDHOOK = false;
    const bf16_t* X; bf16_t* Y; float alpha, sc;
    __device__ __forceinline__ void operator()(const f32x4 (&acc)[2][2][4][2], const Unit& u, int wr, int wc, int fr, int fq) const {
        const int row0 = u.pm * BM + wr * 64 + fr, col0 = u.pn * BM + wc * 32 + 8 * fq;
#pragma unroll
        for (int ai = 0; ai < 2; ++ai) {
            u32x4 xr[4][2];
#pragma unroll
            for (int m = 0; m < 4; ++m)
#pragma unroll
                for (int bj = 0; bj < 2; ++bj) xr[m][bj] = *(const u32x4*)(X + (size_t)(row0 + ai * HALF + m * 16) * 1024 + col0 + bj * HALF);
#pragma unroll
            for (int m = 0; m < 4; ++m) { const size_t off = (size_t)(row0 + ai * HALF + m * 16) * 1024 + col0;
#pragma unroll
                for (int bj = 0; bj < 2; ++bj) { f32x4 x0, x1; unpack8(xr[m][bj], x0, x1);
                    *(u32x4*)(Y + off + bj * HALF) = pack8(x0 * alpha + acc[ai][bj][m][0] * sc, x1 * alpha + acc[ai][bj][m][1] * sc); } }
            asm volatile("" ::: "memory"); }
    }
};
template <class Epi, class Sched, bool ALIGN_EPI = false, bool SP2 = false>
__device__ __forceinline__ void gemm_phase(PG8_LAS unsigned char* lds, const Gemm g, const Sched& S, const Epi& E) {
    int tid_ = threadIdx.x; asm volatile("" : "+v"(tid_));
    const int tid = tid_, wid = __builtin_amdgcn_readfirstlane(tid >> 6), lane = tid & 63, wr = wid >> 2, wc = wid & 3, fr = lane & 15, fq = lane >> 4;
    const int K = g.K, nt = K / BK;
    unsigned voffA[2], voffB[2];
#pragma unroll
    for (int i = 0; i < 2; ++i) { int R, C; stage_rc(tid * 16 + i * 8192, R, C); const int Rb = Epi::PERM ? ((R & ~31) + perm32(R & 31)) : R;
        voffA[i] = (unsigned)(R * K + C) * 2u; voffB[i] = (unsigned)(Rb * K + C) * 2u; }
    const size_t kstep = (size_t)(BK * 2);
    const size_t hstep = (size_t)HALF * K * 2;
    const size_t tstep = 2 * hstep;
    const unsigned ldsw = (unsigned)wid * 1024u;
    const int aoff = lds_byte(wr * 64 + fr, fq * 8), boff = lds_byte(wc * 32 + fr, fq * 8);
#define PG8_SA(b, h) (((b) * 2 + (h)) * HTB)
#define PG8_SB(b, h) ((4 + (b) * 2 + (h)) * HTB)
#define PG8_STAGE(bufoff, gbase, voff) do { _Pragma("unroll") for (int _i = 0; _i < 2; ++_i) \
        __builtin_amdgcn_global_load_lds((const unsigned*)((const char*)(gbase) + (voff)[_i]), (PG8_LAS unsigned*)(lds + (bufoff) + ldsw + _i * 8192), 16, 0, 0); } while (0)
#define PG8_LDA(dst, b, h) do { _Pragma("unroll") for (int m = 0; m < 4; ++m) _Pragma("unroll") for (int k = 0; k < 2; ++k) dst[m][k] = *(const PG8_LAS bf16x8*)(lds + PG8_SA(b, h) + aoff + m * 2048 + k * 1024); } while (0)
#define PG8_LDB(dst, b, h) do { _Pragma("unroll") for (int n = 0; n < 2; ++n) _Pragma("unroll") for (int k = 0; k < 2; ++k) dst[n][k] = *(const PG8_LAS bf16x8*)(lds + PG8_SB(b, h) + boff + n * 2048 + k * 1024); } while (0)
#define PG8_MMA(ai, bj, At, Bt) do { __builtin_amdgcn_s_setprio(1); _Pragma("unroll") for (int m = 0; m < 4; ++m) _Pragma("unroll") for (int n = 0; n < 2; ++n) _Pragma("unroll") for (int k = 0; k < 2; ++k) \
        acc[ai][bj][m][n] = __builtin_amdgcn_mfma_f32_16x16x32_bf16(Bt[n][k], At[m][k], acc[ai][bj][m][n], 0, 0, 0); __builtin_amdgcn_s_setprio(0); } while (0)
#define PG8_WAIT_V(n) asm volatile("s_waitcnt vmcnt(" #n ")" ::: "memory")
#define PG8_WAIT_L(n) asm volatile("s_waitcnt lgkmcnt(" #n ")" ::: "memory")
#define PG8_BAR __builtin_amdgcn_s_barrier()
#define PG8_SCHED __builtin_amdgcn_sched_barrier(0)
    Unit cur, nxt; int ui = 0;
    if (!S.next(0, cur)) return;
    f32x4 acc[2][2][4][2];
#pragma unroll
    for (int a = 0; a < 2; ++a)
#pragma unroll
        for (int b = 0; b < 2; ++b)
#pragma unroll
            for (int m = 0; m < 4; ++m)
#pragma unroll
                for (int n = 0; n < 2; ++n) acc[a][b][m][n] = (f32x4){0.f, 0.f, 0.f, 0.f};
    bf16x8 At[4][2], B0[2][2], B1[2][2];
    const char* cA = (const char*)g.A + (size_t)cur.pm * tstep; const char* cB = (const char*)g.Bt + (size_t)cur.pn * tstep;
    S.a_ready(cur);
    if constexpr (SP2) {
        PG8_STAGE(PG8_SB(0, 0), cB, voffB); PG8_STAGE(PG8_SB(0, 1), cB + hstep, voffB); PG8_STAGE(PG8_SA(0, 0), cA, voffA); PG8_STAGE(PG8_SA(0, 1), cA + hstep, voffA);
        if (wr == 1) PG8_BAR;
        PG8_WAIT_V(2); PG8_BAR;
        PG8_STAGE(PG8_SB(1, 0), cB + kstep, voffB); PG8_STAGE(PG8_SA(1, 0), cA + kstep, voffA); PG8_STAGE(PG8_SB(1, 1), cB + hstep + kstep, voffB);
        PG8_WAIT_V(6); PG8_BAR;
    } else {
        PG8_STAGE(PG8_SB(0, 0), cB, voffB); PG8_STAGE(PG8_SA(0, 0), cA, voffA); PG8_STAGE(PG8_SB(0, 1), cB + hstep, voffB); PG8_STAGE(PG8_SA(0, 1), cA + hstep, voffA);
        if (wr == 1) PG8_BAR;
        PG8_WAIT_V(4); PG8_BAR;
        PG8_STAGE(PG8_SB(1, 0), cB + kstep, voffB); PG8_STAGE(PG8_SA(1, 0), cA + kstep, voffA); PG8_STAGE(PG8_SB(1, 1), cB + hstep + kstep, voffB);
        PG8_WAIT_V(6); PG8_BAR;
    }
    for (;;) {
        const bool has_next = S.next(ui + 1, nxt);
        const char* nA = has_next ? (const char*)g.A + (size_t)nxt.pm * tstep : cA; const char* nB = has_next ? (const char*)g.Bt + (size_t)nxt.pn * tstep : cB;
#pragma unroll 1
        for (int t = 0; t < nt; t += 2) {
            if constexpr (Epi::MIDHOOK) { if (t == nt / 2) E.mid(acc, cur, wr, wc, fr, fq); }
            const bool last = (t == nt - 2);
            const char* a1 = cA + (size_t)(t + 1) * kstep;
            const char* a2 = last ? nA : cA + (size_t)(t + 2) * kstep; const char* b2 = last ? nB : cB + (size_t)(t + 2) * kstep;
            const char* a3 = a2 + kstep; const char* b3 = b2 + kstep;
            if (last && has_next) S.a_ready(nxt);
            if constexpr (SP2) {
            PG8_LDB(B0, 0, 0); PG8_LDB(B1, 0, 1); PG8_SCHED; PG8_LDA(At, 0, 0); PG8_STAGE(PG8_SA(1, 1), a1 + hstep, voffA);
            PG8_WAIT_V(8); PG8_WAIT_L(0); PG8_BAR; PG8_MMA(0, 0, At, B0); PG8_MMA(0, 1, At, B1); PG8_BAR; PG8_SCHED;
            PG8_LDA(At, 0, 1); PG8_STAGE(PG8_SB(0, 0), b2, voffB); PG8_STAGE(PG8_SB(0, 1), b2 + hstep, voffB); PG8_STAGE(PG8_SA(0, 0), a2, voffA);
            PG8_WAIT_V(8); PG8_WAIT_L(0); PG8_BAR; PG8_MMA(1, 0, At, B0); PG8_MMA(1, 1, At, B1); PG8_BAR; PG8_SCHED;
            PG8_LDB(B0, 1, 0); PG8_LDB(B1, 1, 1); PG8_SCHED; PG8_LDA(At, 1, 0); PG8_STAGE(PG8_SA(0, 1), a2 + hstep, voffA);
            PG8_WAIT_V(8); PG8_WAIT_L(0); PG8_BAR; PG8_MMA(0, 0, At, B0); PG8_MMA(0, 1, At, B1); PG8_BAR; PG8_SCHED;
            PG8_LDA(At, 1, 1); PG8_STAGE(PG8_SB(1, 0), b3, voffB); PG8_STAGE(PG8_SB(1, 1), b3 + hstep, voffB); PG8_STAGE(PG8_SA(1, 0), a3, voffA);
            PG8_WAIT_V(8); PG8_WAIT_L(0); PG8_BAR; PG8_MMA(1, 0, At, B0); PG8_MMA(1, 1, At, B1); PG8_BAR; PG8_SCHED;
            } else {
            PG8_LDB(B0, 0, 0); PG8_SCHED; PG8_LDA(At, 0, 0); PG8_STAGE(PG8_SA(1, 1), a1 + hstep, voffA);
            PG8_WAIT_L(8); PG8_BAR; PG8_WAIT_L(0); PG8_MMA(0, 0, At, B0); PG8_BAR; PG8_SCHED;
            PG8_LDB(B1, 0, 1); PG8_STAGE(PG8_SB(0, 0), b2, voffB);
            PG8_BAR; PG8_WAIT_L(0); PG8_MMA(0, 1, At, B1); PG8_BAR;
            PG8_LDA(At, 0, 1); PG8_STAGE(PG8_SA(0, 0), a2, voffA);
            PG8_BAR; PG8_WAIT_L(0); PG8_MMA(1, 0, At, B0); PG8_BAR; PG8_SCHED;
            PG8_STAGE(PG8_SB(0, 1), b2 + hstep, voffB);
            PG8_WAIT_V(6); PG8_BAR; PG8_MMA(1, 1, At, B1); PG8_BAR;
            PG8_LDB(B0, 1, 0); PG8_SCHED; PG8_LDA(At, 1, 0); PG8_STAGE(PG8_SA(0, 1), a2 + hstep, voffA);
            PG8_WAIT_L(8); PG8_BAR; PG8_WAIT_L(0); PG8_MMA(0, 0, At, B0); PG8_BAR; PG8_SCHED;
            PG8_LDB(B1, 1, 1); PG8_STAGE(PG8_SB(1, 0), b3, voffB);
            PG8_BAR; PG8_WAIT_L(0); PG8_MMA(0, 1, At, B1); PG8_BAR;
            PG8_LDA(At, 1, 1); PG8_STAGE(PG8_SA(1, 0), a3, voffA);
            PG8_BAR; PG8_WAIT_L(0); PG8_MMA(1, 0, At, B0); PG8_BAR; PG8_SCHED;
            PG8_STAGE(PG8_SB(1, 1), b3 + hstep, voffB);
            PG8_WAIT_V(6); PG8_BAR; PG8_MMA(1, 1, At, B1); PG8_BAR;
            }
        }
        if constexpr (ALIGN_EPI) { if (wr == 0) PG8_BAR; }
        if constexpr (!Epi::AFTER_DRAIN) { E(acc, cur, wr, wc, fr, fq); S.done(cur); }
        if (!has_next) break;
#pragma unroll
        for (int a = 0; a < 2; ++a)
#pragma unroll
            for (int b = 0; b < 2; ++b)
#pragma unroll
                for (int m = 0; m < 4; ++m)
#pragma unroll
                    for (int n = 0; n < 2; ++n) acc[a][b][m][n] = (f32x4){0.f, 0.f, 0.f, 0.f};
        cur = nxt; cA = nA; cB = nB; ++ui;
        if constexpr (ALIGN_EPI) { if (wr == 1) PG8_BAR; }
    }
    PG8_WAIT_V(0);
    if constexpr (!ALIGN_EPI) { if (wr == 0) PG8_BAR; }
    PG8_BAR;
    if constexpr (Epi::AFTER_DRAIN) { E.fused(acc, cur, wr, wc, fr, fq, lds, wid, lane); S.done(cur); }
#undef PG8_SA
#undef PG8_SB
#undef PG8_STAGE
#undef PG8_LDA
#undef PG8_LDB
#undef PG8_MMA
#undef PG8_WAIT_V
#undef PG8_WAIT_L
#undef PG8_BAR
#undef PG8_SCHED
}
}

#define LAS __attribute__((address_space(3)))
typedef unsigned short bf16;
typedef float f32x4 __attribute__((ext_vector_type(4)));
typedef float f32x16 __attribute__((ext_vector_type(16)));
typedef short bf16x8 __attribute__((ext_vector_type(8)));
typedef unsigned u32x4 __attribute__((ext_vector_type(4)));
typedef unsigned u32x2 __attribute__((ext_vector_type(2)));

constexpr int NTOK = 65536, DM = 1024, DFF = 2816, SEQ = 2048, NBATCH = 32;
constexpr int NPAN = NTOK / 256;
constexpr float LN_EPS = 1e-5f, RMS_EPS = 1e-5f;
constexpr float DN_ALPHA = 1.189207115002721f;
constexpr float LAMBDA_INIT = 0.2f;
constexpr float QSCALE = 0.125f * 1.4426950408889634f;

constexpr size_t MiB = 1u << 20;
constexpr size_t WS_WGU1 = 0, WS_WD1 = 11 * MiB, WS_WIN = 17 * MiB, WS_WBA = 25 * MiB, WS_WBP = 26 * MiB, WS_WOUT = 27 * MiB, WS_WGU2 = 29 * MiB, WS_WD2 = 40 * MiB;
constexpr size_t WS_COS = 46 * MiB, WS_SIN = 46 * MiB + 256 * 1024;
constexpr size_t WS_XB = 48 * MiB;
constexpr size_t WS_YATT = WS_XB, WS_POOL = WS_XB + 64 * MiB;
constexpr size_t WS_X1F = 176 * MiB;
constexpr size_t WS_R1 = 432 * MiB;
constexpr size_t WS_Q = WS_R1, WS_K = WS_R1 + 64 * MiB, WS_VT = WS_R1 + 128 * MiB, WS_U = WS_R1 + 192 * MiB;
constexpr size_t WS_R2 = 784 * MiB;
constexpr size_t WS_O1S = 912 * MiB;
constexpr size_t WS_BAR = 944 * MiB;
constexpr size_t WS_END = 976 * MiB;
constexpr int LDS_BYTES = 139264;

__device__ __forceinline__ unsigned f2bf(float f) { unsigned u = __builtin_bit_cast(unsigned, f); return (u + 0x7fffu + ((u >> 16) & 1u)) >> 16; }
__device__ __forceinline__ unsigned pk2(float lo, float hi) { return f2bf(lo) | (f2bf(hi) << 16); }
__device__ __forceinline__ float wave_sum(float v) {
#pragma unroll
    for (int o = 1; o < 64; o <<= 1) v += __shfl_xor(v, o);
    return v;
}
__device__ __forceinline__ float swap_max(float m) { auto rr = __builtin_amdgcn_permlane32_swap(__float_as_uint(m), __float_as_uint(m), false, false); return fmaxf(__uint_as_float(rr[0]), __uint_as_float(rr[1])); }
__device__ __forceinline__ float swap_sum(float m) { auto rr = __builtin_amdgcn_permlane32_swap(__float_as_uint(m), __float_as_uint(m), false, false); return __uint_as_float(rr[0]) + __uint_as_float(rr[1]); }

struct MapOff { int off; __device__ __forceinline__ int operator()(int n) const { return off + n; } };
struct MapGateUp { int half; __device__ __forceinline__ int operator()(int n) const { return 256 * (n >> 7) + (n & 127) + 128 * half; } };
struct MapWin { __device__ __forceinline__ int operator()(int n) const {
    if (n < 1024) { const int t = n >> 8, r = n & 255, s = r >> 6, w = r & 63, hf = w >> 5, i = w & 31; return 256 * t + 128 * hf + 32 * s + i; }
    if (n < 1536) return 3584 + (n - 1024);
    if (n < 2048) return 1024 + (n - 1536);
    { const int c = n - 2048, br = c >> 10, j = c & 1023; return 1536 + 256 * (j >> 7) + 128 * br + (j & 127); } } };
template <class MAP>
__device__ __forceinline__ void transpose_item(const float* __restrict__ W, int K, int N, bf16* __restrict__ WT, const MAP map, LAS float* scr, int item, int lane, int ldw = 0) {
    if (ldw == 0) ldw = K;
    const int nblk = N / 32, kb = item / nblk, nb = item % nblk, k0 = 64 * kb, n0 = 32 * nb;
#pragma unroll 8
    for (int i = 0; i < 32; ++i) { const int kk = 2 * i + (lane >> 5); scr[kk * 33 + (lane & 31)] = W[(size_t)(k0 + kk) * N + n0 + (lane & 31)]; }
    asm volatile("s_waitcnt lgkmcnt(0)" ::: "memory");
    const int c = lane & 7;
#pragma unroll
    for (int j = 0; j < 4; ++j) { const int n = (lane >> 3) + 8 * j; const LAS float* s = scr + (8 * c) * 33 + n;
        u32x4 o; o.x = pk2(s[0 * 33], s[1 * 33]); o.y = pk2(s[2 * 33], s[3 * 33]); o.z = pk2(s[4 * 33], s[5 * 33]); o.w = pk2(s[6 * 33], s[7 * 33]);
        *(u32x4*)(WT + (size_t)map(n0 + n) * ldw + k0 + 8 * c) = o; }
    asm volatile("s_waitcnt lgkmcnt(0)" ::: "memory");
}

#define XB_TMO      128
#define XB_XCNT(j)  (256  + 64 * (j))
#define XB_XSUB(j)  (1280 + 64 * (j))
#define XB_XGEN(j)  (2304 + 64 * (j))
#define XB_TOP      3328
#define XB_TOPGEN   3392
#define XCD_BAR_WORDS 3456
#define XB_SPIN_CAP (1u << 18)

__device__ __forceinline__ unsigned xb_ld(unsigned* p)              { return __hip_atomic_load(p, __ATOMIC_RELAXED, __HIP_MEMORY_SCOPE_AGENT); }
__device__ __forceinline__ unsigned xb_add(unsigned* p, unsigned v) { return __hip_atomic_fetch_add(p, v, __ATOMIC_RELAXED, __HIP_MEMORY_SCOPE_AGENT); }
__device__ __forceinline__ unsigned xb_xcc_id() { return (unsigned)__builtin_amdgcn_s_getreg((3 << 11) | 20) & 0xFu; }
#define XB_SPIN(cond, bar) do { unsigned _sp = 0; while (cond) { __builtin_amdgcn_s_sleep(1); \
    if ((++_sp & 255u) == 0u) { if (xb_ld(&(bar)[XB_TMO])) break; if (_sp > XB_SPIN_CAP) { atomicAdd(&(bar)[XB_TMO], 1u); break; } } } } while (0)

struct XcdBarrier {
    unsigned* bar; unsigned x;
    volatile LAS unsigned* st;
};

__device__ __forceinline__ XcdBarrier xcd_barrier_post(unsigned* bar, volatile LAS unsigned* st) {
    XcdBarrier b; b.bar = bar; b.x = xb_xcc_id(); b.st = st;
    if (threadIdx.x == 0) (void)xb_add(&bar[XB_XCNT(b.x)], 1u);
    return b;
}
__device__ __forceinline__ void xcd_barrier_complete(unsigned* bar, unsigned x, unsigned& nloc, unsigned& nx) {
    const unsigned G = gridDim.x * gridDim.y * gridDim.z;
    unsigned sum, cnt, mine, sp = 0u;
    for (;;) {
        sum = 0u; cnt = 0u; mine = 0u;
#pragma unroll
        for (unsigned j = 0; j < 16; ++j) { const unsigned c = xb_ld(&bar[XB_XCNT(j)]); sum += c; cnt += (c > 0u) ? 1u : 0u; mine = (j == x) ? c : mine; }
        if (sum == G) break;
        __builtin_amdgcn_s_sleep(1);
        if ((++sp & 255u) == 0u) { if (xb_ld(&bar[XB_TMO])) break; if (sp > XB_SPIN_CAP) { atomicAdd(&bar[XB_TMO], 1u); break; } }
    }
    nloc = mine > 0u ? mine : 1u; nx = cnt > 0u ? cnt : 1u;
}

__device__ __forceinline__ void xcd_barrier(const XcdBarrier& b) {
    asm volatile("s_waitcnt vmcnt(0)" ::: "memory");
    __syncthreads();
    if (threadIdx.x == 0) {
        unsigned* bar = b.bar;
        __builtin_amdgcn_s_waitcnt(0);
        unsigned nloc = b.st[0], nx = b.st[1];
        if (nloc == 0u) { xcd_barrier_complete(bar, b.x, nloc, nx); b.st[0] = nloc; b.st[1] = nx; }
        const unsigned old = xb_add(&bar[XB_XSUB(b.x)], 1u);
        const unsigned gen = old / nloc;
        if (old + 1u == (gen + 1u) * nloc) {
            __builtin_amdgcn_fence(__ATOMIC_RELEASE, "agent");
            asm volatile("s_waitcnt vmcnt(0)" ::: "memory");
            const unsigned og = xb_add(&bar[XB_TOP], 1u);
            const unsigned tg = og / nx;
            if (og + 1u == (tg + 1u) * nx) xb_add(&bar[XB_TOPGEN], 1u);
            else XB_SPIN(xb_ld(&bar[XB_TOPGEN]) == tg, bar);
            __builtin_amdgcn_fence(__ATOMIC_ACQUIRE, "agent");
            xb_add(&bar[XB_XGEN(b.x)], 1u);
            asm volatile("s_waitcnt vmcnt(0)" ::: "memory");
        } else {
            XB_SPIN(xb_ld(&bar[XB_XGEN(b.x)]) == gen, bar);
            __builtin_amdgcn_fence(__ATOMIC_ACQUIRE, "agent");
            asm volatile("s_waitcnt vmcnt(0)" ::: "memory");
        }
    }
    __syncthreads();
}

struct Args { const float* in[24]; float* out; unsigned char* ws; int ph_lo, ph_hi, rep_mask, pad; };

__device__ __forceinline__ void ln_panel(const bf16* Y, float* Xf, bf16* Xb, const float* g, const float* bta, int pm, int wid, int lane) {
    asm volatile("" : "+s"(g), "+s"(bta));
    f32x4 gv[4], bv[4];
#pragma unroll
    for (int j = 0; j < 2; ++j)
#pragma unroll
        for (int n = 0; n < 2; ++n) { gv[2 * j + n] = *(const f32x4*)(g + 8 * lane + 512 * j + 4 * n); bv[2 * j + n] = *(const f32x4*)(bta + 8 * lane + 512 * j + 4 * n); }
    constexpr int RB = 4;
#pragma unroll 1
    for (int r = 0; r < 32; r += RB) {
        const size_t row0 = (size_t)pm * 256 + wid * 32 + r;
        u32x4 raw[RB][2]; f32x4 v[RB][4]; float s[RB];
#pragma unroll
        for (int q = 0; q < RB; ++q)
#pragma unroll
            for (int j = 0; j < 2; ++j) raw[q][j] = *(const u32x4*)(Y + (row0 + q) * 1024 + 8 * lane + 512 * j);
#pragma unroll
        for (int q = 0; q < RB; ++q) { s[q] = 0.f;
#pragma unroll
            for (int j = 0; j < 2; ++j) pg8::unpack8(raw[q][j], v[q][2 * j], v[q][2 * j + 1]);
#pragma unroll
            for (int j = 0; j < 4; ++j) s[q] += (v[q][j][0] + v[q][j][1]) + (v[q][j][2] + v[q][j][3]); }
#pragma unroll
        for (int o = 1; o < 64; o <<= 1)
#pragma unroll
            for (int q = 0; q < RB; ++q) s[q] += __shfl_xor(s[q], o);
        float s2[RB];
#pragma unroll
        for (int q = 0; q < RB; ++q) { const float mean = s[q] * (1.0f / 1024.0f); s2[q] = 0.f;
#pragma unroll
            for (int j = 0; j < 4; ++j) { v[q][j] = v[q][j] - mean; s2[q] += (v[q][j][0] * v[q][j][0] + v[q][j][1] * v[q][j][1]) + (v[q][j][2] * v[q][j][2] + v[q][j][3] * v[q][j][3]); } }
#pragma unroll
        for (int o = 1; o < 64; o <<= 1)
#pragma unroll
            for (int q = 0; q < RB; ++q) s2[q] += __shfl_xor(s2[q], o);
#pragma unroll
        for (int q = 0; q < RB; ++q) { const float rstd = 1.0f / sqrtf(s2[q] * (1.0f / 1024.0f) + LN_EPS); const size_t row = row0 + q;
#pragma unroll
            for (int j = 0; j < 2; ++j) { const f32x4 o0 = v[q][2 * j] * rstd * gv[2 * j] + bv[2 * j], o1 = v[q][2 * j + 1] * rstd * gv[2 * j + 1] + bv[2 * j + 1];
                if (Xf) { *(f32x4*)(Xf + row * 1024 + 8 * lane + 512 * j) = o0; *(f32x4*)(Xf + row * 1024 + 8 * lane + 512 * j + 4) = o1; }
                if (Xb) *(u32x4*)(Xb + row * 1024 + 8 * lane + 512 * j) = pg8::pack8(o0, o1); } }
    }
}

struct AttnState { float mrun, l; };
#define DSR128(dst, addr, off) asm volatile("ds_read_b128 %0, %1 offset:%2" : "=&v"(dst) : "v"(addr), "i"(off))
template <bool FIRST, bool HAS_PREV>
__device__ __forceinline__ void attn_step(f32x16& c0, f32x16& c1, f32x16 (&o)[4], bf16x8 (&pbp)[4], const bf16x8 (&qr)[4], AttnState& st,
                                          const LAS unsigned char* kfr, const LAS unsigned char* vfr, const int (&kofs)[4], const int (&vofs)[4]) {
    const unsigned kb_ = (unsigned)(unsigned long)kfr, vb_ = (unsigned)(unsigned long)vfr;
    unsigned ka[4], va[4];
#pragma unroll
    for (int k = 0; k < 4; ++k) { ka[k] = kb_ + (unsigned)kofs[k]; va[k] = vb_ + (unsigned)vofs[k]; }
    bf16x8 kf[4], vA[4], vB[4];
    { const float nm = FIRST ? 0.f : -st.mrun;
#pragma unroll
      for (int i = 0; i < 16; ++i) { c0[i] = nm; c1[i] = nm; } }
#pragma unroll
    for (int ks = 0; ks < 2; ++ks) { DSR128(kf[2 * ks], ka[ks], 0); DSR128(kf[2 * ks + 1], ka[ks], 4096); }
    asm volatile("s_waitcnt lgkmcnt(0)" : "+v"(kf[0]), "+v"(kf[1]), "+v"(kf[2]), "+v"(kf[3]));
#pragma unroll
    for (int ks = 0; ks < 2; ++ks) {
        c0 = __builtin_amdgcn_mfma_f32_32x32x16_bf16(kf[2 * ks], qr[ks], c0, 0, 0, 0);
        c1 = __builtin_amdgcn_mfma_f32_32x32x16_bf16(kf[2 * ks + 1], qr[ks], c1, 0, 0, 0);
    }
    __builtin_amdgcn_sched_barrier(0);
    { bf16x8 kg[4];
#pragma unroll
      for (int ks = 0; ks < 2; ++ks) { DSR128(kg[2 * ks], ka[2 + ks], 0); DSR128(kg[2 * ks + 1], ka[2 + ks], 4096); }
      asm volatile("s_waitcnt lgkmcnt(0)" : "+v"(kg[0]), "+v"(kg[1]), "+v"(kg[2]), "+v"(kg[3]));
#pragma unroll
      for (int ks = 0; ks < 2; ++ks) {
          c0 = __builtin_amdgcn_mfma_f32_32x32x16_bf16(kg[2 * ks], qr[2 + ks], c0, 0, 0, 0);
          c1 = __builtin_amdgcn_mfma_f32_32x32x16_bf16(kg[2 * ks + 1], qr[2 + ks], c1, 0, 0, 0);
      } }
    __builtin_amdgcn_sched_barrier(0);
    if (HAS_PREV) {
#pragma unroll
        for (int e = 0; e < 4; ++e) DSR128(vA[e], va[0], e * 4096);
    }
    float mx = fmaxf(c0[0], c1[0]);
#pragma unroll
    for (int i = 1; i < 16; ++i) mx = fmaxf(mx, fmaxf(c0[i], c1[i]));
    mx = swap_max(mx);
    float a = 1.0f;
    { const float dl = FIRST ? mx : ((mx > 8.0f) ? mx : 0.f);
      if (FIRST || __any(dl != 0.f)) {
#pragma unroll
          for (int i = 0; i < 16; ++i) { c0[i] -= dl; c1[i] -= dl; }
          st.mrun += dl; if (!FIRST) a = __builtin_amdgcn_exp2f(-dl);
      } }
    float ps = 0.f;
#define ATT_EXPS(E) do { _Pragma("unroll") for (int j = 0; j < 8; ++j) { const int i = (E) * 8 + j; \
        if (i < 16) { c0[i] = __builtin_amdgcn_exp2f(c0[i]); ps += c0[i]; } else { c1[i - 16] = __builtin_amdgcn_exp2f(c1[i - 16]); ps += c1[i - 16]; } } \
        asm volatile("" : "+v"(c0), "+v"(c1), "+v"(ps)); __builtin_amdgcn_sched_barrier(0); } while (0)
#define ATT_PV(KK, VF) do { _Pragma("unroll") for (int e = 0; e < 4; ++e) o[e] = __builtin_amdgcn_mfma_f32_32x32x16_bf16(VF[e], pbp[KK], o[e], 0, 0, 0); } while (0)
#define ATT_TIE(N, VF) asm volatile("s_waitcnt lgkmcnt(" #N ")" : "+v"(VF[0]), "+v"(VF[1]), "+v"(VF[2]), "+v"(VF[3]))
    if (HAS_PREV) {
        __builtin_amdgcn_sched_barrier(0);
#pragma unroll
        for (int e = 0; e < 4; ++e) DSR128(vB[e], va[1], e * 4096);
        ATT_TIE(4, vA); ATT_PV(0, vA); ATT_EXPS(0);
#pragma unroll
        for (int e = 0; e < 4; ++e) DSR128(vA[e], va[2], e * 4096);
        ATT_TIE(4, vB); ATT_PV(1, vB); ATT_EXPS(1);
#pragma unroll
        for (int e = 0; e < 4; ++e) DSR128(vB[e], va[3], e * 4096);
        ATT_TIE(4, vA); ATT_PV(2, vA); ATT_EXPS(2);
        ATT_TIE(0, vB); ATT_PV(3, vB); ATT_EXPS(3);
    } else {
#pragma unroll
        for (int i = 0; i < 16; ++i) { c0[i] = __builtin_amdgcn_exp2f(c0[i]); ps += c0[i]; c1[i] = __builtin_amdgcn_exp2f(c1[i]); ps += c1[i]; }
    }
#undef ATT_EXPS
#undef ATT_PV
#undef ATT_TIE
    st.l = st.l * a + ps;
    if (!FIRST) { if (__any(a != 1.0f)) {
#pragma unroll
        for (int e = 0; e < 4; ++e)
#pragma unroll
            for (int i = 0; i < 16; ++i) o[e][i] *= a; } }
    { u32x4 w;
      w.x = pg8::cvt_pk_bf16(c0[0], c0[1]); w.y = pg8::cvt_pk_bf16(c0[2], c0[3]); w.z = pg8::cvt_pk_bf16(c0[4], c0[5]); w.w = pg8::cvt_pk_bf16(c0[6], c0[7]); pbp[0] = __builtin_bit_cast(bf16x8, w);
      w.x = pg8::cvt_pk_bf16(c0[8], c0[9]); w.y = pg8::cvt_pk_bf16(c0[10], c0[11]); w.z = pg8::cvt_pk_bf16(c0[12], c0[13]); w.w = pg8::cvt_pk_bf16(c0[14], c0[15]); pbp[1] = __builtin_bit_cast(bf16x8, w);
      w.x = pg8::cvt_pk_bf16(c1[0], c1[1]); w.y = pg8::cvt_pk_bf16(c1[2], c1[3]); w.z = pg8::cvt_pk_bf16(c1[4], c1[5]); w.w = pg8::cvt_pk_bf16(c1[6], c1[7]); pbp[2] = __builtin_bit_cast(bf16x8, w);
      w.x = pg8::cvt_pk_bf16(c1[8], c1[9]); w.y = pg8::cvt_pk_bf16(c1[10], c1[11]); w.z = pg8::cvt_pk_bf16(c1[12], c1[13]); w.w = pg8::cvt_pk_bf16(c1[14], c1[15]); pbp[3] = __builtin_bit_cast(bf16x8, w); }
}
__device__ __forceinline__ void attn_unit(LAS unsigned char* lds, const bf16* __restrict__ Qb, const bf16* __restrict__ Kb, const bf16* __restrict__ VT, bf16* __restrict__ Y,
                                          const float* __restrict__ gsub, float lam, int b, int h, int qb, float* o1scr) {
    int tid_ = threadIdx.x; asm volatile("" : "+v"(tid_));
    const int tid = tid_, lane = tid & 63, wid = __builtin_amdgcn_readfirstlane(tid >> 6), r32 = lane & 31, hi = lane >> 5;
    const size_t tok0 = (size_t)b * SEQ;
    constexpr int KSL = 8192, VSL = 16384, VB0 = 3 * KSL;
    const int kap = 16 * ((r32 >> 4) & 1) + 8 * ((r32 >> 2) & 1) + 4 * ((r32 >> 3) & 1) + (r32 & 3);
    int kofs[4], vofs[4];
#pragma unroll
    for (int k = 0; k < 4; ++k) { kofs[k] = kap * 128 + (((2 * k + hi) ^ ((kap >> 1) & 7)) << 4); vofs[k] = r32 * 128 + (((2 * k + hi) ^ ((r32 >> 1) & 7)) << 4); }
    const int lrow = tid >> 3, lc = (tid & 7) ^ ((lrow >> 1) & 7);
    const int kcol = (lc < 4) ? 8 * lc : 128 + 8 * (lc - 4);
    const unsigned wofs = (unsigned)wid * 1024u;
    f32x16 o[4]; float inv = 0.f;
#define ATT_WAITBAR(N) do { asm volatile("s_waitcnt vmcnt(" #N ") lgkmcnt(0)" ::: "memory"); __builtin_amdgcn_s_barrier(); asm volatile("" ::: "memory"); } while (0)
#define ATT_DMA(src, ldsoff) __builtin_amdgcn_global_load_lds((const unsigned*)(src), (LAS unsigned*)(lds + (ldsoff) + wofs), 16, 0, 0)
#pragma unroll 1
    for (int mp = 0; mp < 2; ++mp) {
        const int c1 = 256 * (h >> 1) + 32 * (2 * (h & 1) + mp);
        const bf16* qp = Qb + (tok0 + (size_t)qb * 256 + wid * 32 + r32) * 512 + c1 + 8 * hi;
        bf16x8 qr[4];
        qr[0] = *(const bf16x8*)(qp); qr[1] = *(const bf16x8*)(qp + 16); qr[2] = *(const bf16x8*)(qp + 128); qr[3] = *(const bf16x8*)(qp + 144);
        const bf16* kp = Kb + (tok0 + lrow) * 512 + c1 + kcol;
        const bf16* vp = VT + ((size_t)((b * 4 + h) * 32) * 128 + lrow) * 64 + lc * 8;
        ATT_DMA(kp, 0); ATT_DMA(vp, VB0); ATT_DMA(vp + 4096, VB0 + 8192); ATT_DMA(kp + (size_t)64 * 512, KSL);
        ATT_WAITBAR(0);
#pragma unroll
        for (int e = 0; e < 4; ++e)
#pragma unroll
            for (int i = 0; i < 16; ++i) o[e][i] = 0.f;
        AttnState st; st.mrun = 0.f; st.l = 0.f;
        bf16x8 pbp[4];
        f32x16 sA, sB;
        int s0 = 0, s1 = 1, s2 = 2;
#define ATT_STEP(T, FIRST, HASP) do { const int t_ = (T); \
        if (t_ + 2 < 32) ATT_DMA(kp + (size_t)(t_ + 2) * 64 * 512, s2 * KSL); \
        if (t_ + 1 < 32) { ATT_DMA(vp + (size_t)(t_ + 1) * 8192, VB0 + s1 * VSL); ATT_DMA(vp + (size_t)(t_ + 1) * 8192 + 4096, VB0 + s1 * VSL + 8192); } \
        attn_step<FIRST, HASP>(sA, sB, o, pbp, qr, st, lds + s0 * KSL, lds + VB0 + s2 * VSL, kofs, vofs); \
        if (t_ + 2 < 32) ATT_WAITBAR(3); else ATT_WAITBAR(0); \
        { const int tmp_ = s0; s0 = s1; s1 = s2; s2 = tmp_; } } while (0)
        ATT_STEP(0, true, false);
#pragma unroll 1
        for (int t = 1; t < 32; ++t) ATT_STEP(t, false, true);
#undef ATT_STEP
        { const LAS unsigned char* vb = lds + VB0 + 1 * VSL;
#pragma unroll
          for (int e = 0; e < 4; ++e)
#pragma unroll
              for (int kk = 0; kk < 4; ++kk) { const bf16x8 vf = *(const LAS bf16x8*)(vb + e * 4096 + vofs[kk]);
                  o[e] = __builtin_amdgcn_mfma_f32_32x32x16_bf16(vf, pbp[kk], o[e], 0, 0, 0); } }
        ATT_WAITBAR(0);
        inv = 1.0f / swap_sum(st.l);
        if (mp == 0) {
#pragma unroll
            for (int e = 0; e < 4; ++e)
#pragma unroll
                for (int a = 0; a < 4; ++a) { f32x4 v = {o[e][4 * a] * inv, o[e][4 * a + 1] * inv, o[e][4 * a + 2] * inv, o[e][4 * a + 3] * inv};
                    *(f32x4*)(o1scr + ((size_t)(e * 4 + a) * 512 + tid) * 4) = v; }
        }
    }
#undef ATT_WAITBAR
#undef ATT_DMA
    {
        const float li = lam * inv; float ss = 0.f;
#pragma unroll
        for (int e = 0; e < 4; ++e)
#pragma unroll
            for (int a = 0; a < 4; ++a) { const f32x4 v1 = *(const f32x4*)(o1scr + ((size_t)(e * 4 + a) * 512 + tid) * 4);
#pragma unroll
                for (int k = 0; k < 4; ++k) { const float v = v1[k] - li * o[e][4 * a + k]; o[e][4 * a + k] = v; ss += v * v; } }
        ss = swap_sum(ss);
        const float rs = (1.0f - LAMBDA_INIT) / sqrtf(ss * (1.0f / 128.0f) + RMS_EPS);
        bf16* yp = Y + (tok0 + (size_t)qb * 256 + wid * 32 + r32) * 1024 + h * 128 + 4 * hi;
#pragma unroll
        for (int e = 0; e < 4; ++e)
#pragma unroll
            for (int a = 0; a < 4; ++a) { const f32x4 gg = *(const f32x4*)(gsub + 32 * e + 8 * a + 4 * hi);
                u32x2 w; w.x = pk2(o[e][4 * a] * rs * gg[0], o[e][4 * a + 1] * rs * gg[1]); w.y = pk2(o[e][4 * a + 2] * rs * gg[2], o[e][4 * a + 3] * rs * gg[3]);
                *(u32x2*)(yp + 32 * e + 8 * a) = w; }
    }
}

constexpr int NPHASE = 12;
__global__ void __launch_bounds__(512, 2) fwd_mega(Args a) {
    extern __shared__ __attribute__((aligned(16))) unsigned char lds_raw[];
    LAS unsigned char* lds = (LAS unsigned char*)lds_raw;
    cg::grid_group grid = cg::this_grid();
    const int tid = threadIdx.x, lane = tid & 63, wid = __builtin_amdgcn_readfirstlane(tid >> 6);
    const int G = gridDim.x, bx = blockIdx.x;
    const int lo = a.ph_lo, hi = a.ph_hi;
    const bool fused = (hi - lo) > 1;
    volatile LAS unsigned* MISC = (volatile LAS unsigned*)(lds + 131072 + 512);
    if (tid < 4) MISC[tid] = 0u;
    __syncthreads();
    XcdBarrier xbar; xbar.bar = (unsigned*)(a.ws + WS_BAR); xbar.x = 0; xbar.st = MISC;
    if (fused) xbar = xcd_barrier_post((unsigned*)(a.ws + WS_BAR), MISC);
    if (a.ph_lo < 0) grid.sync();
    unsigned char* ws = a.ws;
    const float* x = a.in[0];
    bf16* Wgu1 = (bf16*)(ws + WS_WGU1); bf16* Wd1 = (bf16*)(ws + WS_WD1); bf16* Win = (bf16*)(ws + WS_WIN); bf16* Wba = (bf16*)(ws + WS_WBA); bf16* Wbp = (bf16*)(ws + WS_WBP);
    bf16* Wout = (bf16*)(ws + WS_WOUT); bf16* Wgu2 = (bf16*)(ws + WS_WGU2); bf16* Wd2 = (bf16*)(ws + WS_WD2);
    float* cosT = (float*)(ws + WS_COS); float* sinT = (float*)(ws + WS_SIN);
    bf16* XB = (bf16*)(ws + WS_XB); bf16* YATT = (bf16*)(ws + WS_YATT); bf16* POOL = (bf16*)(ws + WS_POOL);
    bf16* Y1 = (bf16*)(ws + WS_X1F);
    bf16* X1B = (bf16*)a.out;
    bf16* HB = (bf16*)(ws + WS_R1); bf16* QB = (bf16*)(ws + WS_Q); bf16* KB = (bf16*)(ws + WS_K); bf16* VTB = (bf16*)(ws + WS_VT); bf16* UB = (bf16*)(ws + WS_U);
    bf16* TB = (bf16*)(ws + WS_R1);
    bf16* MG = (bf16*)(ws + WS_R2);
    float* O1S = (float*)(ws + WS_O1S) + (size_t)bx * (512 * 64);
    bf16* GATE = (bf16*)(ws + WS_X1F);
    float* OUT = a.out;
#ifndef PHM
#define PHM 4095
#endif
#define IN_PH(k) ((((PHM) >> (k)) & 1) && lo <= (k) && (k) < hi)
#define REPS(k) (IN_PH(k) ? 1 + ((a.rep_mask >> (k)) & 1) : 0)
#define SEAM(k) do { if (lo <= (k) && (k) + 1 < hi) { xcd_barrier(xbar); } } while (0)
#define WG_HANDOFF() do { asm volatile("s_waitcnt vmcnt(0) lgkmcnt(0)" ::: "memory"); __syncthreads(); __builtin_amdgcn_fence(__ATOMIC_ACQUIRE, "agent"); asm volatile("s_waitcnt vmcnt(0)" ::: "memory"); } while (0)

    if (IN_PH(0)) {
        LAS float* scr = (LAS float*)(lds + wid * 16384);
        const int gw = bx * 8 + wid, NGW = G * 8;
        constexpr int I_GU = (DM / 64) * (DFF / 32), I_DN = (DFF / 64) * (DM / 32), I_IN = (DM / 64) * (4096 / 32), I_BA = (512 / 64) * (DM / 32), I_OUT = (DM / 64) * (DM / 32);
        constexpr int NITEMS = 4 * I_GU + 2 * I_DN + I_IN + I_BA + I_OUT;
        for (int it = gw; it < NITEMS; it += NGW) {
            int r = it;
            if (r < I_GU) { transpose_item(a.in[3], DM, DFF, Wgu1, MapGateUp{0}, scr, r, lane); continue; } r -= I_GU;
            if (r < I_GU) { transpose_item(a.in[4], DM, DFF, Wgu1, MapGateUp{1}, scr, r, lane); continue; } r -= I_GU;
            if (r < I_GU) { transpose_item(a.in[19], DM, DFF, Wgu2, MapGateUp{0}, scr, r, lane); continue; } r -= I_GU;
            if (r < I_GU) { transpose_item(a.in[20], DM, DFF, Wgu2, MapGateUp{1}, scr, r, lane); continue; } r -= I_GU;
            if (r < I_DN) { transpose_item(a.in[5], DFF, DM, Wd1, MapOff{0}, scr, r, lane); continue; } r -= I_DN;
            if (r < I_DN) { transpose_item(a.in[21], DFF, DM, Wd2, MapOff{0}, scr, r, lane); continue; } r -= I_DN;
            if (r < I_IN) { transpose_item(a.in[6], DM, 4096, Win, MapWin{}, scr, r, lane); continue; } r -= I_IN;
            if (r < I_BA) { transpose_item(a.in[14], 512, DM, Wba, MapOff{0}, scr, r, lane, 1024); continue; } r -= I_BA;
            transpose_item(a.in[16], DM, DM, Wout, MapOff{0}, scr, r, lane);
        }
        const size_t gt = (size_t)bx * 512 + tid, NT = (size_t)G * 512;
        { const float* pw = a.in[12]; const float* psc = a.in[13]; const float* wbp = a.in[15];
          for (int w = gw; w < 1024 * 8; w += NGW) { const int n = w & 1023, gc = (w >> 10) * 64 + lane, g = gc >> 7;
              float acc = 0.f;
              for (int d = 0; d < 128; ++d) acc += pw[(size_t)gc * 128 + d] * psc[g * 128 + d] * wbp[(size_t)(g * 128 + d) * 1024 + n];
              Wba[(size_t)n * 1024 + 512 + gc] = (bf16)f2bf(acc); } }
        for (size_t idx = gt; idx < (size_t)SEQ * 32; idx += NT) { const int i = (int)(idx & 31), pos = (int)(idx >> 5);
            const float inv = 1.0f / powf(10000.0f, (float)(2 * i) / 64.0f); const float ang = (float)pos * inv;
            cosT[idx] = cosf(ang); sinT[idx] = sinf(ang); }
#pragma unroll 4
        for (size_t idx = gt; idx < (size_t)NTOK * DM / 8; idx += NT) { const f32x4 v0 = *(const f32x4*)(x + idx * 8), v1 = *(const f32x4*)(x + idx * 8 + 4);
            u32x4 w; w.x = pk2(v0[0], v0[1]); w.y = pk2(v0[2], v0[3]); w.z = pk2(v1[0], v1[1]); w.w = pk2(v1[2], v1[3]); *(u32x4*)(XB + idx * 8) = w; }
        __syncthreads();
    }
    SEAM(0);
    if (IN_PH(1)) {
        pg8::Gemm g{XB, Wgu1, NTOK, 2 * DFF, DM}; pg8::StaticOrder S; S.init(NTOK, 2 * DFF, G, bx);
        pg8::EpiSwiglu E{HB, DFF};
        pg8::gemm_phase<pg8::EpiSwiglu, pg8::StaticOrder, true, true>(lds, g, S, E);
    }
    SEAM(1);
    if (IN_PH(2)) {
        pg8::Gemm g{HB, Wd1, NTOK, DM, DFF}; pg8::StaticOrder S; S.init(NTOK, DM, G, bx);
        pg8::EpiResid E{x, Y1, DN_ALPHA, 0.5f};
        pg8::gemm_phase<pg8::EpiResid, pg8::StaticOrder, true, true>(lds, g, S, E);
    }
    SEAM(2);
    if (IN_PH(3)) {
        for (int pm = bx; pm < NPAN; pm += G) ln_panel(Y1, nullptr, X1B, a.in[1], a.in[2], pm, wid, lane);
        __syncthreads();
    }
    SEAM(3);
    if (IN_PH(4)) {
        { pg8::Gemm g{X1B, Win, NTOK, 3584, DM}; pg8::StaticOrder S; S.init(NTOK, 3584, G, bx);
          pg8::EpiWin E{QB, KB, UB, GATE, cosT, sinT, QSCALE};
          pg8::gemm_phase<pg8::EpiWin, pg8::StaticOrder, true, true>(lds, g, S, E); }
        { pg8::Gemm g{Win + (size_t)3584 * DM, X1B, 512, NTOK, DM}; pg8::StaticOrder S; S.init(512, NTOK, G, bx);
          pg8::EpiVT E{VTB};
          pg8::gemm_phase<pg8::EpiVT, pg8::StaticOrder, true, true>(lds, g, S, E); }
    }
    SEAM(4);
    if (IN_PH(5)) {
        for (int item = bx * 512 + tid; item < NBATCH * 64 * 64; item += G * 512) {
            const int c8 = item & 63, seg = (item >> 6) & 63, bb = item >> 12;
            const int ch = c8 * 8, hw = 1 << (ch >> 7);
            const bf16* base = UB + (size_t)bb * SEQ * 512 + ch;
            bf16* obase = XB + (size_t)bb * SEQ * 1024 + 512 + ch;
            const int s0 = seg * 32;
            f32x4 w0 = {0.f, 0.f, 0.f, 0.f}, w1 = {0.f, 0.f, 0.f, 0.f};
            { const int jlo = (s0 - hw) > 0 ? (s0 - hw) : 0, jhi = (s0 + hw) < SEQ ? (s0 + hw) : SEQ;
              for (int j = jlo; j < jhi; ++j) { f32x4 a0, a1; pg8::unpack8(*(const u32x4*)(base + (size_t)j * 512), a0, a1); w0 += a0; w1 += a1; } }
#pragma unroll 4
            for (int s = s0; s < s0 + 32; ++s) {
                f32x4 u0, u1; pg8::unpack8(*(const u32x4*)(base + (size_t)s * 512), u0, u1);
                const int jlo = (s - hw) > 0 ? (s - hw) : 0, jhi = (s + hw) < SEQ ? (s + hw) : SEQ;
                const float rc = 1.0f / (float)(jhi - jlo);
                *(u32x4*)(obase + (size_t)s * 1024) = pg8::pack8(w0 * rc - u0, w1 * rc - u1);
                if (s + hw < SEQ) { f32x4 a0, a1; pg8::unpack8(*(const u32x4*)(base + (size_t)(s + hw) * 512), a0, a1); w0 += a0; w1 += a1; }
                if (s - hw >= 0) { f32x4 a0, a1; pg8::unpack8(*(const u32x4*)(base + (size_t)(s - hw) * 512), a0, a1); w0 -= a0; w1 -= a1; }
            }
        }
        float lam;
        { const float p1 = a.in[7][lane] * a.in[8][lane], p2 = a.in[9][lane] * a.in[10][lane];
          lam = expf(wave_sum(p1)) - expf(wave_sum(p2)) + LAMBDA_INIT; }
        if (G == 256) {
            const int xc = bx & 7, j = bx >> 3;
            for (int i = 0; i < 4; ++i) { const int bh = i * 32 + xc * 4 + (j >> 3), qb = j & 7;
                attn_unit(lds, QB, KB, VTB, YATT, a.in[11], lam, bh >> 2, bh & 3, qb, O1S); }
        } else {
            for (int u = bx; u < 1024; u += G) attn_unit(lds, QB, KB, VTB, YATT, a.in[11], lam, (u >> 3) >> 2, (u >> 3) & 3, u & 7, O1S);
        }
    }
    SEAM(5);
    if (IN_PH(6)) {
        pg8::Gemm g{XB, Wba, NTOK, DM, DM}; pg8::StaticOrder S; S.init(NTOK, DM, G, bx);
        pg8::EpiGateMid E{GATE, MG};
        pg8::gemm_phase<pg8::EpiGateMid, pg8::StaticOrder, true, true>(lds, g, S, E);
    }
    SEAM(6);
    if (IN_PH(7)) {
        pg8::Gemm g{MG, Wout, NTOK, DM, DM}; pg8::StaticOrder S; S.init(NTOK, DM, G, bx);
        pg8::EpiResidB E{X1B, TB, DN_ALPHA, 1.0f};
        pg8::gemm_phase<pg8::EpiResidB, pg8::StaticOrder, true, true>(lds, g, S, E);
    }
    SEAM(7);
    if (IN_PH(8)) {
        for (int pm = bx; pm < NPAN; pm += G) ln_panel(TB, nullptr, MG, a.in[17], a.in[18], pm, wid, lane);
        __syncthreads();
    }
    SEAM(8);
    if (IN_PH(9)) {
        pg8::Gemm g{MG, Wgu2, NTOK, 2 * DFF, DM}; pg8::StaticOrder S; S.init(NTOK, 2 * DFF, G, bx);
        pg8::EpiSwiglu E{HB, DFF};
        pg8::gemm_phase<pg8::EpiSwiglu, pg8::StaticOrder, true, true>(lds, g, S, E);
    }
    SEAM(9);
    if (IN_PH(10)) {
        pg8::Gemm g{HB, Wd2, NTOK, DM, DFF}; pg8::StaticOrder S; S.init(NTOK, DM, G, bx);
        pg8::EpiResidB E{MG, Y1, DN_ALPHA, 0.5f};
        pg8::gemm_phase<pg8::EpiResidB, pg8::StaticOrder, true, true>(lds, g, S, E);
    }
    SEAM(10);
    if (IN_PH(11)) {
        for (int pm = bx; pm < NPAN; pm += G) ln_panel(Y1, OUT, nullptr, a.in[22], a.in[23], pm, wid, lane);
    }
}

#ifndef REP_MASK
#define REP_MASK 0
#endif
#ifndef MK_N_LAUNCHES
#define MK_N_LAUNCHES 1
#endif
extern "C" void kernel_launch(void* const* d_in, const int* in_sizes, int n_in, void* d_out, int out_size, void* d_ws, size_t ws_size, hipStream_t stream) {
    static int grid = 0;
    if (grid == 0) {
        if (n_in != 24 || in_sizes[0] != NTOK * DM || out_size != NTOK * DM || ws_size < WS_END) { fprintf(stderr, "kernel_launch: unexpected shapes (n_in %d, ws %zu)\n", n_in, ws_size); grid = -1; return; }
        int dev = 0, cus = 0, per_cu = 0;
        hipGetDevice(&dev); hipDeviceGetAttribute(&cus, hipDeviceAttributeMultiprocessorCount, dev);
        if (hipFuncSetAttribute((const void*)fwd_mega, hipFuncAttributeMaxDynamicSharedMemorySize, LDS_BYTES) != hipSuccess) { fprintf(stderr, "kernel_launch: hipFuncSetAttribute failed\n"); grid = -1; return; }
        if (hipOccupancyMaxActiveBlocksPerMultiprocessor(&per_cu, (const void*)fwd_mega, 512, LDS_BYTES) != hipSuccess || per_cu < 1) { fprintf(stderr, "kernel_launch: occupancy query says %d\n", per_cu); per_cu = 1; }
        (void)hipGetLastError();
        grid = cus * per_cu;
    }
    if (grid < 0) return;
    Args a{};
    for (int i = 0; i < 24; ++i) a.in[i] = (const float*)d_in[i];
    a.out = (float*)d_out; a.ws = (unsigned char*)d_ws;
    (void)hipMemsetAsync((unsigned char*)d_ws + WS_BAR, 0, 16384, stream);
#if MK_N_LAUNCHES == 1
    a.ph_lo = 0; a.ph_hi = NPHASE; a.rep_mask = REP_MASK;
    void* args[] = {&a};
    hipError_t e = hipLaunchCooperativeKernel((const void*)fwd_mega, dim3(grid), dim3(512), args, LDS_BYTES, stream);
    if (e != hipSuccess) fprintf(stderr, "cooperative launch failed: %s (grid %d)\n", hipGetErrorString(e), grid);
#else
    for (int p = 0; p < NPHASE; ++p) { a.ph_lo = p; a.ph_hi = p + 1; hipLaunchKernelGGL(fwd_mega, dim3(grid), dim3(512), LDS_BYTES, stream, a); }
#endif
}
```

```cpp
#include <hip/hip_runtime.h>
#include <hip/hip_cooperative_groups.h>
#include <cstdio>
#include <cstdint>
namespace cg = cooperative_groups;
namespace pg8 {
#define PG8_LAS __attribute__((address_space(3)))
typedef unsigned short bf16_t;
typedef short bf16x8 __attribute__((ext_vector_type(8)));
typedef float f32x4 __attribute__((ext_vector_type(4)));
typedef unsigned u32x4 __attribute__((ext_vector_type(4)));
constexpr int BM = 256, BK = 64, HALF = 128, HTB = HALF * BK * 2  , STAGE_BYTES = 8 * HTB, NXCD = 8, WGM = 4;

__host__ __device__ __forceinline__ int lds_byte(int r, int c) { const int st = (r >> 4) * 2 + (c >> 5), rr = r & 15, cc = c & 31, ob = rr * 64 + cc * 2; return st * 1024 + (ob ^ (((ob >> 9) & 1) << 5)); }
__host__ __device__ __forceinline__ void stage_rc(int b, int& R, int& C) { const int st = b / 1024, sb = b % 1024, swz = sb ^ (((sb >> 9) & 1) << 5); R = (st >> 1) * 16 + swz / 64; C = (st & 1) * 32 + (swz % 64) / 2; }
__host__ __device__ __forceinline__ int perm32(int rho) { const int n = rho >> 4, i = rho & 15; return 8 * (i >> 2) + 4 * n + (i & 3); }

struct Unit { int pm, pn; };
struct Gemm { const bf16_t* A; const bf16_t* Bt; int M, N, K; };

struct StaticOrder {
    int nM, nN, nwg, G, c;
    __host__ __device__ void init(int M, int N, int G_, int c_) { nM = M / BM; nN = N / BM; nwg = nM * nN; G = G_; c = c_; }
    __host__ __device__ bool next(int i, Unit& u) const {
        const long L = (long)i * G + c; if (L >= nwg) return false;
        int wgid = (int)L; { const int q = nwg / NXCD, r = nwg % NXCD, xcd = wgid % NXCD, off = wgid / NXCD; wgid = (xcd < r ? xcd * (q + 1) : r * (q + 1) + (xcd - r) * q) + off; }
        const int nig = WGM * nN, gid = wgid / nig, fm = gid * WGM, gsz = (nM - fm) < WGM ? (nM - fm) : WGM;
        u.pm = fm + ((wgid % nig) % gsz); u.pn = (wgid % nig) / gsz; return true;
    }
    __device__ __forceinline__ void a_ready(const Unit&) const {}
    __device__ __forceinline__ void done(const Unit&) const {}
};

typedef float cvt_f32x2_t __attribute__((ext_vector_type(2))); typedef __bf16 cvt_bf16x2_t __attribute__((ext_vector_type(2)));
__device__ __forceinline__ unsigned cvt_pk_bf16(float lo, float hi) { cvt_f32x2_t v = {lo, hi}; cvt_bf16x2_t b = __builtin_convertvector(v, cvt_bf16x2_t); return __builtin_bit_cast(unsigned, b); }
typedef float f32x2 __attribute__((ext_vector_type(2)));
struct PanelOrder {
    int pm, npn;
    __device__ __forceinline__ bool next(int i, Unit& u) const { if (i >= npn) return false; int p = pm, q = i; asm volatile("" : "+s"(p), "+s"(q));
        u.pm = p; u.pn = q; return true; }
    __device__ __forceinline__ void a_ready(const Unit&) const {}
    __device__ __forceinline__ void done(const Unit&) const {}
};
__device__ __forceinline__ float fast_sigmoid(float v) { return __builtin_amdgcn_rcpf(1.0f + __builtin_amdgcn_exp2f(v * -1.4426950408889634f)); }
__device__ __forceinline__ u32x4 pack8(const f32x4 a, const f32x4 b) { u32x4 w; w.x = cvt_pk_bf16(a[0], a[1]); w.y = cvt_pk_bf16(a[2], a[3]); w.z = cvt_pk_bf16(b[0], b[1]); w.w = cvt_pk_bf16(b[2], b[3]); return w; }
__device__ __forceinline__ void unpack8(const u32x4 w, f32x4& a, f32x4& b) {
    a[0] = __uint_as_float(w.x << 16); a[1] = __uint_as_float(w.x & 0xffff0000u); a[2] = __uint_as_float(w.y << 16); a[3] = __uint_as_float(w.y & 0xffff0000u);
    b[0] = __uint_as_float(w.z << 16); b[1] = __uint_as_float(w.z & 0xffff0000u); b[2] = __uint_as_float(w.w << 16); b[3] = __uint_as_float(w.w & 0xffff0000u);
}
struct EpiPlain {
    static constexpr bool PERM = true, AFTER_DRAIN = false, MIDHOOK = false;
    bf16_t* O; size_t ldc;
    __device__ __forceinline__ void operator()(const f32x4 (&acc)[2][2][4][2], const Unit& u, int wr, int wc, int fr, int fq) const {
        const int row0 = u.pm * BM + wr * 64 + fr, col0 = u.pn * BM + wc * 32 + 8 * fq;
#pragma unroll
        for (int ai = 0; ai < 2; ++ai)
#pragma unroll
            for (int m = 0; m < 4; ++m) { bf16_t* rowp = O + (size_t)(row0 + ai * HALF + m * 16) * ldc + col0;
#pragma unroll
                for (int bj = 0; bj < 2; ++bj) *(u32x4*)(rowp + bj * HALF) = pack8(acc[ai][bj][m][0], acc[ai][bj][m][1]); }
    }
};
struct EpiSwiglu {
    static constexpr bool PERM = true, AFTER_DRAIN = false, MIDHOOK = false;
    bf16_t* H; int ldh;
    __device__ __forceinline__ void operator()(const f32x4 (&acc)[2][2][4][2], const Unit& u, int wr, int wc, int fr, int fq) const {
        const int row0 = u.pm * BM + wr * 64 + fr, col0 = u.pn * HALF + wc * 32 + 8 * fq;
#pragma unroll
        for (int ai = 0; ai < 2; ++ai)
#pragma unroll
            for (int m = 0; m < 4; ++m) { f32x4 h[2];
#pragma unroll
                for (int n = 0; n < 2; ++n) { const f32x4 g = acc[ai][0][m][n], up = acc[ai][1][m][n];
#pragma unroll
                    for (int e = 0; e < 4; ++e) h[n][e] = g[e] * fast_sigmoid(g[e]) * up[e]; }
                __builtin_nontemporal_store(pack8(h[0], h[1]), (u32x4*)(H + (size_t)(row0 + ai * HALF + m * 16) * ldh + col0)); }
    }
};
struct EpiWin {
    static constexpr bool PERM = true, AFTER_DRAIN = false, MIDHOOK = false;
    bf16_t *Q, *K, *U, *G; const float* cosT; const float* sinT; float qscale;
    __device__ __forceinline__ void operator()(const f32x4 (&acc)[2][2][4][2], const Unit& u, int wr, int wc, int fr, int fq) const {
        const int row0 = u.pm * BM + wr * 64 + fr; const int pn = u.pn;
        if (pn < 4) {
            bf16_t* base = (pn < 2) ? Q : K; const float sc = (pn < 2) ? qscale : 1.0f; const int ct = (pn & 1) * BM + wc * 32 + 8 * fq;
#pragma unroll
            for (int ai = 0; ai < 2; ++ai)
#pragma unroll
                for (int mh = 0; mh < 2; ++mh) {
                    f32x4 cs[2][2], sn[2][2];
#pragma unroll
                    for (int mm = 0; mm < 2; ++mm) { const int pos = (row0 + ai * HALF + (mh * 2 + mm) * 16) & 2047;
#pragma unroll
                        for (int n = 0; n < 2; ++n) { cs[mm][n] = *(const f32x4*)(cosT + pos * 32 + 8 * fq + 4 * n); sn[mm][n] = *(const f32x4*)(sinT + pos * 32 + 8 * fq + 4 * n); } }
#pragma unroll
                    for (int mm = 0; mm < 2; ++mm) { const int m = mh * 2 + mm; const int row = row0 + ai * HALF + m * 16;
                        f32x4 o1[2], o2[2];
#pragma unroll
                        for (int n = 0; n < 2; ++n) { const f32x4 x1 = acc[ai][0][m][n], x2 = acc[ai][1][m][n];
                            o1[n] = (x1 * cs[mm][n] - x2 * sn[mm][n]) * sc; o2[n] = (x1 * sn[mm][n] + x2 * cs[mm][n]) * sc; }
                        bf16_t* rowp = base + (size_t)row * 512 + ct;
                        *(u32x4*)(rowp) = pack8(o1[0], o1[1]); *(u32x4*)(rowp + HALF) = pack8(o2[0], o2[1]); }
                    asm volatile("" ::: "memory"); }
        } else if (pn < 6) {
            const int col0 = (pn - 4) * BM + wc * 32 + 8 * fq;
#pragma unroll
            for (int ai = 0; ai < 2; ++ai)
#pragma unroll
                for (int m = 0; m < 4; ++m) { bf16_t* rowp = U + (size_t)(row0 + ai * HALF + m * 16) * 512 + col0;
#pragma unroll
                    for (int bj = 0; bj < 2; ++bj) *(u32x4*)(rowp + bj * HALF) = pack8(acc[ai][bj][m][0], acc[ai][bj][m][1]); }
        } else {
            const int col0 = (pn - 6) * BM + wc * 32 + 8 * fq;
#pragma unroll
            for (int ai = 0; ai < 2; ++ai)
#pragma unroll
                for (int m = 0; m < 4; ++m) { bf16_t* rowp = G + (size_t)(row0 + ai * HALF + m * 16) * 2048 + col0;
                    f32x4 rt[2], gp[2];
#pragma unroll
                    for (int n = 0; n < 2; ++n)
#pragma unroll
                        for (int e = 0; e < 4; ++e) { const float ea = 1.0f + __builtin_amdgcn_exp2f(acc[ai][0][m][n][e] * -1.4426950408889634f), ep = fminf(1.0f + __builtin_amdgcn_exp2f(acc[ai][1][m][n][e] * -1.4426950408889634f), 1e30f);
                            gp[n][e] = __builtin_amdgcn_rcpf(ep); rt[n][e] = ep * __builtin_amdgcn_rcpf(ea); }
                    *(u32x4*)(rowp) = pack8(rt[0], rt[1]); *(u32x4*)(rowp + HALF) = pack8(gp[0], gp[1]); }
        }
    }
};
struct EpiResid {
    static constexpr bool PERM = true, AFTER_DRAIN = false, MIDHOOK = false;
    const float* X; bf16_t* Y; float alpha, sc;
    __device__ __forceinline__ void operator()(const f32x4 (&acc)[2][2][4][2], const Unit& u, int wr, int wc, int fr, int fq) const {
        const int row0 = u.pm * BM + wr * 64 + fr, col0 = u.pn * BM + wc * 32 + 8 * fq;
#pragma unroll
        for (int ai = 0; ai < 2; ++ai)
#pragma unroll
            for (int mh = 0; mh < 2; ++mh) {
                f32x4 xr[2][2][2];
#pragma unroll
                for (int mm = 0; mm < 2; ++mm)
#pragma unroll
                    for (int bj = 0; bj < 2; ++bj)
#pragma unroll
                        for (int n = 0; n < 2; ++n) xr[mm][bj][n] = *(const f32x4*)(X + (size_t)(row0 + ai * HALF + (mh * 2 + mm) * 16) * 1024 + col0 + bj * HALF + 4 * n);
#pragma unroll
                for (int mm = 0; mm < 2; ++mm) { const int m = mh * 2 + mm; const size_t off = (size_t)(row0 + ai * HALF + m * 16) * 1024 + col0;
#pragma unroll
                    for (int bj = 0; bj < 2; ++bj) *(u32x4*)(Y + off + bj * HALF) = pack8(xr[mm][bj][0] * alpha + acc[ai][bj][m][0] * sc, xr[mm][bj][1] * alpha + acc[ai][bj][m][1] * sc); }
                asm volatile("" ::: "memory"); }
    }
};
struct EpiGate1 {
    static constexpr bool PERM = true, AFTER_DRAIN = false, MIDHOOK = false;
    const bf16_t* G; float* T;
    __device__ __forceinline__ void operator()(const f32x4 (&acc)[2][2][4][2], const Unit& u, int wr, int wc, int fr, int fq) const {
        const int row0 = u.pm * BM + wr * 64 + fr, col0 = u.pn * BM + wc * 32 + 8 * fq;
#pragma unroll
        for (int ai = 0; ai < 2; ++ai)
#pragma unroll
            for (int m = 0; m < 4; ++m) { const size_t row = (size_t)(row0 + ai * HALF + m * 16);
#pragma unroll
                for (int bj = 0; bj < 2; ++bj) { f32x4 ga, gb; unpack8(*(const u32x4*)(G + row * 2048 + col0 + bj * HALF), ga, gb);
                    float* tp = T + row * 1024 + col0 + bj * HALF;
                    *(f32x4*)(tp) = ga * acc[ai][bj][m][0]; *(f32x4*)(tp + 4) = gb * acc[ai][bj][m][1]; }
                asm volatile("" ::: "memory"); }
    }
};
struct EpiGate2 {
    static constexpr bool PERM = true, AFTER_DRAIN = false, MIDHOOK = false;
    const bf16_t* G; const float* T; bf16_t* Mg;
    __device__ __forceinline__ void operator()(const f32x4 (&acc)[2][2][4][2], const Unit& u, int wr, int wc, int fr, int fq) const {
        const int row0 = u.pm * BM + wr * 64 + fr, col0 = u.pn * BM + wc * 32 + 8 * fq;
#pragma unroll
        for (int ai = 0; ai < 2; ++ai)
#pragma unroll
            for (int m = 0; m < 4; ++m) { const size_t row = (size_t)(row0 + ai * HALF + m * 16);
#pragma unroll
                for (int bj = 0; bj < 2; ++bj) { f32x4 ga, gb; unpack8(*(const u32x4*)(G + row * 2048 + 1024 + col0 + bj * HALF), ga, gb);
                    const float* tp = T + row * 1024 + col0 + bj * HALF;
                    const f32x4 t0 = *(const f32x4*)(tp), t1 = *(const f32x4*)(tp + 4);
                    *(u32x4*)(Mg + row * 1024 + col0 + bj * HALF) = pack8(t0 + ga * acc[ai][bj][m][0], t1 + gb * acc[ai][bj][m][1]); }
                asm volatile("" ::: "memory"); }
    }
};
struct EpiVT {
    static constexpr bool PERM = true, AFTER_DRAIN = false, MIDHOOK = false;
    bf16_t* O;
    __device__ __forceinline__ void operator()(const f32x4 (&acc)[2][2][4][2], const Unit& u, int wr, int wc, int fr, int fq) const {
        const int row0 = u.pm * BM + wr * 64 + fr, col0 = u.pn * BM + wc * 32 + 8 * fq;
#pragma unroll
        for (int ai = 0; ai < 2; ++ai)
#pragma unroll
            for (int m = 0; m < 4; ++m) { const int vcol = row0 + ai * HALF + m * 16, h = vcol >> 7, e = vcol & 127;
#pragma unroll
                for (int bj = 0; bj < 2; ++bj) { const int tok = col0 + bj * HALF, b = tok >> 11, sq = tok & 2047, kt = sq >> 6, key = sq & 63;
                    *(u32x4*)(O + ((size_t)(((b * 4 + h) * 32 + kt) * 128 + e)) * 64 + key) = pack8(acc[ai][bj][m][0], acc[ai][bj][m][1]); } }
    }
};
struct EpiGateMid {
    static constexpr bool PERM = true, AFTER_DRAIN = false, MIDHOOK = true;
    const bf16_t* G; bf16_t* Mg;
    __device__ __forceinline__ void mid(f32x4 (&acc)[2][2][4][2], const Unit& u, int wr, int wc, int fr, int fq) const {
        int row0 = u.pm * BM + wr * 64 + fr, gc0 = u.pn * 512 + wc * 32 + 8 * fq;
        asm volatile("" : "+v"(row0), "+v"(gc0));
#pragma unroll
        for (int ai = 0; ai < 2; ++ai) {
            u32x4 rt[4][2];
#pragma unroll
            for (int m = 0; m < 4; ++m)
#pragma unroll
                for (int bj = 0; bj < 2; ++bj) rt[m][bj] = *(const u32x4*)(G + (size_t)(row0 + ai * HALF + m * 16) * 2048 + gc0 + bj * 256);
#pragma unroll
            for (int m = 0; m < 4; ++m)
#pragma unroll
                for (int bj = 0; bj < 2; ++bj) { f32x4 r0, r1; unpack8(rt[m][bj], r0, r1); acc[ai][bj][m][0] *= r0; acc[ai][bj][m][1] *= r1; }
            asm volatile("" ::: "memory"); }
    }
    __device__ __forceinline__ void operator()(const f32x4 (&acc)[2][2][4][2], const Unit& u, int wr, int wc, int fr, int fq) const {
        const int row0 = u.pm * BM + wr * 64 + fr, col0 = u.pn * BM + wc * 32 + 8 * fq, gc0 = u.pn * 512 + wc * 32 + 8 * fq + 128;
#pragma unroll
        for (int ai = 0; ai < 2; ++ai) {
            u32x4 gp[4][2];
#pragma unroll
            for (int m = 0; m < 4; ++m)
#pragma unroll
                for (int bj = 0; bj < 2; ++bj) gp[m][bj] = *(const u32x4*)(G + (size_t)(row0 + ai * HALF + m * 16) * 2048 + gc0 + bj * 256);
#pragma unroll
            for (int m = 0; m < 4; ++m) { const size_t row = (size_t)(row0 + ai * HALF + m * 16);
#pragma unroll
                for (int bj = 0; bj < 2; ++bj) { f32x4 p0, p1; unpack8(gp[m][bj], p0, p1);
                    *(u32x4*)(Mg + row * 1024 + col0 + bj * HALF) = pack8(acc[ai][bj][m][0] * p0, acc[ai][bj][m][1] * p1); } }
            asm volatile("" ::: "memory"); }
    }
};
struct EpiResidB {
    static constexpr bool PERM = true, AFTER_DRAIN = false, MIDHOOK = false;
    const bf16_t* X; bf16_t* Y; float alpha, sc;
    __device__ __forceinline__ void operator()(const f32x4 (&acc)[2][2][4][2], const Unit& u, int wr, int wc, int fr, int fq) const {
        const int row0 = u.pm * BM + wr * 64 + fr, col0 = u.pn * BM + wc * 32 + 8 * fq;
#pragma unroll
        for (int ai = 0; ai < 2; ++ai) {
            u32x4 xr[4][2];
#pragma unroll
            for (int m = 0; m < 4; ++m)
#pragma unroll
                for (int bj = 0; bj < 2; ++bj) xr[m][bj] = *(const u32x4*)(X + (size_t)(row0 + ai * HALF + m * 16) * 1024 + col0 + bj * HALF);
#pragma unroll
            for (int m = 0; m < 4; ++m) { const size_t off = (size_t)(row0 + ai * HALF + m * 16) * 1024 + col0;
#pragma unroll
                for (int bj = 0; bj < 2; ++bj) { f32x4 x0, x1; unpack8(xr[m][bj], x0, x1);
                    *(u32x4*)(Y + off + bj * HALF) = pack8(x0 * alpha + acc[ai][bj][m][0] * sc, x1 * alpha + acc[ai][bj][m][1] * sc); } }
            asm volatile("" ::: "memory"); }
    }
};
template <class Epi, class Sched, bool ALIGN_EPI = false, bool SP2 = false>
__device__ __forceinline__ void gemm_phase(PG8_LAS unsigned char* lds, const Gemm g, const Sched& S, const Epi& E) {
    int tid_ = threadIdx.x; asm volatile("" : "+v"(tid_));
    const int tid = tid_, wid = __builtin_amdgcn_readfirstlane(tid >> 6), lane = tid & 63, wr = wid >> 2, wc = wid & 3, fr = lane & 15, fq = lane >> 4;
    const int K = g.K, nt = K / BK;
    unsigned voffA[2], voffB[2];
#pragma unroll
    for (int i = 0; i < 2; ++i) { int R, C; stage_rc(tid * 16 + i * 8192, R, C); const int Rb = Epi::PERM ? ((R & ~31) + perm32(R & 31)) : R;
        voffA[i] = (unsigned)(R * K + C) * 2u; voffB[i] = (unsigned)(Rb * K + C) * 2u; }
    const size_t kstep = (size_t)(BK * 2);
    const size_t hstep = (size_t)HALF * K * 2;
    const size_t tstep = 2 * hstep;
    const unsigned ldsw = (unsigned)wid * 1024u;
    const int aoff = lds_byte(wr * 64 + fr, fq * 8), boff = lds_byte(wc * 32 + fr, fq * 8);
#define PG8_SA(b, h) (((b) * 2 + (h)) * HTB)
#define PG8_SB(b, h) ((4 + (b) * 2 + (h)) * HTB)
#define PG8_STAGE(bufoff, gbase, voff) do { _Pragma("unroll") for (int _i = 0; _i < 2; ++_i) \
        __builtin_amdgcn_global_load_lds((const unsigned*)((const char*)(gbase) + (voff)[_i]), (PG8_LAS unsigned*)(lds + (bufoff) + ldsw + _i * 8192), 16, 0, 0); } while (0)
#define PG8_LDA(dst, b, h) do { _Pragma("unroll") for (int m = 0; m < 4; ++m) _Pragma("unroll") for (int k = 0; k < 2; ++k) dst[m][k] = *(const PG8_LAS bf16x8*)(lds + PG8_SA(b, h) + aoff + m * 2048 + k * 1024); } while (0)
#define PG8_LDB(dst, b, h) do { _Pragma("unroll") for (int n = 0; n < 2; ++n) _Pragma("unroll") for (int k = 0; k < 2; ++k) dst[n][k] = *(const PG8_LAS bf16x8*)(lds + PG8_SB(b, h) + boff + n * 2048 + k * 1024); } while (0)
#define PG8_MMA(ai, bj, At, Bt) do { __builtin_amdgcn_s_setprio(1); _Pragma("unroll") for (int m = 0; m < 4; ++m) _Pragma("unroll") for (int n = 0; n < 2; ++n) _Pragma("unroll") for (int k = 0; k < 2; ++k) \
        acc[ai][bj][m][n] = __builtin_amdgcn_mfma_f32_16x16x32_bf16(Bt[n][k], At[m][k], acc[ai][bj][m][n], 0, 0, 0); __builtin_amdgcn_s_setprio(0); } while (0)
#define PG8_WAIT_V(n) asm volatile("s_waitcnt vmcnt(" #n ")" ::: "memory")
#define PG8_WAIT_L(n) asm volatile("s_waitcnt lgkmcnt(" #n ")" ::: "memory")
#define PG8_BAR __builtin_amdgcn_s_barrier()
#define PG8_SCHED __builtin_amdgcn_sched_barrier(0)
    Unit cur, nxt; int ui = 0;
    if (!S.next(0, cur)) return;
    f32x4 acc[2][2][4][2];
#pragma unroll
    for (int a = 0; a < 2; ++a)
#pragma unroll
        for (int b = 0; b < 2; ++b)
#pragma unroll
            for (int m = 0; m < 4; ++m)
#pragma unroll
                for (int n = 0; n < 2; ++n) acc[a][b][m][n] = (f32x4){0.f, 0.f, 0.f, 0.f};
    bf16x8 At[4][2], B0[2][2], B1[2][2];
    const char* cA = (const char*)g.A + (size_t)cur.pm * tstep; const char* cB = (const char*)g.Bt + (size_t)cur.pn * tstep;
    S.a_ready(cur);
    if constexpr (SP2) {
        PG8_STAGE(PG8_SB(0, 0), cB, voffB); PG8_STAGE(PG8_SB(0, 1), cB + hstep, voffB); PG8_STAGE(PG8_SA(0, 0), cA, voffA); PG8_STAGE(PG8_SA(0, 1), cA + hstep, voffA);
        if (wr == 1) PG8_BAR;
        PG8_WAIT_V(2); PG8_BAR;
        PG8_STAGE(PG8_SB(1, 0), cB + kstep, voffB); PG8_STAGE(PG8_SA(1, 0), cA + kstep, voffA); PG8_STAGE(PG8_SB(1, 1), cB + hstep + kstep, voffB);
        PG8_WAIT_V(6); PG8_BAR;
    } else {
        PG8_STAGE(PG8_SB(0, 0), cB, voffB); PG8_STAGE(PG8_SA(0, 0), cA, voffA); PG8_STAGE(PG8_SB(0, 1), cB + hstep, voffB); PG8_STAGE(PG8_SA(0, 1), cA + hstep, voffA);
        if (wr == 1) PG8_BAR;
        PG8_WAIT_V(4); PG8_BAR;
        PG8_STAGE(PG8_SB(1, 0), cB + kstep, voffB); PG8_STAGE(PG8_SA(1, 0), cA + kstep, voffA); PG8_STAGE(PG8_SB(1, 1), cB + hstep + kstep, voffB);
        PG8_WAIT_V(6); PG8_BAR;
    }
    for (;;) {
        const bool has_next = S.next(ui + 1, nxt);
        const char* nA = has_next ? (const char*)g.A + (size_t)nxt.pm * tstep : cA; const char* nB = has_next ? (const char*)g.Bt + (size_t)nxt.pn * tstep : cB;
#pragma unroll 1
        for (int t = 0; t < nt; t += 2) {
            if constexpr (Epi::MIDHOOK) { if (t == nt / 2) E.mid(acc, cur, wr, wc, fr, fq); }
            const bool last = (t == nt - 2);
            const char* a1 = cA + (size_t)(t + 1) * kstep;
            const char* a2 = last ? nA : cA + (size_t)(t + 2) * kstep; const char* b2 = last ? nB : cB + (size_t)(t + 2) * kstep;
            const char* a3 = a2 + kstep; const char* b3 = b2 + kstep;
            if (last && has_next) S.a_ready(nxt);
            if constexpr (SP2) {
            PG8_LDB(B0, 0, 0); PG8_LDB(B1, 0, 1); PG8_SCHED; PG8_LDA(At, 0, 0); PG8_STAGE(PG8_SA(1, 1), a1 + hstep, voffA);
            PG8_WAIT_V(8); PG8_WAIT_L(0); PG8_BAR; PG8_MMA(0, 0, At, B0); PG8_MMA(0, 1, At, B1); PG8_BAR; PG8_SCHED;
            PG8_LDA(At, 0, 1); PG8_STAGE(PG8_SB(0, 0), b2, voffB); PG8_STAGE(PG8_SB(0, 1), b2 + hstep, voffB); PG8_STAGE(PG8_SA(0, 0), a2, voffA);
            PG8_WAIT_V(8); PG8_WAIT_L(0); PG8_BAR; PG8_MMA(1, 0, At, B0); PG8_MMA(1, 1, At, B1); PG8_BAR; PG8_SCHED;
            PG8_LDB(B0, 1, 0); PG8_LDB(B1, 1, 1); PG8_SCHED; PG8_LDA(At, 1, 0); PG8_STAGE(PG8_SA(0, 1), a2 + hstep, voffA);
            PG8_WAIT_V(8); PG8_WAIT_L(0); PG8_BAR; PG8_MMA(0, 0, At, B0); PG8_MMA(0, 1, At, B1); PG8_BAR; PG8_SCHED;
            PG8_LDA(At, 1, 1); PG8_STAGE(PG8_SB(1, 0), b3, voffB); PG8_STAGE(PG8_SB(1, 1), b3 + hstep, voffB); PG8_STAGE(PG8_SA(1, 0), a3, voffA);
            PG8_WAIT_V(8); PG8_WAIT_L(0); PG8_BAR; PG8_MMA(1, 0, At, B0); PG8_MMA(1, 1, At, B1); PG8_BAR; PG8_SCHED;
            } else {
            PG8_LDB(B0, 0, 0); PG8_SCHED; PG8_LDA(At, 0, 0); PG8_STAGE(PG8_SA(1, 1), a1 + hstep, voffA);
            PG8_WAIT_L(8); PG8_BAR; PG8_WAIT_L(0); PG8_MMA(0, 0, At, B0); PG8_BAR; PG8_SCHED;
            PG8_LDB(B1, 0, 1); PG8_STAGE(PG8_SB(0, 0), b2, voffB);
            PG8_BAR; PG8_WAIT_L(0); PG8_MMA(0, 1, At, B1); PG8_BAR;
            PG8_LDA(At, 0, 1); PG8_STAGE(PG8_SA(0, 0), a2, voffA);
            PG8_BAR; PG8_WAIT_L(0); PG8_MMA(1, 0, At, B0); PG8_BAR; PG8_SCHED;
            PG8_STAGE(PG8_SB(0, 1), b2 + hstep, voffB);
            PG8_WAIT_V(6); PG8_BAR; PG8_MMA(1, 1, At, B1); PG8_BAR;
            PG8_LDB(B0, 1, 0); PG8_SCHED; PG8_LDA(At, 1, 0); PG8_STAGE(PG8_SA(0, 1), a2 + hstep, voffA);
            PG8_WAIT_L(8); PG8_BAR; PG8_WAIT_L(0); PG8_MMA(0, 0, At, B0); PG8_BAR; PG8_SCHED;
            PG8_LDB(B1, 1, 1); PG8_STAGE(PG8_SB(1, 0), b3, voffB);
            PG8_BAR; PG8_WAIT_L(0); PG8_MMA(0, 1, At, B1); PG8_BAR;
            PG8_LDA(At, 1, 1); PG8_STAGE(PG8_SA(1, 0), a3, voffA);
            PG8_BAR; PG8_WAIT_L(0); PG8_MMA(1, 0, At, B0); PG8_BAR; PG8_SCHED;
            PG8_STAGE(PG8_SB(1, 1), b3 + hstep, voffB);
            PG8_WAIT_V(6); PG8_BAR; PG8_MMA(1, 1, At, B1); PG8_BAR;
            }
        }
        if constexpr (ALIGN_EPI) { if (wr == 0) PG8_BAR; }
        if constexpr (!Epi::AFTER_DRAIN) { E(acc, cur, wr, wc, fr, fq); S.done(cur); }
        if (!has_next) break;
#pragma unroll
        for (int a = 0; a < 2; ++a)
#pragma unroll
            for (int b = 0; b < 2; ++b)
#pragma unroll
                for (int m = 0; m < 4; ++m)
#pragma unroll
                    for (int n = 0; n < 2; ++n) acc[a][b][m][n] = (f32x4){0.f, 0.f, 0.f, 0.f};
        cur = nxt; cA = nA; cB = nB; ++ui;
        if constexpr (ALIGN_EPI) { if (wr == 1) PG8_BAR; }
    }
    PG8_WAIT_V(0);
    if constexpr (!ALIGN_EPI) { if (wr == 0) PG8_BAR; }
    PG8_BAR;
    if constexpr (Epi::AFTER_DRAIN) { E.fused(acc, cur, wr, wc, fr, fq, lds, wid, lane); S.done(cur); }
#undef PG8_SA
#undef PG8_SB
#undef PG8_STAGE
#undef PG8_LDA
#undef PG8_LDB
#undef PG8_MMA
#undef PG8_WAIT_V
#undef PG8_WAIT_L
#undef PG8_BAR
#undef PG8_SCHED
}
}

#define LAS __attribute__((address_space(3)))
typedef unsigned short bf16;
typedef float f32x4 __attribute__((ext_vector_type(4)));
typedef float f32x16 __attribute__((ext_vector_type(16)));
typedef short bf16x8 __attribute__((ext_vector_type(8)));
typedef unsigned u32x4 __attribute__((ext_vector_type(4)));
typedef unsigned u32x2 __attribute__((ext_vector_type(2)));

constexpr int NTOK = 65536, DM = 1024, DFF = 2816, SEQ = 2048, NBATCH = 32;
constexpr int NPAN = NTOK / 256;
constexpr float LN_EPS = 1e-5f, RMS_EPS = 1e-5f;
constexpr float DN_ALPHA = 1.189207115002721f;
constexpr float LAMBDA_INIT = 0.2f;
constexpr float QSCALE = 0.125f * 1.4426950408889634f;

constexpr size_t MiB = 1u << 20;
constexpr size_t WS_WGU1 = 0, WS_WD1 = 11 * MiB, WS_WIN = 17 * MiB, WS_WBA = 25 * MiB, WS_WBP = 26 * MiB, WS_WOUT = 27 * MiB, WS_WGU2 = 29 * MiB, WS_WD2 = 40 * MiB;
constexpr size_t WS_COS = 46 * MiB, WS_SIN = 46 * MiB + 256 * 1024;
constexpr size_t WS_XB = 48 * MiB;
constexpr size_t WS_YATT = WS_XB, WS_POOL = WS_XB + 64 * MiB;
constexpr size_t WS_X1F = 176 * MiB;
constexpr size_t WS_R1 = 432 * MiB;
constexpr size_t WS_Q = WS_R1, WS_K = WS_R1 + 64 * MiB, WS_VT = WS_R1 + 128 * MiB, WS_U = WS_R1 + 192 * MiB;
constexpr size_t WS_R2 = 784 * MiB;
constexpr size_t WS_O1S = 912 * MiB;
constexpr size_t WS_BAR = 944 * MiB;
constexpr size_t WS_END = 976 * MiB;
constexpr int LDS_BYTES = 139264;

__device__ __forceinline__ unsigned f2bf(float f) { unsigned u = __builtin_bit_cast(unsigned, f); return (u + 0x7fffu + ((u >> 16) & 1u)) >> 16; }
__device__ __forceinline__ unsigned pk2(float lo, float hi) { return f2bf(lo) | (f2bf(hi) << 16); }
__device__ __forceinline__ float wave_sum(float v) {
#pragma unroll
    for (int o = 1; o < 64; o <<= 1) v += __shfl_xor(v, o);
    return v;
}
__device__ __forceinline__ float swap_max(float m) { auto rr = __builtin_amdgcn_permlane32_swap(__float_as_uint(m), __float_as_uint(m), false, false); return fmaxf(__uint_as_float(rr[0]), __uint_as_float(rr[1])); }
__device__ __forceinline__ float swap_sum(float m) { auto rr = __builtin_amdgcn_permlane32_swap(__float_as_uint(m), __float_as_uint(m), false, false); return __uint_as_float(rr[0]) + __uint_as_float(rr[1]); }

struct MapOff { int off; __device__ __forceinline__ int operator()(int n) const { return off + n; } };
struct MapGateUp { int half; __device__ __forceinline__ int operator()(int n) const { return 256 * (n >> 7) + (n & 127) + 128 * half; } };
struct MapWin { __device__ __forceinline__ int operator()(int n) const {
    if (n < 1024) { const int t = n >> 8, r = n & 255, s = r >> 6, w = r & 63, hf = w >> 5, i = w & 31; return 256 * t + 128 * hf + 32 * s + i; }
    if (n < 1536) return 3584 + (n - 1024);
    if (n < 2048) return 1024 + (n - 1536);
    { const int c = n - 2048, br = c >> 10, j = c & 1023; return 1536 + 256 * (j >> 7) + 128 * br + (j & 127); } } };
template <class MAP>
__device__ __forceinline__ void transpose_item(const float* __restrict__ W, int K, int N, bf16* __restrict__ WT, const MAP map, LAS float* scr, int item, int lane, int ldw = 0) {
    if (ldw == 0) ldw = K;
    const int nblk = N / 32, kb = item / nblk, nb = item % nblk, k0 = 64 * kb, n0 = 32 * nb;
#pragma unroll 8
    for (int i = 0; i < 32; ++i) { const int kk = 2 * i + (lane >> 5); scr[kk * 33 + (lane & 31)] = W[(size_t)(k0 + kk) * N + n0 + (lane & 31)]; }
    asm volatile("s_waitcnt lgkmcnt(0)" ::: "memory");
    const int c = lane & 7;
#pragma unroll
    for (int j = 0; j < 4; ++j) { const int n = (lane >> 3) + 8 * j; const LAS float* s = scr + (8 * c) * 33 + n;
        u32x4 o; o.x = pk2(s[0 * 33], s[1 * 33]); o.y = pk2(s[2 * 33], s[3 * 33]); o.z = pk2(s[4 * 33], s[5 * 33]); o.w = pk2(s[6 * 33], s[7 * 33]);
        *(u32x4*)(WT + (size_t)map(n0 + n) * ldw + k0 + 8 * c) = o; }
    asm volatile("s_waitcnt lgkmcnt(0)" ::: "memory");
}

#define XB_TMO      128
#define XB_XCNT(j)  (256  + 64 * (j))
#define XB_XSUB(j)  (1280 + 64 * (j))
#define XB_XGEN(j)  (2304 + 64 * (j))
#define XB_TOP      3328
#define XB_TOPGEN   3392
#define XCD_BAR_WORDS 3456
#define XB_SPIN_CAP (1u << 18)

__device__ __forceinline__ unsigned xb_ld(unsigned* p)              { return __hip_atomic_load(p, __ATOMIC_RELAXED, __HIP_MEMORY_SCOPE_AGENT); }
__device__ __forceinline__ unsigned xb_add(unsigned* p, unsigned v) { return __hip_atomic_fetch_add(p, v, __ATOMIC_RELAXED, __HIP_MEMORY_SCOPE_AGENT); }
__device__ __forceinline__ unsigned xb_xcc_id() { return (unsigned)__builtin_amdgcn_s_getreg((3 << 11) | 20) & 0xFu; }
#define XB_SPIN(cond, bar) do { unsigned _sp = 0; while (cond) { __builtin_amdgcn_s_sleep(1); \
    if ((++_sp & 255u) == 0u) { if (xb_ld(&(bar)[XB_TMO])) break; if (_sp > XB_SPIN_CAP) { atomicAdd(&(bar)[XB_TMO], 1u); break; } } } } while (0)

struct XcdBarrier {
    unsigned* bar; unsigned x;
    volatile LAS unsigned* st;
};

__device__ __forceinline__ XcdBarrier xcd_barrier_post(unsigned* bar, volatile LAS unsigned* st) {
    XcdBarrier b; b.bar = bar; b.x = xb_xcc_id(); b.st = st;
    if (threadIdx.x == 0) (void)xb_add(&bar[XB_XCNT(b.x)], 1u);
    return b;
}
__device__ __forceinline__ void xcd_barrier_complete(unsigned* bar, unsigned x, unsigned& nloc, unsigned& nx) {
    const unsigned G = gridDim.x * gridDim.y * gridDim.z;
    unsigned sum, cnt, mine, sp = 0u;
    for (;;) {
        sum = 0u; cnt = 0u; mine = 0u;
#pragma unroll
        for (unsigned j = 0; j < 16; ++j) { const unsigned c = xb_ld(&bar[XB_XCNT(j)]); sum += c; cnt += (c > 0u) ? 1u : 0u; mine = (j == x) ? c : mine; }
        if (sum == G) break;
        __builtin_amdgcn_s_sleep(1);
        if ((++sp & 255u) == 0u) { if (xb_ld(&bar[XB_TMO])) break; if (sp > XB_SPIN_CAP) { atomicAdd(&bar[XB_TMO], 1u); break; } }
    }
    nloc = mine > 0u ? mine : 1u; nx = cnt > 0u ? cnt : 1u;
}

__device__ __forceinline__ void xcd_barrier(const XcdBarrier& b) {
    asm volatile("s_waitcnt vmcnt(0)" ::: "memory");
    __syncthreads();
    if (threadIdx.x == 0) {
        unsigned* bar = b.bar;
        __builtin_amdgcn_s_waitcnt(0);
        unsigned nloc = b.st[0], nx = b.st[1];
        if (nloc == 0u) { xcd_barrier_complete(bar, b.x, nloc, nx); b.st[0] = nloc; b.st[1] = nx; }
        const unsigned old = xb_add(&bar[XB_XSUB(b.x)], 1u);
        const unsigned gen = old / nloc;
        if (old + 1u == (gen + 1u) * nloc) {
            __builtin_amdgcn_fence(__ATOMIC_RELEASE, "agent");
            asm volatile("s_waitcnt vmcnt(0)" ::: "memory");
            const unsigned og = xb_add(&bar[XB_TOP], 1u);
            const unsigned tg = og / nx;
            if (og + 1u == (tg + 1u) * nx) xb_add(&bar[XB_TOPGEN], 1u);
            else XB_SPIN(xb_ld(&bar[XB_TOPGEN]) == tg, bar);
            __builtin_amdgcn_fence(__ATOMIC_ACQUIRE, "agent");
            xb_add(&bar[XB_XGEN(b.x)], 1u);
            asm volatile("s_waitcnt vmcnt(0)" ::: "memory");
        } else {
            XB_SPIN(xb_ld(&bar[XB_XGEN(b.x)]) == gen, bar);
            __builtin_amdgcn_fence(__ATOMIC_ACQUIRE, "agent");
            asm volatile("s_waitcnt vmcnt(0)" ::: "memory");
        }
    }
    __syncthreads();
}

struct Args { const float* in[24]; float* out; unsigned char* ws; int ph_lo, ph_hi, rep_mask, pad; };

__device__ __forceinline__ void ln_panel(const bf16* Y, float* Xf, bf16* Xb, const float* g, const float* bta, int pm, int wid, int lane) {
    asm volatile("" : "+s"(g), "+s"(bta));
    f32x4 gv[4], bv[4];
#pragma unroll
    for (int j = 0; j < 2; ++j)
#pragma unroll
        for (int n = 0; n < 2; ++n) { gv[2 * j + n] = *(const f32x4*)(g + 8 * lane + 512 * j + 4 * n); bv[2 * j + n] = *(const f32x4*)(bta + 8 * lane + 512 * j + 4 * n); }
    constexpr int RB = 4;
#pragma unroll 1
    for (int r = 0; r < 32; r += RB) {
        const size_t row0 = (size_t)pm * 256 + wid * 32 + r;
        u32x4 raw[RB][2]; f32x4 v[RB][4]; float s[RB];
#pragma unroll
        for (int q = 0; q < RB; ++q)
#pragma unroll
            for (int j = 0; j < 2; ++j) raw[q][j] = *(const u32x4*)(Y + (row0 + q) * 1024 + 8 * lane + 512 * j);
#pragma unroll
        for (int q = 0; q < RB; ++q) { s[q] = 0.f;
#pragma unroll
            for (int j = 0; j < 2; ++j) pg8::unpack8(raw[q][j], v[q][2 * j], v[q][2 * j + 1]);
#pragma unroll
            for (int j = 0; j < 4; ++j) s[q] += (v[q][j][0] + v[q][j][1]) + (v[q][j][2] + v[q][j][3]); }
#pragma unroll
        for (int o = 1; o < 64; o <<= 1)
#pragma unroll
            for (int q = 0; q < RB; ++q) s[q] += __shfl_xor(s[q], o);
        float s2[RB];
#pragma unroll
        for (int q = 0; q < RB; ++q) { const float mean = s[q] * (1.0f / 1024.0f); s2[q] = 0.f;
#pragma unroll
            for (int j = 0; j < 4; ++j) { v[q][j] = v[q][j] - mean; s2[q] += (v[q][j][0] * v[q][j][0] + v[q][j][1] * v[q][j][1]) + (v[q][j][2] * v[q][j][2] + v[q][j][3] * v[q][j][3]); } }
#pragma unroll
        for (int o = 1; o < 64; o <<= 1)
#pragma unroll
            for (int q = 0; q < RB; ++q) s2[q] += __shfl_xor(s2[q], o);
#pragma unroll
        for (int q = 0; q < RB; ++q) { const float rstd = 1.0f / sqrtf(s2[q] * (1.0f / 1024.0f) + LN_EPS); const size_t row = row0 + q;
#pragma unroll
            for (int j = 0; j < 2; ++j) { const f32x4 o0 = v[q][2 * j] * rstd * gv[2 * j] + bv[2 * j], o1 = v[q][2 * j + 1] * rstd * gv[2 * j + 1] + bv[2 * j + 1];
                if (Xf) { *(f32x4*)(Xf + row * 1024 + 8 * lane + 512 * j) = o0; *(f32x4*)(Xf + row * 1024 + 8 * lane + 512 * j + 4) = o1; }
                if (Xb) *(u32x4*)(Xb + row * 1024 + 8 * lane + 512 * j) = pg8::pack8(o0, o1); } }
    }
}

struct AttnState { float mrun, l; };
#define DSR128(dst, addr, off) asm volatile("ds_read_b128 %0, %1 offset:%2" : "=&v"(dst) : "v"(addr), "i"(off))
template <bool FIRST, bool HAS_PREV>
__device__ __forceinline__ void attn_step(f32x16& c0, f32x16& c1, f32x16 (&o)[4], bf16x8 (&pbp)[4], const bf16x8 (&qr)[4], AttnState& st,
                                          const LAS unsigned char* kfr, const LAS unsigned char* vfr, const int (&kofs)[4], const int (&vofs)[4]) {
    const unsigned kb_ = (unsigned)(unsigned long)kfr, vb_ = (unsigned)(unsigned long)vfr;
    unsigned ka[4], va[4];
#pragma unroll
    for (int k = 0; k < 4; ++k) { ka[k] = kb_ + (unsigned)kofs[k]; va[k] = vb_ + (unsigned)vofs[k]; }
    bf16x8 kf[4], vA[4], vB[4];
    { const float nm = FIRST ? 0.f : -st.mrun;
#pragma unroll
      for (int i = 0; i < 16; ++i) { c0[i] = nm; c1[i] = nm; } }
#pragma unroll
    for (int ks = 0; ks < 2; ++ks) { DSR128(kf[2 * ks], ka[ks], 0); DSR128(kf[2 * ks + 1], ka[ks], 4096); }
    asm volatile("s_waitcnt lgkmcnt(0)" : "+v"(kf[0]), "+v"(kf[1]), "+v"(kf[2]), "+v"(kf[3]));
#pragma unroll
    for (int ks = 0; ks < 2; ++ks) {
        c0 = __builtin_amdgcn_mfma_f32_32x32x16_bf16(kf[2 * ks], qr[ks], c0, 0, 0, 0);
        c1 = __builtin_amdgcn_mfma_f32_32x32x16_bf16(kf[2 * ks + 1], qr[ks], c1, 0, 0, 0);
    }
    __builtin_amdgcn_sched_barrier(0);
    { bf16x8 kg[4];
#pragma unroll
      for (int ks = 0; ks < 2; ++ks) { DSR128(kg[2 * ks], ka[2 + ks], 0); DSR128(kg[2 * ks + 1], ka[2 + ks], 4096); }
      asm volatile("s_waitcnt lgkmcnt(0)" : "+v"(kg[0]), "+v"(kg[1]), "+v"(kg[2]), "+v"(kg[3]));
#pragma unroll
      for (int ks = 0; ks < 2; ++ks) {
          c0 = __builtin_amdgcn_mfma_f32_32x32x16_bf16(kg[2 * ks], qr[2 + ks], c0, 0, 0, 0);
          c1 = __builtin_amdgcn_mfma_f32_32x32x16_bf16(kg[2 * ks + 1], qr[2 + ks], c1, 0, 0, 0);
      } }
    __builtin_amdgcn_sched_barrier(0);
    if (HAS_PREV) {
#pragma unroll
        for (int e = 0; e < 4; ++e) DSR128(vA[e], va[0], e * 4096);
    }
    float mx = fmaxf(c0[0], c1[0]);
#pragma unroll
    for (int i = 1; i < 16; ++i) mx = fmaxf(mx, fmaxf(c0[i], c1[i]));
    mx = swap_max(mx);
    float a = 1.0f;
    { const float dl = FIRST ? mx : ((mx > 8.0f) ? mx : 0.f);
      if (FIRST || __any(dl != 0.f)) {
#pragma unroll
          for (int i = 0; i < 16; ++i) { c0[i] -= dl; c1[i] -= dl; }
          st.mrun += dl; if (!FIRST) a = __builtin_amdgcn_exp2f(-dl);
      } }
    float ps = 0.f;
#define ATT_EXPS(E) do { _Pragma("unroll") for (int j = 0; j < 8; ++j) { const int i = (E) * 8 + j; \
        if (i < 16) { c0[i] = __builtin_amdgcn_exp2f(c0[i]); ps += c0[i]; } else { c1[i - 16] = __builtin_amdgcn_exp2f(c1[i - 16]); ps += c1[i - 16]; } } \
        asm volatile("" : "+v"(c0), "+v"(c1), "+v"(ps)); __builtin_amdgcn_sched_barrier(0); } while (0)
#define ATT_PV(KK, VF) do { _Pragma("unroll") for (int e = 0; e < 4; ++e) o[e] = __builtin_amdgcn_mfma_f32_32x32x16_bf16(VF[e], pbp[KK], o[e], 0, 0, 0); } while (0)
#define ATT_TIE(N, VF) asm volatile("s_waitcnt lgkmcnt(" #N ")" : "+v"(VF[0]), "+v"(VF[1]), "+v"(VF[2]), "+v"(VF[3]))
    if (HAS_PREV) {
        __builtin_amdgcn_sched_barrier(0);
#pragma unroll
        for (int e = 0; e < 4; ++e) DSR128(vB[e], va[1], e * 4096);
        ATT_TIE(4, vA); ATT_PV(0, vA); ATT_EXPS(0);
#pragma unroll
        for (int e = 0; e < 4; ++e) DSR128(vA[e], va[2], e * 4096);
        ATT_TIE(4, vB); ATT_PV(1, vB); ATT_EXPS(1);
#pragma unroll
        for (int e = 0; e < 4; ++e) DSR128(vB[e], va[3], e * 4096);
        ATT_TIE(4, vA); ATT_PV(2, vA); ATT_EXPS(2);
        ATT_TIE(0, vB); ATT_PV(3, vB); ATT_EXPS(3);
    } else {
#pragma unroll
        for (int i = 0; i < 16; ++i) { c0[i] = __builtin_amdgcn_exp2f(c0[i]); ps += c0[i]; c1[i] = __builtin_amdgcn_exp2f(c1[i]); ps += c1[i]; }
    }
#undef ATT_EXPS
#undef ATT_PV
#undef ATT_TIE
    st.l = st.l * a + ps;
    if (!FIRST) { if (__any(a != 1.0f)) {
#pragma unroll
        for (int e = 0; e < 4; ++e)
#pragma unroll
            for (int i = 0; i < 16; ++i) o[e][i] *= a; } }
    { u32x4 w;
      w.x = pg8::cvt_pk_bf16(c0[0], c0[1]); w.y = pg8::cvt_pk_bf16(c0[2], c0[3]); w.z = pg8::cvt_pk_bf16(c0[4], c0[5]); w.w = pg8::cvt_pk_bf16(c0[6], c0[7]); pbp[0] = __builtin_bit_cast(bf16x8, w);
      w.x = pg8::cvt_pk_bf16(c0[8], c0[9]); w.y = pg8::cvt_pk_bf16(c0[10], c0[11]); w.z = pg8::cvt_pk_bf16(c0[12], c0[13]); w.w = pg8::cvt_pk_bf16(c0[14], c0[15]); pbp[1] = __builtin_bit_cast(bf16x8, w);
      w.x = pg8::cvt_pk_bf16(c1[0], c1[1]); w.y = pg8::cvt_pk_bf16(c1[2], c1[3]); w.z = pg8::cvt_pk_bf16(c1[4], c1[5]); w.w = pg8::cvt_pk_bf16(c1[6], c1[7]); pbp[2] = __builtin_bit_cast(bf16x8, w);
      w.x = pg8::cvt_pk_bf16(c1[8], c1[9]); w.y = pg8::cvt_pk_bf16(c1[10], c1[11]); w.z = pg8::cvt_pk_bf16(c1[12], c1[13]); w.w = pg8::cvt_pk_bf16(c1[14], c1[15]); pbp[3] = __builtin_bit_cast(bf16x8, w); }
}
__device__ __forceinline__ void attn_unit(LAS unsigned char* lds, const bf16* __restrict__ Qb, const bf16* __restrict__ Kb, const bf16* __restrict__ VT, bf16* __restrict__ Y,
                                          const float* __restrict__ gsub, float lam, int b, int h, int qb, float* o1scr) {
    int tid_ = threadIdx.x; asm volatile("" : "+v"(tid_));
    const int tid = tid_, lane = tid & 63, wid = __builtin_amdgcn_readfirstlane(tid >> 6), r32 = lane & 31, hi = lane >> 5;
    const size_t tok0 = (size_t)b * SEQ;
    constexpr int KSL = 8192, VSL = 16384, VB0 = 3 * KSL;
    const int kap = 16 * ((r32 >> 4) & 1) + 8 * ((r32 >> 2) & 1) + 4 * ((r32 >> 3) & 1) + (r32 & 3);
    int kofs[4], vofs[4];
#pragma unroll
    for (int k = 0; k < 4; ++k) { kofs[k] = kap * 128 + (((2 * k + hi) ^ ((kap >> 1) & 7)) << 4); vofs[k] = r32 * 128 + (((2 * k + hi) ^ ((r32 >> 1) & 7)) << 4); }
    const int lrow = tid >> 3, lc = (tid & 7) ^ ((lrow >> 1) & 7);
    const int kcol = (lc < 4) ? 8 * lc : 128 + 8 * (lc - 4);
    const unsigned wofs = (unsigned)wid * 1024u;
    f32x16 o[4]; float inv = 0.f;
#define ATT_WAITBAR(N) do { asm volatile("s_waitcnt vmcnt(" #N ") lgkmcnt(0)" ::: "memory"); __builtin_amdgcn_s_barrier(); asm volatile("" ::: "memory"); } while (0)
#define ATT_DMA(src, ldsoff) __builtin_amdgcn_global_load_lds((const unsigned*)(src), (LAS unsigned*)(lds + (ldsoff) + wofs), 16, 0, 0)
#pragma unroll 1
    for (int mp = 0; mp < 2; ++mp) {
        const int c1 = 256 * (h >> 1) + 32 * (2 * (h & 1) + mp);
        const bf16* qp = Qb + (tok0 + (size_t)qb * 256 + wid * 32 + r32) * 512 + c1 + 8 * hi;
        bf16x8 qr[4];
        qr[0] = *(const bf16x8*)(qp); qr[1] = *(const bf16x8*)(qp + 16); qr[2] = *(const bf16x8*)(qp + 128); qr[3] = *(const bf16x8*)(qp + 144);
        const bf16* kp = Kb + (tok0 + lrow) * 512 + c1 + kcol;
        const bf16* vp = VT + ((size_t)((b * 4 + h) * 32) * 128 + lrow) * 64 + lc * 8;
        ATT_DMA(kp, 0); ATT_DMA(vp, VB0); ATT_DMA(vp + 4096, VB0 + 8192); ATT_DMA(kp + (size_t)64 * 512, KSL);
        ATT_WAITBAR(0);
#pragma unroll
        for (int e = 0; e < 4; ++e)
#pragma unroll
            for (int i = 0; i < 16; ++i) o[e][i] = 0.f;
        AttnState st; st.mrun = 0.f; st.l = 0.f;
        bf16x8 pbp[4];
        f32x16 sA, sB;
        int s0 = 0, s1 = 1, s2 = 2;
#define ATT_STEP(T, FIRST, HASP) do { const int t_ = (T); \
        if (t_ + 2 < 32) ATT_DMA(kp + (size_t)(t_ + 2) * 64 * 512, s2 * KSL); \
        if (t_ + 1 < 32) { ATT_DMA(vp + (size_t)(t_ + 1) * 8192, VB0 + s1 * VSL); ATT_DMA(vp + (size_t)(t_ + 1) * 8192 + 4096, VB0 + s1 * VSL + 8192); } \
        attn_step<FIRST, HASP>(sA, sB, o, pbp, qr, st, lds + s0 * KSL, lds + VB0 + s2 * VSL, kofs, vofs); \
        if (t_ + 2 < 32) ATT_WAITBAR(3); else ATT_WAITBAR(0); \
        { const int tmp_ = s0; s0 = s1; s1 = s2; s2 = tmp_; } } while (0)
        ATT_STEP(0, true, false);
#pragma unroll 1
        for (int t = 1; t < 32; ++t) ATT_STEP(t, false, true);
#undef ATT_STEP
        { const LAS unsigned char* vb = lds + VB0 + 1 * VSL;
#pragma unroll
          for (int e = 0; e < 4; ++e)
#pragma unroll
              for (int kk = 0; kk < 4; ++kk) { const bf16x8 vf = *(const LAS bf16x8*)(vb + e * 4096 + vofs[kk]);
                  o[e] = __builtin_amdgcn_mfma_f32_32x32x16_bf16(vf, pbp[kk], o[e], 0, 0, 0); } }
        ATT_WAITBAR(0);
        inv = 1.0f / swap_sum(st.l);
        if (mp == 0) {
#pragma unroll
            for (int e = 0; e < 4; ++e)
#pragma unroll
                for (int a = 0; a < 4; ++a) { f32x4 v = {o[e][4 * a] * inv, o[e][4 * a + 1] * inv, o[e][4 * a + 2] * inv, o[e][4 * a + 3] * inv};
                    *(f32x4*)(o1scr + ((size_t)(e * 4 + a) * 512 + tid) * 4) = v; }
        }
    }
#undef ATT_WAITBAR
#undef ATT_DMA
    {
        const float li = lam * inv; float ss = 0.f;
#pragma unroll
        for (int e = 0; e < 4; ++e)
#pragma unroll
            for (int a = 0; a < 4; ++a) { const f32x4 v1 = *(const f32x4*)(o1scr + ((size_t)(e * 4 + a) * 512 + tid) * 4);
#pragma unroll
                for (int k = 0; k < 4; ++k) { const float v = v1[k] - li * o[e][4 * a + k]; o[e][4 * a + k] = v; ss += v * v; } }
        ss = swap_sum(ss);
        const float rs = (1.0f - LAMBDA_INIT) / sqrtf(ss * (1.0f / 128.0f) + RMS_EPS);
        bf16* yp = Y + (tok0 + (size_t)qb * 256 + wid * 32 + r32) * 1024 + h * 128 + 4 * hi;
#pragma unroll
        for (int e = 0; e < 4; ++e)
#pragma unroll
            for (int a = 0; a < 4; ++a) { const f32x4 gg = *(const f32x4*)(gsub + 32 * e + 8 * a + 4 * hi);
                u32x2 w; w.x = pk2(o[e][4 * a] * rs * gg[0], o[e][4 * a + 1] * rs * gg[1]); w.y = pk2(o[e][4 * a + 2] * rs * gg[2], o[e][4 * a + 3] * rs * gg[3]);
                *(u32x2*)(yp + 32 * e + 8 * a) = w; }
    }
}

constexpr int NPHASE = 12;
__global__ void __launch_bounds__(512, 2) fwd_mega(Args a) {
    extern __shared__ __attribute__((aligned(16))) unsigned char lds_raw[];
    LAS unsigned char* lds = (LAS unsigned char*)lds_raw;
    cg::grid_group grid = cg::this_grid();
    const int tid = threadIdx.x, lane = tid & 63, wid = __builtin_amdgcn_readfirstlane(tid >> 6);
    const int G = gridDim.x, bx = blockIdx.x;
    const int lo = a.ph_lo, hi = a.ph_hi;
    const bool fused = (hi - lo) > 1;
    volatile LAS unsigned* MISC = (volatile LAS unsigned*)(lds + 131072 + 512);
    if (tid < 4) MISC[tid] = 0u;
    __syncthreads();
    XcdBarrier xbar; xbar.bar = (unsigned*)(a.ws + WS_BAR); xbar.x = 0; xbar.st = MISC;
    if (fused) xbar = xcd_barrier_post((unsigned*)(a.ws + WS_BAR), MISC);
    if (a.ph_lo < 0) grid.sync();
    unsigned char* ws = a.ws;
    const float* x = a.in[0];
    bf16* Wgu1 = (bf16*)(ws + WS_WGU1); bf16* Wd1 = (bf16*)(ws + WS_WD1); bf16* Win = (bf16*)(ws + WS_WIN); bf16* Wba = (bf16*)(ws + WS_WBA); bf16* Wbp = (bf16*)(ws + WS_WBP);
    bf16* Wout = (bf16*)(ws + WS_WOUT); bf16* Wgu2 = (bf16*)(ws + WS_WGU2); bf16* Wd2 = (bf16*)(ws + WS_WD2);
    float* cosT = (float*)(ws + WS_COS); float* sinT = (float*)(ws + WS_SIN);
    bf16* XB = (bf16*)(ws + WS_XB); bf16* YATT = (bf16*)(ws + WS_YATT); bf16* POOL = (bf16*)(ws + WS_POOL);
    bf16* Y1 = (bf16*)(ws + WS_X1F);
    bf16* X1B = (bf16*)a.out;
    bf16* HB = (bf16*)(ws + WS_R1); bf16* QB = (bf16*)(ws + WS_Q); bf16* KB = (bf16*)(ws + WS_K); bf16* VTB = (bf16*)(ws + WS_VT); bf16* UB = (bf16*)(ws + WS_U);
    bf16* TB = (bf16*)(ws + WS_R1);
    bf16* MG = (bf16*)(ws + WS_R2);
    float* O1S = (float*)(ws + WS_O1S) + (size_t)bx * (512 * 64);
    bf16* GATE = (bf16*)(ws + WS_X1F);
    float* OUT = a.out;
#ifndef PHM
#define PHM 4095
#endif
#define IN_PH(k) ((((PHM) >> (k)) & 1) && lo <= (k) && (k) < hi)
#define REPS(k) (IN_PH(k) ? 1 + ((a.rep_mask >> (k)) & 1) : 0)
#define SEAM(k) do { if (lo <= (k) && (k) + 1 < hi) { xcd_barrier(xbar); } } while (0)
#define WG_HANDOFF() do { asm volatile("s_waitcnt vmcnt(0) lgkmcnt(0)" ::: "memory"); __syncthreads(); __builtin_amdgcn_fence(__ATOMIC_ACQUIRE, "agent"); asm volatile("s_waitcnt vmcnt(0)" ::: "memory"); } while (0)

    if (IN_PH(0)) {
        LAS float* scr = (LAS float*)(lds + wid * 16384);
        const int gw = bx * 8 + wid, NGW = G * 8;
        constexpr int I_GU = (DM / 64) * (DFF / 32), I_DN = (DFF / 64) * (DM / 32), I_IN = (DM / 64) * (4096 / 32), I_BA = (512 / 64) * (DM / 32), I_OUT = (DM / 64) * (DM / 32);
        constexpr int NITEMS = 4 * I_GU + 2 * I_DN + I_IN + I_BA + I_OUT;
        for (int it = gw; it < NITEMS; it += NGW) {
            int r = it;
            if (r < I_GU) { transpose_item(a.in[3], DM, DFF, Wgu1, MapGateUp{0}, scr, r, lane); continue; } r -= I_GU;
            if (r < I_GU) { transpose_item(a.in[4], DM, DFF, Wgu1, MapGateUp{1}, scr, r, lane); continue; } r -= I_GU;
            if (r < I_GU) { transpose_item(a.in[19], DM, DFF, Wgu2, MapGateUp{0}, scr, r, lane); continue; } r -= I_GU;
            if (r < I_GU) { transpose_item(a.in[20], DM, DFF, Wgu2, MapGateUp{1}, scr, r, lane); continue; } r -= I_GU;
            if (r < I_DN) { transpose_item(a.in[5], DFF, DM, Wd1, MapOff{0}, scr, r, lane); continue; } r -= I_DN;
            if (r < I_DN) { transpose_item(a.in[21], DFF, DM, Wd2, MapOff{0}, scr, r, lane); continue; } r -= I_DN;
            if (r < I_IN) { transpose_item(a.in[6], DM, 4096, Win, MapWin{}, scr, r, lane); continue; } r -= I_IN;
            if (r < I_BA) { transpose_item(a.in[14], 512, DM, Wba, MapOff{0}, scr, r, lane, 1024); continue; } r -= I_BA;
            transpose_item(a.in[16], DM, DM, Wout, MapOff{0}, scr, r, lane);
        }
        const size_t gt = (size_t)bx * 512 + tid, NT = (size_t)G * 512;
        { const float* pw = a.in[12]; const float* psc = a.in[13]; const float* wbp = a.in[15];
          for (int w = gw; w < 1024 * 8; w += NGW) { const int n = w & 1023, gc = (w >> 10) * 64 + lane, g = gc >> 7;
              float acc = 0.f;
              for (int d = 0; d < 128; ++d) acc += pw[(size_t)gc * 128 + d] * psc[g * 128 + d] * wbp[(size_t)(g * 128 + d) * 1024 + n];
              Wba[(size_t)n * 1024 + 512 + gc] = (bf16)f2bf(acc); } }
        for (size_t idx = gt; idx < (size_t)SEQ * 32; idx += NT) { const int i = (int)(idx & 31), pos = (int)(idx >> 5);
            const float inv = 1.0f / powf(10000.0f, (float)(2 * i) / 64.0f); const float ang = (float)pos * inv;
            cosT[idx] = cosf(ang); sinT[idx] = sinf(ang); }
#pragma unroll 4
        for (size_t idx = gt; idx < (size_t)NTOK * DM / 8; idx += NT) { const f32x4 v0 = __builtin_nontemporal_load((const f32x4*)(x + idx * 8)), v1 = __builtin_nontemporal_load((const f32x4*)(x + idx * 8 + 4));
            u32x4 w; w.x = pk2(v0[0], v0[1]); w.y = pk2(v0[2], v0[3]); w.z = pk2(v1[0], v1[1]); w.w = pk2(v1[2], v1[3]); *(u32x4*)(XB + idx * 8) = w; }
        __syncthreads();
    }
    SEAM(0);
    if (IN_PH(1)) {
        pg8::Gemm g{XB, Wgu1, NTOK, 2 * DFF, DM}; pg8::StaticOrder S; S.init(NTOK, 2 * DFF, G, bx);
        pg8::EpiSwiglu E{HB, DFF};
        pg8::gemm_phase<pg8::EpiSwiglu, pg8::StaticOrder, true, true>(lds, g, S, E);
    }
    SEAM(1);
    if (IN_PH(2)) {
        pg8::Gemm g{HB, Wd1, NTOK, DM, DFF}; pg8::StaticOrder S; S.init(NTOK, DM, G, bx);
        pg8::EpiResid E{x, Y1, DN_ALPHA, 0.5f};
        pg8::gemm_phase<pg8::EpiResid, pg8::StaticOrder, true, true>(lds, g, S, E);
    }
    SEAM(2);
    if (IN_PH(3)) {
        for (int pm = bx; pm < NPAN; pm += G) ln_panel(Y1, nullptr, X1B, a.in[1], a.in[2], pm, wid, lane);
        __syncthreads();
    }
    SEAM(3);
    if (IN_PH(4)) {
        { pg8::Gemm g{X1B, Win, NTOK, 3584, DM}; pg8::StaticOrder S; S.init(NTOK, 3584, G, bx);
          pg8::EpiWin E{QB, KB, UB, GATE, cosT, sinT, QSCALE};
          pg8::gemm_phase<pg8::EpiWin, pg8::StaticOrder, true, true>(lds, g, S, E); }
        { pg8::Gemm g{Win + (size_t)3584 * DM, X1B, 512, NTOK, DM}; pg8::StaticOrder S; S.init(512, NTOK, G, bx);
          pg8::EpiVT E{VTB};
          pg8::gemm_phase<pg8::EpiVT, pg8::StaticOrder, true, true>(lds, g, S, E); }
    }
    SEAM(4);
    if (IN_PH(5)) {
        for (int item = bx * 512 + tid; item < NBATCH * 64 * 64; item += G * 512) {
            const int c8 = item & 63, seg = (item >> 6) & 63, bb = item >> 12;
            const int ch = c8 * 8, hw = 1 << (ch >> 7);
            const bf16* base = UB + (size_t)bb * SEQ * 512 + ch;
            bf16* obase = XB + (size_t)bb * SEQ * 1024 + 512 + ch;
            const int s0 = seg * 32;
            f32x4 w0 = {0.f, 0.f, 0.f, 0.f}, w1 = {0.f, 0.f, 0.f, 0.f};
            { const int jlo = (s0 - hw) > 0 ? (s0 - hw) : 0, jhi = (s0 + hw) < SEQ ? (s0 + hw) : SEQ;
              for (int j = jlo; j < jhi; ++j) { f32x4 a0, a1; pg8::unpack8(*(const u32x4*)(base + (size_t)j * 512), a0, a1); w0 += a0; w1 += a1; } }
#pragma unroll 4
            for (int s = s0; s < s0 + 32; ++s) {
                f32x4 u0, u1; pg8::unpack8(*(const u32x4*)(base + (size_t)s * 512), u0, u1);
                const int jlo = (s - hw) > 0 ? (s - hw) : 0, jhi = (s + hw) < SEQ ? (s + hw) : SEQ;
                const float rc = 1.0f / (float)(jhi - jlo);
                *(u32x4*)(obase + (size_t)s * 1024) = pg8::pack8(w0 * rc - u0, w1 * rc - u1);
                if (s + hw < SEQ) { f32x4 a0, a1; pg8::unpack8(*(const u32x4*)(base + (size_t)(s + hw) * 512), a0, a1); w0 += a0; w1 += a1; }
                if (s - hw >= 0) { f32x4 a0, a1; pg8::unpack8(*(const u32x4*)(base + (size_t)(s - hw) * 512), a0, a1); w0 -= a0; w1 -= a1; }
            }
        }
        float lam;
        { const float p1 = a.in[7][lane] * a.in[8][lane], p2 = a.in[9][lane] * a.in[10][lane];
          lam = expf(wave_sum(p1)) - expf(wave_sum(p2)) + LAMBDA_INIT; }
        if (G == 256) {
            const int xc = bx & 7, j = bx >> 3;
            for (int i = 0; i < 4; ++i) { const int bh = i * 32 + xc * 4 + (j >> 3), qb = j & 7;
                attn_unit(lds, QB, KB, VTB, YATT, a.in[11], lam, bh >> 2, bh & 3, qb, O1S); }
        } else {
            for (int u = bx; u < 1024; u += G) attn_unit(lds, QB, KB, VTB, YATT, a.in[11], lam, (u >> 3) >> 2, (u >> 3) & 3, u & 7, O1S);
        }
    }
    SEAM(5);
    if (IN_PH(6)) {
        pg8::Gemm g{XB, Wba, NTOK, DM, DM}; pg8::StaticOrder S; S.init(NTOK, DM, G, bx);
        pg8::EpiGateMid E{GATE, MG};
        pg8::gemm_phase<pg8::EpiGateMid, pg8::StaticOrder, true, true>(lds, g, S, E);
    }
    SEAM(6);
    if (IN_PH(7)) {
        pg8::Gemm g{MG, Wout, NTOK, DM, DM}; pg8::StaticOrder S; S.init(NTOK, DM, G, bx);
        pg8::EpiResidB E{X1B, TB, DN_ALPHA, 1.0f};
        pg8::gemm_phase<pg8::EpiResidB, pg8::StaticOrder, true, true>(lds, g, S, E);
    }
    SEAM(7);
    if (IN_PH(8)) {
        for (int pm = bx; pm < NPAN; pm += G) ln_panel(TB, nullptr, MG, a.in[17], a.in[18], pm, wid, lane);
        __syncthreads();
    }
    SEAM(8);
    if (IN_PH(9)) {
        pg8::Gemm g{MG, Wgu2, NTOK, 2 * DFF, DM}; pg8::StaticOrder S; S.init(NTOK, 2 * DFF, G, bx);
        pg8::EpiSwiglu E{HB, DFF};
        pg8::gemm_phase<pg8::EpiSwiglu, pg8::StaticOrder, true, true>(lds, g, S, E);
    }
    SEAM(9);
    if (IN_PH(10)) {
        pg8::Gemm g{HB, Wd2, NTOK, DM, DFF}; pg8::StaticOrder S; S.init(NTOK, DM, G, bx);
        pg8::EpiResidB E{MG, Y1, DN_ALPHA, 0.5f};
        pg8::gemm_phase<pg8::EpiResidB, pg8::StaticOrder, true, true>(lds, g, S, E);
    }
    SEAM(10);
    if (IN_PH(11)) {
        for (int pm = bx; pm < NPAN; pm += G) ln_panel(Y1, OUT, nullptr, a.in[22], a.in[23], pm, wid, lane);
    }
}

#ifndef REP_MASK
#define REP_MASK 0
#endif
#ifndef MK_N_LAUNCHES
#define MK_N_LAUNCHES 1
#endif
extern "C" void kernel_launch(void* const* d_in, const int* in_sizes, int n_in, void* d_out, int out_size, void* d_ws, size_t ws_size, hipStream_t stream) {
    static int grid = 0;
    if (grid == 0) {
        if (n_in != 24 || in_sizes[0] != NTOK * DM || out_size != NTOK * DM || ws_size < WS_END) { fprintf(stderr, "kernel_launch: unexpected shapes (n_in %d, ws %zu)\n", n_in, ws_size); grid = -1; return; }
        int dev = 0, cus = 0, per_cu = 0;
        hipGetDevice(&dev); hipDeviceGetAttribute(&cus, hipDeviceAttributeMultiprocessorCount, dev);
        if (hipFuncSetAttribute((const void*)fwd_mega, hipFuncAttributeMaxDynamicSharedMemorySize, LDS_BYTES) != hipSuccess) { fprintf(stderr, "kernel_launch: hipFuncSetAttribute failed\n"); grid = -1; return; }
        if (hipOccupancyMaxActiveBlocksPerMultiprocessor(&per_cu, (const void*)fwd_mega, 512, LDS_BYTES) != hipSuccess || per_cu < 1) { fprintf(stderr, "kernel_launch: occupancy query says %d\n", per_cu); per_cu = 1; }
        (void)hipGetLastError();
        grid = cus * per_cu;
    }
    if (grid < 0) return;
    Args a{};
    for (int i = 0; i < 24; ++i) a.in[i] = (const float*)d_in[i];
    a.out = (float*)d_out; a.ws = (unsigned char*)d_ws;
    (void)hipMemsetAsync((unsigned char*)d_ws + WS_BAR, 0, 16384, stream);
#if MK_N_LAUNCHES == 1
    a.ph_lo = 0; a.ph_hi = NPHASE; a.rep_mask = REP_MASK;
    void* args[] = {&a};
    hipError_t e = hipLaunchCooperativeKernel((const void*)fwd_mega, dim3(grid), dim3(512), args, LDS_BYTES, stream);
    if (e != hipSuccess) fprintf(stderr, "cooperative launch failed: %s (grid %d)\n", hipGetErrorString(e), grid);
#else
    for (int p = 0; p < NPHASE; ++p) { a.ph_lo = p; a.ph_hi = p + 1; hipLaunchKernelGGL(fwd_mega, dim3(grid), dim3(512), LDS_BYTES, stream, a); }
#endif
}
```

```cpp
#include <hip/hip_runtime.h>
#include <hip/hip_cooperative_groups.h>
#include <cstdio>
#include <cstdint>
namespace cg = cooperative_groups;
namespace pg8 {
#define PG8_LAS __attribute__((address_space(3)))
typedef unsigned short bf16_t;
typedef short bf16x8 __attribute__((ext_vector_type(8)));
typedef float f32x4 __attribute__((ext_vector_type(4)));
typedef unsigned u32x4 __attribute__((ext_vector_type(4)));
constexpr int BM = 256, BK = 64, HALF = 128, HTB = HALF * BK * 2  , STAGE_BYTES = 8 * HTB, NXCD = 8, WGM = 4;

__host__ __device__ __forceinline__ int lds_byte(int r, int c) { const int st = (r >> 4) * 2 + (c >> 5), rr = r & 15, cc = c & 31, ob = rr * 64 + cc * 2; return st * 1024 + (ob ^ (((ob >> 9) & 1) << 5)); }
__host__ __device__ __forceinline__ void stage_rc(int b, int& R, int& C) { const int st = b / 1024, sb = b % 1024, swz = sb ^ (((sb >> 9) & 1) << 5); R = (st >> 1) * 16 + swz / 64; C = (st & 1) * 32 + (swz % 64) / 2; }
__host__ __device__ __forceinline__ int perm32(int rho) { const int n = rho >> 4, i = rho & 15; return 8 * (i >> 2) + 4 * n + (i & 3); }

struct Unit { int pm, pn; };
struct Gemm { const bf16_t* A; const bf16_t* Bt; int M, N, K; };

struct StaticOrder {
    int nM, nN, nwg, G, c;
    __host__ __device__ void init(int M, int N, int G_, int c_) { nM = M / BM; nN = N / BM; nwg = nM * nN; G = G_; c = c_; }
    __host__ __device__ bool next(int i, Unit& u) const {
        const long L = (long)i * G + c; if (L >= nwg) return false;
        int wgid = (int)L; { const int q = nwg / NXCD, r = nwg % NXCD, xcd = wgid % NXCD, off = wgid / NXCD; wgid = (xcd < r ? xcd * (q + 1) : r * (q + 1) + (xcd - r) * q) + off; }
        const int nig = WGM * nN, gid = wgid / nig, fm = gid * WGM, gsz = (nM - fm) < WGM ? (nM - fm) : WGM;
        u.pm = fm + ((wgid % nig) % gsz); u.pn = (wgid % nig) / gsz; return true;
    }
    __device__ __forceinline__ void a_ready(const Unit&) const {}
    __device__ __forceinline__ void done(const Unit&) const {}
};

typedef float cvt_f32x2_t __attribute__((ext_vector_type(2))); typedef __bf16 cvt_bf16x2_t __attribute__((ext_vector_type(2)));
__device__ __forceinline__ unsigned cvt_pk_bf16(float lo, float hi) { cvt_f32x2_t v = {lo, hi}; cvt_bf16x2_t b = __builtin_convertvector(v, cvt_bf16x2_t); return __builtin_bit_cast(unsigned, b); }
typedef float f32x2 __attribute__((ext_vector_type(2)));
struct PanelOrder {
    int pm, npn;
    __device__ __forceinline__ bool next(int i, Unit& u) const { if (i >= npn) return false; int p = pm, q = i; asm volatile("" : "+s"(p), "+s"(q));
        u.pm = p; u.pn = q; return true; }
    __device__ __forceinline__ void a_ready(const Unit&) const {}
    __device__ __forceinline__ void done(const Unit&) const {}
};
__device__ __forceinline__ float fast_sigmoid(float v) { return __builtin_amdgcn_rcpf(1.0f + __builtin_amdgcn_exp2f(v * -1.4426950408889634f)); }
__device__ __forceinline__ u32x4 pack8(const f32x4 a, const f32x4 b) { u32x4 w; w.x = cvt_pk_bf16(a[0], a[1]); w.y = cvt_pk_bf16(a[2], a[3]); w.z = cvt_pk_bf16(b[0], b[1]); w.w = cvt_pk_bf16(b[2], b[3]); return w; }
__device__ __forceinline__ void unpack8(const u32x4 w, f32x4& a, f32x4& b) {
    a[0] = __uint_as_float(w.x << 16); a[1] = __uint_as_float(w.x & 0xffff0000u); a[2] = __uint_as_float(w.y << 16); a[3] = __uint_as_float(w.y & 0xffff0000u);
    b[0] = __uint_as_float(w.z << 16); b[1] = __uint_as_float(w.z & 0xffff0000u); b[2] = __uint_as_float(w.w << 16); b[3] = __uint_as_float(w.w & 0xffff0000u);
}
struct EpiPlain {
    static constexpr bool PERM = true, AFTER_DRAIN = false, MIDHOOK = false;
    bf16_t* O; size_t ldc;
    __device__ __forceinline__ void operator()(const f32x4 (&acc)[2][2][4][2], const Unit& u, int wr, int wc, int fr, int fq) const {
        const int row0 = u.pm * BM + wr * 64 + fr, col0 = u.pn * BM + wc * 32 + 8 * fq;
#pragma unroll
        for (int ai = 0; ai < 2; ++ai)
#pragma unroll
            for (int m = 0; m < 4; ++m) { bf16_t* rowp = O + (size_t)(row0 + ai * HALF + m * 16) * ldc + col0;
#pragma unroll
                for (int bj = 0; bj < 2; ++bj) *(u32x4*)(rowp + bj * HALF) = pack8(acc[ai][bj][m][0], acc[ai][bj][m][1]); }
    }
};
struct EpiSwiglu {
    static constexpr bool PERM = true, AFTER_DRAIN = false, MIDHOOK = false;
    bf16_t* H; int ldh;
    __device__ __forceinline__ void operator()(const f32x4 (&acc)[2][2][4][2], const Unit& u, int wr, int wc, int fr, int fq) const {
        const int row0 = u.pm * BM + wr * 64 + fr, col0 = u.pn * HALF + wc * 32 + 8 * fq;
#pragma unroll
        for (int ai = 0; ai < 2; ++ai)
#pragma unroll
            for (int m = 0; m < 4; ++m) { f32x4 h[2];
#pragma unroll
                for (int n = 0; n < 2; ++n) { const f32x4 g = acc[ai][0][m][n], up = acc[ai][1][m][n];
#pragma unroll
                    for (int e = 0; e < 4; ++e) h[n][e] = g[e] * fast_sigmoid(g[e]) * up[e]; }
                __builtin_nontemporal_store(pack8(h[0], h[1]), (u32x4*)(H + (size_t)(row0 + ai * HALF + m * 16) * ldh + col0)); }
    }
};
struct EpiWin {
    static constexpr bool PERM = true, AFTER_DRAIN = false, MIDHOOK = false;
    bf16_t *Q, *K, *U, *G; const float* cosT; const float* sinT; float qscale;
    __device__ __forceinline__ void operator()(const f32x4 (&acc)[2][2][4][2], const Unit& u, int wr, int wc, int fr, int fq) const {
        const int row0 = u.pm * BM + wr * 64 + fr; const int pn = u.pn;
        if (pn < 4) {
            bf16_t* base = (pn < 2) ? Q : K; const float sc = (pn < 2) ? qscale : 1.0f; const int ct = (pn & 1) * BM + wc * 32 + 8 * fq;
#pragma unroll
            for (int ai = 0; ai < 2; ++ai)
#pragma unroll
                for (int mh = 0; mh < 2; ++mh) {
                    f32x4 cs[2][2], sn[2][2];
#pragma unroll
                    for (int mm = 0; mm < 2; ++mm) { const int pos = (row0 + ai * HALF + (mh * 2 + mm) * 16) & 2047;
#pragma unroll
                        for (int n = 0; n < 2; ++n) { cs[mm][n] = *(const f32x4*)(cosT + pos * 32 + 8 * fq + 4 * n); sn[mm][n] = *(const f32x4*)(sinT + pos * 32 + 8 * fq + 4 * n); } }
#pragma unroll
                    for (int mm = 0; mm < 2; ++mm) { const int m = mh * 2 + mm; const int row = row0 + ai * HALF + m * 16;
                        f32x4 o1[2], o2[2];
#pragma unroll
                        for (int n = 0; n < 2; ++n) { const f32x4 x1 = acc[ai][0][m][n], x2 = acc[ai][1][m][n];
                            o1[n] = (x1 * cs[mm][n] - x2 * sn[mm][n]) * sc; o2[n] = (x1 * sn[mm][n] + x2 * cs[mm][n]) * sc; }
                        bf16_t* rowp = base + (size_t)row * 512 + ct;
                        *(u32x4*)(rowp) = pack8(o1[0], o1[1]); *(u32x4*)(rowp + HALF) = pack8(o2[0], o2[1]); }
                    asm volatile("" ::: "memory"); }
        } else if (pn < 6) {
            const int col0 = (pn - 4) * BM + wc * 32 + 8 * fq;
#pragma unroll
            for (int ai = 0; ai < 2; ++ai)
#pragma unroll
                for (int m = 0; m < 4; ++m) { bf16_t* rowp = U + (size_t)(row0 + ai * HALF + m * 16) * 512 + col0;
#pragma unroll
                    for (int bj = 0; bj < 2; ++bj) *(u32x4*)(rowp + bj * HALF) = pack8(acc[ai][bj][m][0], acc[ai][bj][m][1]); }
        } else {
            const int col0 = (pn - 6) * BM + wc * 32 + 8 * fq;
#pragma unroll
            for (int ai = 0; ai < 2; ++ai)
#pragma unroll
                for (int m = 0; m < 4; ++m) { bf16_t* rowp = G + (size_t)(row0 + ai * HALF + m * 16) * 2048 + col0;
                    f32x4 rt[2], gp[2];
#pragma unroll
                    for (int n = 0; n < 2; ++n)
#pragma unroll
                        for (int e = 0; e < 4; ++e) { const float ea = 1.0f + __builtin_amdgcn_exp2f(acc[ai][0][m][n][e] * -1.4426950408889634f), ep = fminf(1.0f + __builtin_amdgcn_exp2f(acc[ai][1][m][n][e] * -1.4426950408889634f), 1e30f);
                            gp[n][e] = __builtin_amdgcn_rcpf(ep); rt[n][e] = ep * __builtin_amdgcn_rcpf(ea); }
                    *(u32x4*)(rowp) = pack8(rt[0], rt[1]); *(u32x4*)(rowp + HALF) = pack8(gp[0], gp[1]); }
        }
    }
};
struct EpiResid {
    static constexpr bool PERM = true, AFTER_DRAIN = false, MIDHOOK = false;
    const float* X; bf16_t* Y; float alpha, sc;
    __device__ __forceinline__ void operator()(const f32x4 (&acc)[2][2][4][2], const Unit& u, int wr, int wc, int fr, int fq) const {
        const int row0 = u.pm * BM + wr * 64 + fr, col0 = u.pn * BM + wc * 32 + 8 * fq;
#pragma unroll
        for (int ai = 0; ai < 2; ++ai)
#pragma unroll
            for (int mh = 0; mh < 2; ++mh) {
                f32x4 xr[2][2][2];
#pragma unroll
                for (int mm = 0; mm < 2; ++mm)
#pragma unroll
                    for (int bj = 0; bj < 2; ++bj)
#pragma unroll
                        for (int n = 0; n < 2; ++n) xr[mm][bj][n] = *(const f32x4*)(X + (size_t)(row0 + ai * HALF + (mh * 2 + mm) * 16) * 1024 + col0 + bj * HALF + 4 * n);
#pragma unroll
                for (int mm = 0; mm < 2; ++mm) { const int m = mh * 2 + mm; const size_t off = (size_t)(row0 + ai * HALF + m * 16) * 1024 + col0;
#pragma unroll
                    for (int bj = 0; bj < 2; ++bj) *(u32x4*)(Y + off + bj * HALF) = pack8(xr[mm][bj][0] * alpha + acc[ai][bj][m][0] * sc, xr[mm][bj][1] * alpha + acc[ai][bj][m][1] * sc); }
                asm volatile("" ::: "memory"); }
    }
};
struct EpiGate1 {
    static constexpr bool PERM = true, AFTER_DRAIN = false, MIDHOOK = false;
    const bf16_t* G; float* T;
    __device__ __forceinline__ void operator()(const f32x4 (&acc)[2][2][4][2], const Unit& u, int wr, int wc, int fr, int fq) const {
        const int row0 = u.pm * BM + wr * 64 + fr, col0 = u.pn * BM + wc * 32 + 8 * fq;
#pragma unroll
        for (int ai = 0; ai < 2; ++ai)
#pragma unroll
            for (int m = 0; m < 4; ++m) { const size_t row = (size_t)(row0 + ai * HALF + m * 16);
#pragma unroll
                for (int bj = 0; bj < 2; ++bj) { f32x4 ga, gb; unpack8(*(const u32x4*)(G + row * 2048 + col0 + bj * HALF), ga, gb);
                    float* tp = T + row * 1024 + col0 + bj * HALF;
                    *(f32x4*)(tp) = ga * acc[ai][bj][m][0]; *(f32x4*)(tp + 4) = gb * acc[ai][bj][m][1]; }
                asm volatile("" ::: "memory"); }
    }
};
struct EpiGate2 {
    static constexpr bool PERM = true, AFTER_DRAIN = false, MIDHOOK = false;
    const bf16_t* G; const float* T; bf16_t* Mg;
    __device__ __forceinline__ void operator()(const f32x4 (&acc)[2][2][4][2], const Unit& u, int wr, int wc, int fr, int fq) const {
        const int row0 = u.pm * BM + wr * 64 + fr, col0 = u.pn * BM + wc * 32 + 8 * fq;
#pragma unroll
        for (int ai = 0; ai < 2; ++ai)
#pragma unroll
            for (int m = 0; m < 4; ++m) { const size_t row = (size_t)(row0 + ai * HALF + m * 16);
#pragma unroll
                for (int bj = 0; bj < 2; ++bj) { f32x4 ga, gb; unpack8(*(const u32x4*)(G + row * 2048 + 1024 + col0 + bj * HALF), ga, gb);
                    const float* tp = T + row * 1024 + col0 + bj * HALF;
                    const f32x4 t0 = *(const f32x4*)(tp), t1 = *(const f32x4*)(tp + 4);
                    *(u32x4*)(Mg + row * 1024 + col0 + bj * HALF) = pack8(t0 + ga * acc[ai][bj][m][0], t1 + gb * acc[ai][bj][m][1]); }
                asm volatile("" ::: "memory"); }
    }
};
struct EpiVT {
    static constexpr bool PERM = true, AFTER_DRAIN = false, MIDHOOK = false;
    bf16_t* O;
    __device__ __forceinline__ void operator()(const f32x4 (&acc)[2][2][4][2], const Unit& u, int wr, int wc, int fr, int fq) const {
        const int row0 = u.pm * BM + wr * 64 + fr, col0 = u.pn * BM + wc * 32 + 8 * fq;
#pragma unroll
        for (int ai = 0; ai < 2; ++ai)
#pragma unroll
            for (int m = 0; m < 4; ++m) { const int vcol = row0 + ai * HALF + m * 16, h = vcol >> 7, e = vcol & 127;
#pragma unroll
                for (int bj = 0; bj < 2; ++bj) { const int tok = col0 + bj * HALF, b = tok >> 11, sq = tok & 2047, kt = sq >> 6, key = sq & 63;
                    *(u32x4*)(O + ((size_t)(((b * 4 + h) * 32 + kt) * 128 + e)) * 64 + key) = pack8(acc[ai][bj][m][0], acc[ai][bj][m][1]); } }
    }
};
struct EpiGateMid {
    static constexpr bool PERM = true, AFTER_DRAIN = false, MIDHOOK = true;
    const bf16_t* G; bf16_t* Mg;
    __device__ __forceinline__ void mid(f32x4 (&acc)[2][2][4][2], const Unit& u, int wr, int wc, int fr, int fq) const {
        int row0 = u.pm * BM + wr * 64 + fr, gc0 = u.pn * 512 + wc * 32 + 8 * fq;
        asm volatile("" : "+v"(row0), "+v"(gc0));
#pragma unroll
        for (int ai = 0; ai < 2; ++ai) {
            u32x4 rt[4][2];
#pragma unroll
            for (int m = 0; m < 4; ++m)
#pragma unroll
                for (int bj = 0; bj < 2; ++bj) rt[m][bj] = *(const u32x4*)(G + (size_t)(row0 + ai * HALF + m * 16) * 2048 + gc0 + bj * 256);
#pragma unroll
            for (int m = 0; m < 4; ++m)
#pragma unroll
                for (int bj = 0; bj < 2; ++bj) { f32x4 r0, r1; unpack8(rt[m][bj], r0, r1); acc[ai][bj][m][0] *= r0; acc[ai][bj][m][1] *= r1; }
            asm volatile("" ::: "memory"); }
    }
    __device__ __forceinline__ void operator()(const f32x4 (&acc)[2][2][4][2], const Unit& u, int wr, int wc, int fr, int fq) const {
        const int row0 = u.pm * BM + wr * 64 + fr, col0 = u.pn * BM + wc * 32 + 8 * fq, gc0 = u.pn * 512 + wc * 32 + 8 * fq + 128;
#pragma unroll
        for (int ai = 0; ai < 2; ++ai) {
            u32x4 gp[4][2];
#pragma unroll
            for (int m = 0; m < 4; ++m)
#pragma unroll
                for (int bj = 0; bj < 2; ++bj) gp[m][bj] = *(const u32x4*)(G + (size_t)(row0 + ai * HALF + m * 16) * 2048 + gc0 + bj * 256);
#pragma unroll
            for (int m = 0; m < 4; ++m) { const size_t row = (size_t)(row0 + ai * HALF + m * 16);
#pragma unroll
                for (int bj = 0; bj < 2; ++bj) { f32x4 p0, p1; unpack8(gp[m][bj], p0, p1);
                    *(u32x4*)(Mg + row * 1024 + col0 + bj * HALF) = pack8(acc[ai][bj][m][0] * p0, acc[ai][bj][m][1] * p1); } }
            asm volatile("" ::: "memory"); }
    }
};
struct EpiResidB {
    static constexpr bool PERM = true, AFTER_DRAIN = false, MIDHOOK = false;
    const bf16_t* X; bf16_t* Y; float alpha, sc;
    __device__ __forceinline__ void operator()(const f32x4 (&acc)[2][2][4][2], const Unit& u, int wr, int wc, int fr, int fq) const {
        const int row0 = u.pm * BM + wr * 64 + fr, col0 = u.pn * BM + wc * 32 + 8 * fq;
#pragma unroll
        for (int ai = 0; ai < 2; ++ai) {
            u32x4 xr[4][2];
#pragma unroll
            for (int m = 0; m < 4; ++m)
#pragma unroll
                for (int bj = 0; bj < 2; ++bj) xr[m][bj] = *(const u32x4*)(X + (size_t)(row0 + ai * HALF + m * 16) * 1024 + col0 + bj * HALF);
#pragma unroll
            for (int m = 0; m < 4; ++m) { const size_t off = (size_t)(row0 + ai * HALF + m * 16) * 1024 + col0;
#pragma unroll
                for (int bj = 0; bj < 2; ++bj) { f32x4 x0, x1; unpack8(xr[m][bj], x0, x1);
                    *(u32x4*)(Y + off + bj * HALF) = pack8(x0 * alpha + acc[ai][bj][m][0] * sc, x1 * alpha + acc[ai][bj][m][1] * sc); } }
            asm volatile("" ::: "memory"); }
    }
};
template <class Epi, class Sched, bool ALIGN_EPI = false, bool SP2 = false>
__device__ __forceinline__ void gemm_phase(PG8_LAS unsigned char* lds, const Gemm g, const Sched& S, const Epi& E) {
    int tid_ = threadIdx.x; asm volatile("" : "+v"(tid_));
    const int tid = tid_, wid = __builtin_amdgcn_readfirstlane(tid >> 6), lane = tid & 63, wr = wid >> 2, wc = wid & 3, fr = lane & 15, fq = lane >> 4;
    const int K = g.K, nt = K / BK;
    unsigned voffA[2], voffB[2];
#pragma unroll
    for (int i = 0; i < 2; ++i) { int R, C; stage_rc(tid * 16 + i * 8192, R, C); const int Rb = Epi::PERM ? ((R & ~31) + perm32(R & 31)) : R;
        voffA[i] = (unsigned)(R * K + C) * 2u; voffB[i] = (unsigned)(Rb * K + C) * 2u; }
    const size_t kstep = (size_t)(BK * 2);
    const size_t hstep = (size_t)HALF * K * 2;
    const size_t tstep = 2 * hstep;
    const unsigned ldsw = (unsigned)wid * 1024u;
    const int aoff = lds_byte(wr * 64 + fr, fq * 8), boff = lds_byte(wc * 32 + fr, fq * 8);
#define PG8_SA(b, h) (((b) * 2 + (h)) * HTB)
#define PG8_SB(b, h) ((4 + (b) * 2 + (h)) * HTB)
#define PG8_STAGE(bufoff, gbase, voff) do { _Pragma("unroll") for (int _i = 0; _i < 2; ++_i) \
        __builtin_amdgcn_global_load_lds((const unsigned*)((const char*)(gbase) + (voff)[_i]), (PG8_LAS unsigned*)(lds + (bufoff) + ldsw + _i * 8192), 16, 0, 0); } while (0)
#define PG8_LDA(dst, b, h) do { _Pragma("unroll") for (int m = 0; m < 4; ++m) _Pragma("unroll") for (int k = 0; k < 2; ++k) dst[m][k] = *(const PG8_LAS bf16x8*)(lds + PG8_SA(b, h) + aoff + m * 2048 + k * 1024); } while (0)
#define PG8_LDB(dst, b, h) do { _Pragma("unroll") for (int n = 0; n < 2; ++n) _Pragma("unroll") for (int k = 0; k < 2; ++k) dst[n][k] = *(const PG8_LAS bf16x8*)(lds + PG8_SB(b, h) + boff + n * 2048 + k * 1024); } while (0)
#define PG8_MMA(ai, bj, At, Bt) do { __builtin_amdgcn_s_setprio(1); _Pragma("unroll") for (int m = 0; m < 4; ++m) _Pragma("unroll") for (int n = 0; n < 2; ++n) _Pragma("unroll") for (int k = 0; k < 2; ++k) \
        acc[ai][bj][m][n] = __builtin_amdgcn_mfma_f32_16x16x32_bf16(Bt[n][k], At[m][k], acc[ai][bj][m][n], 0, 0, 0); __builtin_amdgcn_s_setprio(0); } while (0)
#define PG8_WAIT_V(n) asm volatile("s_waitcnt vmcnt(" #n ")" ::: "memory")
#define PG8_WAIT_L(n) asm volatile("s_waitcnt lgkmcnt(" #n ")" ::: "memory")
#define PG8_BAR __builtin_amdgcn_s_barrier()
#define PG8_SCHED __builtin_amdgcn_sched_barrier(0)
    Unit cur, nxt; int ui = 0;
    if (!S.next(0, cur)) return;
    f32x4 acc[2][2][4][2];
#pragma unroll
    for (int a = 0; a < 2; ++a)
#pragma unroll
        for (int b = 0; b < 2; ++b)
#pragma unroll
            for (int m = 0; m < 4; ++m)
#pragma unroll
                for (int n = 0; n < 2; ++n) acc[a][b][m][n] = (f32x4){0.f, 0.f, 0.f, 0.f};
    bf16x8 At[4][2], B0[2][2], B1[2][2];
    const char* cA = (const char*)g.A + (size_t)cur.pm * tstep; const char* cB = (const char*)g.Bt + (size_t)cur.pn * tstep;
    S.a_ready(cur);
    if constexpr (SP2) {
        PG8_STAGE(PG8_SB(0, 0), cB, voffB); PG8_STAGE(PG8_SB(0, 1), cB + hstep, voffB); PG8_STAGE(PG8_SA(0, 0), cA, voffA); PG8_STAGE(PG8_SA(0, 1), cA + hstep, voffA);
        if (wr == 1) PG8_BAR;
        PG8_WAIT_V(2); PG8_BAR;
        PG8_STAGE(PG8_SB(1, 0), cB + kstep, voffB); PG8_STAGE(PG8_SA(1, 0), cA + kstep, voffA); PG8_STAGE(PG8_SB(1, 1), cB + hstep + kstep, voffB);
        PG8_WAIT_V(6); PG8_BAR;
    } else {
        PG8_STAGE(PG8_SB(0, 0), cB, voffB); PG8_STAGE(PG8_SA(0, 0), cA, voffA); PG8_STAGE(PG8_SB(0, 1), cB + hstep, voffB); PG8_STAGE(PG8_SA(0, 1), cA + hstep, voffA);
        if (wr == 1) PG8_BAR;
        PG8_WAIT_V(4); PG8_BAR;
        PG8_STAGE(PG8_SB(1, 0), cB + kstep, voffB); PG8_STAGE(PG8_SA(1, 0), cA + kstep, voffA); PG8_STAGE(PG8_SB(1, 1), cB + hstep + kstep, voffB);
        PG8_WAIT_V(6); PG8_BAR;
    }
    for (;;) {
        const bool has_next = S.next(ui + 1, nxt);
        const char* nA = has_next ? (const char*)g.A + (size_t)nxt.pm * tstep : cA; const char* nB = has_next ? (const char*)g.Bt + (size_t)nxt.pn * tstep : cB;
#pragma unroll 1
        for (int t = 0; t < nt; t += 2) {
            if constexpr (Epi::MIDHOOK) { if (t == nt / 2) E.mid(acc, cur, wr, wc, fr, fq); }
            const bool last = (t == nt - 2);
            const char* a1 = cA + (size_t)(t + 1) * kstep;
            const char* a2 = last ? nA : cA + (size_t)(t + 2) * kstep; const char* b2 = last ? nB : cB + (size_t)(t + 2) * kstep;
            const char* a3 = a2 + kstep; const char* b3 = b2 + kstep;
            if (last && has_next) S.a_ready(nxt);
            if constexpr (SP2) {
            PG8_LDB(B0, 0, 0); PG8_LDB(B1, 0, 1); PG8_SCHED; PG8_LDA(At, 0, 0); PG8_STAGE(PG8_SA(1, 1), a1 + hstep, voffA);
            PG8_WAIT_V(8); PG8_WAIT_L(0); PG8_BAR; PG8_MMA(0, 0, At, B0); PG8_MMA(0, 1, At, B1); PG8_BAR; PG8_SCHED;
            PG8_LDA(At, 0, 1); PG8_STAGE(PG8_SB(0, 0), b2, voffB); PG8_STAGE(PG8_SB(0, 1), b2 + hstep, voffB); PG8_STAGE(PG8_SA(0, 0), a2, voffA);
            PG8_WAIT_V(8); PG8_WAIT_L(0); PG8_BAR; PG8_MMA(1, 0, At, B0); PG8_MMA(1, 1, At, B1); PG8_BAR; PG8_SCHED;
            PG8_LDB(B0, 1, 0); PG8_LDB(B1, 1, 1); PG8_SCHED; PG8_LDA(At, 1, 0); PG8_STAGE(PG8_SA(0, 1), a2 + hstep, voffA);
            PG8_WAIT_V(8); PG8_WAIT_L(0); PG8_BAR; PG8_MMA(0, 0, At, B0); PG8_MMA(0, 1, At, B1); PG8_BAR; PG8_SCHED;
            PG8_LDA(At, 1, 1); PG8_STAGE(PG8_SB(1, 0), b3, voffB); PG8_STAGE(PG8_SB(1, 1), b3 + hstep, voffB); PG8_STAGE(PG8_SA(1, 0), a3, voffA);
            PG8_WAIT_V(8); PG8_WAIT_L(0); PG8_BAR; PG8_MMA(1, 0, At, B0); PG8_MMA(1, 1, At, B1); PG8_BAR; PG8_SCHED;
            } else {
            PG8_LDB(B0, 0, 0); PG8_SCHED; PG8_LDA(At, 0, 0); PG8_STAGE(PG8_SA(1, 1), a1 + hstep, voffA);
            PG8_WAIT_L(8); PG8_BAR; PG8_WAIT_L(0); PG8_MMA(0, 0, At, B0); PG8_BAR; PG8_SCHED;
            PG8_LDB(B1, 0, 1); PG8_STAGE(PG8_SB(0, 0), b2, voffB);
            PG8_BAR; PG8_WAIT_L(0); PG8_MMA(0, 1, At, B1); PG8_BAR;
            PG8_LDA(At, 0, 1); PG8_STAGE(PG8_SA(0, 0), a2, voffA);
            PG8_BAR; PG8_WAIT_L(0); PG8_MMA(1, 0, At, B0); PG8_BAR; PG8_SCHED;
            PG8_STAGE(PG8_SB(0, 1), b2 + hstep, voffB);
            PG8_WAIT_V(6); PG8_BAR; PG8_MMA(1, 1, At, B1); PG8_BAR;
            PG8_LDB(B0, 1, 0); PG8_SCHED; PG8_LDA(At, 1, 0); PG8_STAGE(PG8_SA(0, 1), a2 + hstep, voffA);
            PG8_WAIT_L(8); PG8_BAR; PG8_WAIT_L(0); PG8_MMA(0, 0, At, B0); PG8_BAR; PG8_SCHED;
            PG8_LDB(B1, 1, 1); PG8_STAGE(PG8_SB(1, 0), b3, voffB);
            PG8_BAR; PG8_WAIT_L(0); PG8_MMA(0, 1, At, B1); PG8_BAR;
            PG8_LDA(At, 1, 1); PG8_STAGE(PG8_SA(1, 0), a3, voffA);
            PG8_BAR; PG8_WAIT_L(0); PG8_MMA(1, 0, At, B0); PG8_BAR; PG8_SCHED;
            PG8_STAGE(PG8_SB(1, 1), b3 + hstep, voffB);
            PG8_WAIT_V(6); PG8_BAR; PG8_MMA(1, 1, At, B1); PG8_BAR;
            }
        }
        if constexpr (ALIGN_EPI) { if (wr == 0) PG8_BAR; }
        if constexpr (!Epi::AFTER_DRAIN) { E(acc, cur, wr, wc, fr, fq); S.done(cur); }
        if (!has_next) break;
#pragma unroll
        for (int a = 0; a < 2; ++a)
#pragma unroll
            for (int b = 0; b < 2; ++b)
#pragma unroll
                for (int m = 0; m < 4; ++m)
#pragma unroll
                    for (int n = 0; n < 2; ++n) acc[a][b][m][n] = (f32x4){0.f, 0.f, 0.f, 0.f};
        cur = nxt; cA = nA; cB = nB; ++ui;
        if constexpr (ALIGN_EPI) { if (wr == 1) PG8_BAR; }
    }
    PG8_WAIT_V(0);
    if constexpr (!ALIGN_EPI) { if (wr == 0) PG8_BAR; }
    PG8_BAR;
    if constexpr (Epi::AFTER_DRAIN) { E.fused(acc, cur, wr, wc, fr, fq, lds, wid, lane); S.done(cur); }
#undef PG8_SA
#undef PG8_SB
#undef PG8_STAGE
#undef PG8_LDA
#undef PG8_LDB
#undef PG8_MMA
#undef PG8_WAIT_V
#undef PG8_WAIT_L
#undef PG8_BAR
#undef PG8_SCHED
}
}

#define LAS __attribute__((address_space(3)))
typedef unsigned short bf16;
typedef float f32x4 __attribute__((ext_vector_type(4)));
typedef float f32x16 __attribute__((ext_vector_type(16)));
typedef short bf16x8 __attribute__((ext_vector_type(8)));
typedef unsigned u32x4 __attribute__((ext_vector_type(4)));
typedef unsigned u32x2 __attribute__((ext_vector_type(2)));

constexpr int NTOK = 65536, DM = 1024, DFF = 2816, SEQ = 2048, NBATCH = 32;
constexpr int NPAN = NTOK / 256;
constexpr float LN_EPS = 1e-5f, RMS_EPS = 1e-5f;
constexpr float DN_ALPHA = 1.189207115002721f;
constexpr float LAMBDA_INIT = 0.2f;
constexpr float QSCALE = 0.125f * 1.4426950408889634f;

constexpr size_t MiB = 1u << 20;
constexpr size_t WS_WGU1 = 0, WS_WD1 = 11 * MiB, WS_WIN = 17 * MiB, WS_WBA = 25 * MiB, WS_WBP = 26 * MiB, WS_WOUT = 27 * MiB, WS_WGU2 = 29 * MiB, WS_WD2 = 40 * MiB;
constexpr size_t WS_COS = 46 * MiB, WS_SIN = 46 * MiB + 256 * 1024;
constexpr size_t WS_XB = 48 * MiB;
constexpr size_t WS_YATT = WS_XB, WS_POOL = WS_XB + 64 * MiB;
constexpr size_t WS_X1F = 176 * MiB;
constexpr size_t WS_R1 = 432 * MiB;
constexpr size_t WS_Q = WS_R1, WS_K = WS_R1 + 64 * MiB, WS_VT = WS_R1 + 128 * MiB, WS_U = WS_R1 + 192 * MiB;
constexpr size_t WS_R2 = 784 * MiB;
constexpr size_t WS_O1S = 912 * MiB;
constexpr size_t WS_BAR = 944 * MiB;
constexpr size_t WS_END = 976 * MiB;
constexpr int LDS_BYTES = 139264;

__device__ __forceinline__ unsigned f2bf(float f) { unsigned u = __builtin_bit_cast(unsigned, f); return (u + 0x7fffu + ((u >> 16) & 1u)) >> 16; }
__device__ __forceinline__ unsigned pk2(float lo, float hi) { return f2bf(lo) | (f2bf(hi) << 16); }
__device__ __forceinline__ float wave_sum(float v) {
#pragma unroll
    for (int o = 1; o < 64; o <<= 1) v += __shfl_xor(v, o);
    return v;
}
__device__ __forceinline__ float swap_max(float m) { auto rr = __builtin_amdgcn_permlane32_swap(__float_as_uint(m), __float_as_uint(m), false, false); return fmaxf(__uint_as_float(rr[0]), __uint_as_float(rr[1])); }
__device__ __forceinline__ float swap_sum(float m) { auto rr = __builtin_amdgcn_permlane32_swap(__float_as_uint(m), __float_as_uint(m), false, false); return __uint_as_float(rr[0]) + __uint_as_float(rr[1]); }

struct MapOff { int off; __device__ __forceinline__ int operator()(int n) const { return off + n; } };
struct MapGateUp { int half; __device__ __forceinline__ int operator()(int n) const { return 256 * (n >> 7) + (n & 127) + 128 * half; } };
struct MapWin { __device__ __forceinline__ int operator()(int n) const {
    if (n < 1024) { const int t = n >> 8, r = n & 255, s = r >> 6, w = r & 63, hf = w >> 5, i = w & 31; return 256 * t + 128 * hf + 32 * s + i; }
    if (n < 1536) return 3584 + (n - 1024);
    if (n < 2048) return 1024 + (n - 1536);
    { const int c = n - 2048, br = c >> 10, j = c & 1023; return 1536 + 256 * (j >> 7) + 128 * br + (j & 127); } } };
template <class MAP>
__device__ __forceinline__ void transpose_item(const float* __restrict__ W, int K, int N, bf16* __restrict__ WT, const MAP map, LAS float* scr, int item, int lane, int ldw = 0) {
    if (ldw == 0) ldw = K;
    const int nblk = N / 32, kb = item / nblk, nb = item % nblk, k0 = 64 * kb, n0 = 32 * nb;
#pragma unroll 8
    for (int i = 0; i < 32; ++i) { const int kk = 2 * i + (lane >> 5); scr[kk * 33 + (lane & 31)] = __builtin_nontemporal_load(W + (size_t)(k0 + kk) * N + n0 + (lane & 31)); }
    asm volatile("s_waitcnt lgkmcnt(0)" ::: "memory");
    const int c = lane & 7;
#pragma unroll
    for (int j = 0; j < 4; ++j) { const int n = (lane >> 3) + 8 * j; const LAS float* s = scr + (8 * c) * 33 + n;
        u32x4 o; o.x = pk2(s[0 * 33], s[1 * 33]); o.y = pk2(s[2 * 33], s[3 * 33]); o.z = pk2(s[4 * 33], s[5 * 33]); o.w = pk2(s[6 * 33], s[7 * 33]);
        *(u32x4*)(WT + (size_t)map(n0 + n) * ldw + k0 + 8 * c) = o; }
    asm volatile("s_waitcnt lgkmcnt(0)" ::: "memory");
}

#define XB_TMO      128
#define XB_XCNT(j)  (256  + 64 * (j))
#define XB_XSUB(j)  (1280 + 64 * (j))
#define XB_XGEN(j)  (2304 + 64 * (j))
#define XB_TOP      3328
#define XB_TOPGEN   3392
#define XCD_BAR_WORDS 3456
#define XB_SPIN_CAP (1u << 18)

__device__ __forceinline__ unsigned xb_ld(unsigned* p)              { return __hip_atomic_load(p, __ATOMIC_RELAXED, __HIP_MEMORY_SCOPE_AGENT); }
__device__ __forceinline__ unsigned xb_add(unsigned* p, unsigned v) { return __hip_atomic_fetch_add(p, v, __ATOMIC_RELAXED, __HIP_MEMORY_SCOPE_AGENT); }
__device__ __forceinline__ unsigned xb_xcc_id() { return (unsigned)__builtin_amdgcn_s_getreg((3 << 11) | 20) & 0xFu; }
#define XB_SPIN(cond, bar) do { unsigned _sp = 0; while (cond) { __builtin_amdgcn_s_sleep(1); \
    if ((++_sp & 255u) == 0u) { if (xb_ld(&(bar)[XB_TMO])) break; if (_sp > XB_SPIN_CAP) { atomicAdd(&(bar)[XB_TMO], 1u); break; } } } } while (0)

struct XcdBarrier {
    unsigned* bar; unsigned x;
    volatile LAS unsigned* st;
};

__device__ __forceinline__ XcdBarrier xcd_barrier_post(unsigned* bar, volatile LAS unsigned* st) {
    XcdBarrier b; b.bar = bar; b.x = xb_xcc_id(); b.st = st;
    if (threadIdx.x == 0) (void)xb_add(&bar[XB_XCNT(b.x)], 1u);
    return b;
}
__device__ __forceinline__ void xcd_barrier_complete(unsigned* bar, unsigned x, unsigned& nloc, unsigned& nx) {
    const unsigned G = gridDim.x * gridDim.y * gridDim.z;
    unsigned sum, cnt, mine, sp = 0u;
    for (;;) {
        sum = 0u; cnt = 0u; mine = 0u;
#pragma unroll
        for (unsigned j = 0; j < 16; ++j) { const unsigned c = xb_ld(&bar[XB_XCNT(j)]); sum += c; cnt += (c > 0u) ? 1u : 0u; mine = (j == x) ? c : mine; }
        if (sum == G) break;
        __builtin_amdgcn_s_sleep(1);
        if ((++sp & 255u) == 0u) { if (xb_ld(&bar[XB_TMO])) break; if (sp > XB_SPIN_CAP) { atomicAdd(&bar[XB_TMO], 1u); break; } }
    }
    nloc = mine > 0u ? mine : 1u; nx = cnt > 0u ? cnt : 1u;
}

__device__ __forceinline__ void xcd_barrier(const XcdBarrier& b) {
    asm volatile("s_waitcnt vmcnt(0)" ::: "memory");
    __syncthreads();
    if (threadIdx.x == 0) {
        unsigned* bar = b.bar;
        __builtin_amdgcn_s_waitcnt(0);
        unsigned nloc = b.st[0], nx = b.st[1];
        if (nloc == 0u) { xcd_barrier_complete(bar, b.x, nloc, nx); b.st[0] = nloc; b.st[1] = nx; }
        const unsigned old = xb_add(&bar[XB_XSUB(b.x)], 1u);
        const unsigned gen = old / nloc;
        if (old + 1u == (gen + 1u) * nloc) {
            __builtin_amdgcn_fence(__ATOMIC_RELEASE, "agent");
            asm volatile("s_waitcnt vmcnt(0)" ::: "memory");
            const unsigned og = xb_add(&bar[XB_TOP], 1u);
            const unsigned tg = og / nx;
            if (og + 1u == (tg + 1u) * nx) xb_add(&bar[XB_TOPGEN], 1u);
            else XB_SPIN(xb_ld(&bar[XB_TOPGEN]) == tg, bar);
            __builtin_amdgcn_fence(__ATOMIC_ACQUIRE, "agent");
            xb_add(&bar[XB_XGEN(b.x)], 1u);
            asm volatile("s_waitcnt vmcnt(0)" ::: "memory");
        } else {
            XB_SPIN(xb_ld(&bar[XB_XGEN(b.x)]) == gen, bar);
            __builtin_amdgcn_fence(__ATOMIC_ACQUIRE, "agent");
            asm volatile("s_waitcnt vmcnt(0)" ::: "memory");
        }
    }
    __syncthreads();
}

struct Args { const float* in[24]; float* out; unsigned char* ws; int ph_lo, ph_hi, rep_mask, pad; };

__device__ __forceinline__ void ln_panel(const bf16* Y, float* Xf, bf16* Xb, const float* g, const float* bta, int pm, int wid, int lane) {
    asm volatile("" : "+s"(g), "+s"(bta));
    f32x4 gv[4], bv[4];
#pragma unroll
    for (int j = 0; j < 2; ++j)
#pragma unroll
        for (int n = 0; n < 2; ++n) { gv[2 * j + n] = *(const f32x4*)(g + 8 * lane + 512 * j + 4 * n); bv[2 * j + n] = *(const f32x4*)(bta + 8 * lane + 512 * j + 4 * n); }
    constexpr int RB = 4;
#pragma unroll 1
    for (int r = 0; r < 32; r += RB) {
        const size_t row0 = (size_t)pm * 256 + wid * 32 + r;
        u32x4 raw[RB][2]; f32x4 v[RB][4]; float s[RB];
#pragma unroll
        for (int q = 0; q < RB; ++q)
#pragma unroll
            for (int j = 0; j < 2; ++j) raw[q][j] = *(const u32x4*)(Y + (row0 + q) * 1024 + 8 * lane + 512 * j);
#pragma unroll
        for (int q = 0; q < RB; ++q) { s[q] = 0.f;
#pragma unroll
            for (int j = 0; j < 2; ++j) pg8::unpack8(raw[q][j], v[q][2 * j], v[q][2 * j + 1]);
#pragma unroll
            for (int j = 0; j < 4; ++j) s[q] += (v[q][j][0] + v[q][j][1]) + (v[q][j][2] + v[q][j][3]); }
#pragma unroll
        for (int o = 1; o < 64; o <<= 1)
#pragma unroll
            for (int q = 0; q < RB; ++q) s[q] += __shfl_xor(s[q], o);
        float s2[RB];
#pragma unroll
        for (int q = 0; q < RB; ++q) { const float mean = s[q] * (1.0f / 1024.0f); s2[q] = 0.f;
#pragma unroll
            for (int j = 0; j < 4; ++j) { v[q][j] = v[q][j] - mean; s2[q] += (v[q][j][0] * v[q][j][0] + v[q][j][1] * v[q][j][1]) + (v[q][j][2] * v[q][j][2] + v[q][j][3] * v[q][j][3]); } }
#pragma unroll
        for (int o = 1; o < 64; o <<= 1)
#pragma unroll
            for (int q = 0; q < RB; ++q) s2[q] += __shfl_xor(s2[q], o);
#pragma unroll
        for (int q = 0; q < RB; ++q) { const float rstd = 1.0f / sqrtf(s2[q] * (1.0f / 1024.0f) + LN_EPS); const size_t row = row0 + q;
#pragma unroll
            for (int j = 0; j < 2; ++j) { const f32x4 o0 = v[q][2 * j] * rstd * gv[2 * j] + bv[2 * j], o1 = v[q][2 * j + 1] * rstd * gv[2 * j + 1] + bv[2 * j + 1];
                if (Xf) { *(f32x4*)(Xf + row * 1024 + 8 * lane + 512 * j) = o0; *(f32x4*)(Xf + row * 1024 + 8 * lane + 512 * j + 4) = o1; }
                if (Xb) *(u32x4*)(Xb + row * 1024 + 8 * lane + 512 * j) = pg8::pack8(o0, o1); } }
    }
}

struct AttnState { float mrun, l; };
#define DSR128(dst, addr, off) asm volatile("ds_read_b128 %0, %1 offset:%2" : "=&v"(dst) : "v"(addr), "i"(off))
template <bool FIRST, bool HAS_PREV>
__device__ __forceinline__ void attn_step(f32x16& c0, f32x16& c1, f32x16 (&o)[4], bf16x8 (&pbp)[4], const bf16x8 (&qr)[4], AttnState& st,
                                          const LAS unsigned char* kfr, const LAS unsigned char* vfr, const int (&kofs)[4], const int (&vofs)[4]) {
    const unsigned kb_ = (unsigned)(unsigned long)kfr, vb_ = (unsigned)(unsigned long)vfr;
    unsigned ka[4], va[4];
#pragma unroll
    for (int k = 0; k < 4; ++k) { ka[k] = kb_ + (unsigned)kofs[k]; va[k] = vb_ + (unsigned)vofs[k]; }
    bf16x8 kf[4], vA[4], vB[4];
    { const float nm = FIRST ? 0.f : -st.mrun;
#pragma unroll
      for (int i = 0; i < 16; ++i) { c0[i] = nm; c1[i] = nm; } }
#pragma unroll
    for (int ks = 0; ks < 2; ++ks) { DSR128(kf[2 * ks], ka[ks], 0); DSR128(kf[2 * ks + 1], ka[ks], 4096); }
    asm volatile("s_waitcnt lgkmcnt(0)" : "+v"(kf[0]), "+v"(kf[1]), "+v"(kf[2]), "+v"(kf[3]));
#pragma unroll
    for (int ks = 0; ks < 2; ++ks) {
        c0 = __builtin_amdgcn_mfma_f32_32x32x16_bf16(kf[2 * ks], qr[ks], c0, 0, 0, 0);
        c1 = __builtin_amdgcn_mfma_f32_32x32x16_bf16(kf[2 * ks + 1], qr[ks], c1, 0, 0, 0);
    }
    __builtin_amdgcn_sched_barrier(0);
    { bf16x8 kg[4];
#pragma unroll
      for (int ks = 0; ks < 2; ++ks) { DSR128(kg[2 * ks], ka[2 + ks], 0); DSR128(kg[2 * ks + 1], ka[2 + ks], 4096); }
      asm volatile("s_waitcnt lgkmcnt(0)" : "+v"(kg[0]), "+v"(kg[1]), "+v"(kg[2]), "+v"(kg[3]));
#pragma unroll
      for (int ks = 0; ks < 2; ++ks) {
          c0 = __builtin_amdgcn_mfma_f32_32x32x16_bf16(kg[2 * ks], qr[2 + ks], c0, 0, 0, 0);
          c1 = __builtin_amdgcn_mfma_f32_32x32x16_bf16(kg[2 * ks + 1], qr[2 + ks], c1, 0, 0, 0);
      } }
    __builtin_amdgcn_sched_barrier(0);
    if (HAS_PREV) {
#pragma unroll
        for (int e = 0; e < 4; ++e) DSR128(vA[e], va[0], e * 4096);
    }
    float mx = fmaxf(c0[0], c1[0]);
#pragma unroll
    for (int i = 1; i < 16; ++i) mx = fmaxf(mx, fmaxf(c0[i], c1[i]));
    mx = swap_max(mx);
    float a = 1.0f;
    { const float dl = FIRST ? mx : ((mx > 8.0f) ? mx : 0.f);
      if (FIRST || __any(dl != 0.f)) {
#pragma unroll
          for (int i = 0; i < 16; ++i) { c0[i] -= dl; c1[i] -= dl; }
          st.mrun += dl; if (!FIRST) a = __builtin_amdgcn_exp2f(-dl);
      } }
    float ps = 0.f;
#define ATT_EXPS(E) do { _Pragma("unroll") for (int j = 0; j < 8; ++j) { const int i = (E) * 8 + j; \
        if (i < 16) { c0[i] = __builtin_amdgcn_exp2f(c0[i]); ps += c0[i]; } else { c1[i - 16] = __builtin_amdgcn_exp2f(c1[i - 16]); ps += c1[i - 16]; } } \
        asm volatile("" : "+v"(c0), "+v"(c1), "+v"(ps)); __builtin_amdgcn_sched_barrier(0); } while (0)
#define ATT_PV(KK, VF) do { _Pragma("unroll") for (int e = 0; e < 4; ++e) o[e] = __builtin_amdgcn_mfma_f32_32x32x16_bf16(VF[e], pbp[KK], o[e], 0, 0, 0); } while (0)
#define ATT_TIE(N, VF) asm volatile("s_waitcnt lgkmcnt(" #N ")" : "+v"(VF[0]), "+v"(VF[1]), "+v"(VF[2]), "+v"(VF[3]))
    if (HAS_PREV) {
        __builtin_amdgcn_sched_barrier(0);
#pragma unroll
        for (int e = 0; e < 4; ++e) DSR128(vB[e], va[1], e * 4096);
        ATT_TIE(4, vA); ATT_PV(0, vA); ATT_EXPS(0);
#pragma unroll
        for (int e = 0; e < 4; ++e) DSR128(vA[e], va[2], e * 4096);
        ATT_TIE(4, vB); ATT_PV(1, vB); ATT_EXPS(1);
#pragma unroll
        for (int e = 0; e < 4; ++e) DSR128(vB[e], va[3], e * 4096);
        ATT_TIE(4, vA); ATT_PV(2, vA); ATT_EXPS(2);
        ATT_TIE(0, vB); ATT_PV(3, vB); ATT_EXPS(3);
    } else {
#pragma unroll
        for (int i = 0; i < 16; ++i) { c0[i] = __builtin_amdgcn_exp2f(c0[i]); ps += c0[i]; c1[i] = __builtin_amdgcn_exp2f(c1[i]); ps += c1[i]; }
    }
#undef ATT_EXPS
#undef ATT_PV
#undef ATT_TIE
    st.l = st.l * a + ps;
    if (!FIRST) { if (__any(a != 1.0f)) {
#pragma unroll
        for (int e = 0; e < 4; ++e)
#pragma unroll
            for (int i = 0; i < 16; ++i) o[e][i] *= a; } }
    { u32x4 w;
      w.x = pg8::cvt_pk_bf16(c0[0], c0[1]); w.y = pg8::cvt_pk_bf16(c0[2], c0[3]); w.z = pg8::cvt_pk_bf16(c0[4], c0[5]); w.w = pg8::cvt_pk_bf16(c0[6], c0[7]); pbp[0] = __builtin_bit_cast(bf16x8, w);
      w.x = pg8::cvt_pk_bf16(c0[8], c0[9]); w.y = pg8::cvt_pk_bf16(c0[10], c0[11]); w.z = pg8::cvt_pk_bf16(c0[12], c0[13]); w.w = pg8::cvt_pk_bf16(c0[14], c0[15]); pbp[1] = __builtin_bit_cast(bf16x8, w);
      w.x = pg8::cvt_pk_bf16(c1[0], c1[1]); w.y = pg8::cvt_pk_bf16(c1[2], c1[3]); w.z = pg8::cvt_pk_bf16(c1[4], c1[5]); w.w = pg8::cvt_pk_bf16(c1[6], c1[7]); pbp[2] = __builtin_bit_cast(bf16x8, w);
      w.x = pg8::cvt_pk_bf16(c1[8], c1[9]); w.y = pg8::cvt_pk_bf16(c1[10], c1[11]); w.z = pg8::cvt_pk_bf16(c1[12], c1[13]); w.w = pg8::cvt_pk_bf16(c1[14], c1[15]); pbp[3] = __builtin_bit_cast(bf16x8, w); }
}
__device__ __forceinline__ void attn_unit(LAS unsigned char* lds, const bf16* __restrict__ Qb, const bf16* __restrict__ Kb, const bf16* __restrict__ VT, bf16* __restrict__ Y,
                                          const float* __restrict__ gsub, float lam, int b, int h, int qb, float* o1scr) {
    int tid_ = threadIdx.x; asm volatile("" : "+v"(tid_));
    const int tid = tid_, lane = tid & 63, wid = __builtin_amdgcn_readfirstlane(tid >> 6), r32 = lane & 31, hi = lane >> 5;
    const size_t tok0 = (size_t)b * SEQ;
    constexpr int KSL = 8192, VSL = 16384, VB0 = 3 * KSL;
    const int kap = 16 * ((r32 >> 4) & 1) + 8 * ((r32 >> 2) & 1) + 4 * ((r32 >> 3) & 1) + (r32 & 3);
    int kofs[4], vofs[4];
#pragma unroll
    for (int k = 0; k < 4; ++k) { kofs[k] = kap * 128 + (((2 * k + hi) ^ ((kap >> 1) & 7)) << 4); vofs[k] = r32 * 128 + (((2 * k + hi) ^ ((r32 >> 1) & 7)) << 4); }
    const int lrow = tid >> 3, lc = (tid & 7) ^ ((lrow >> 1) & 7);
    const int kcol = (lc < 4) ? 8 * lc : 128 + 8 * (lc - 4);
    const unsigned wofs = (unsigned)wid * 1024u;
    f32x16 o[4]; float inv = 0.f;
#define ATT_WAITBAR(N) do { asm volatile("s_waitcnt vmcnt(" #N ") lgkmcnt(0)" ::: "memory"); __builtin_amdgcn_s_barrier(); asm volatile("" ::: "memory"); } while (0)
#define ATT_DMA(src, ldsoff) __builtin_amdgcn_global_load_lds((const unsigned*)(src), (LAS unsigned*)(lds + (ldsoff) + wofs), 16, 0, 0)
#pragma unroll 1
    for (int mp = 0; mp < 2; ++mp) {
        const int c1 = 256 * (h >> 1) + 32 * (2 * (h & 1) + mp);
        const bf16* qp = Qb + (tok0 + (size_t)qb * 256 + wid * 32 + r32) * 512 + c1 + 8 * hi;
        bf16x8 qr[4];
        qr[0] = *(const bf16x8*)(qp); qr[1] = *(const bf16x8*)(qp + 16); qr[2] = *(const bf16x8*)(qp + 128); qr[3] = *(const bf16x8*)(qp + 144);
        const bf16* kp = Kb + (tok0 + lrow) * 512 + c1 + kcol;
        const bf16* vp = VT + ((size_t)((b * 4 + h) * 32) * 128 + lrow) * 64 + lc * 8;
        ATT_DMA(kp, 0); ATT_DMA(vp, VB0); ATT_DMA(vp + 4096, VB0 + 8192); ATT_DMA(kp + (size_t)64 * 512, KSL);
        ATT_WAITBAR(0);
#pragma unroll
        for (int e = 0; e < 4; ++e)
#pragma unroll
            for (int i = 0; i < 16; ++i) o[e][i] = 0.f;
        AttnState st; st.mrun = 0.f; st.l = 0.f;
        bf16x8 pbp[4];
        f32x16 sA, sB;
        int s0 = 0, s1 = 1, s2 = 2;
#define ATT_STEP(T, FIRST, HASP) do { const int t_ = (T); \
        if (t_ + 2 < 32) ATT_DMA(kp + (size_t)(t_ + 2) * 64 * 512, s2 * KSL); \
        if (t_ + 1 < 32) { ATT_DMA(vp + (size_t)(t_ + 1) * 8192, VB0 + s1 * VSL); ATT_DMA(vp + (size_t)(t_ + 1) * 8192 + 4096, VB0 + s1 * VSL + 8192); } \
        attn_step<FIRST, HASP>(sA, sB, o, pbp, qr, st, lds + s0 * KSL, lds + VB0 + s2 * VSL, kofs, vofs); \
        if (t_ + 2 < 32) ATT_WAITBAR(3); else ATT_WAITBAR(0); \
        { const int tmp_ = s0; s0 = s1; s1 = s2; s2 = tmp_; } } while (0)
        ATT_STEP(0, true, false);
#pragma unroll 1
        for (int t = 1; t < 32; ++t) ATT_STEP(t, false, true);
#undef ATT_STEP
        { const LAS unsigned char* vb = lds + VB0 + 1 * VSL;
#pragma unroll
          for (int e = 0; e < 4; ++e)
#pragma unroll
              for (int kk = 0; kk < 4; ++kk) { const bf16x8 vf = *(const LAS bf16x8*)(vb + e * 4096 + vofs[kk]);
                  o[e] = __builtin_amdgcn_mfma_f32_32x32x16_bf16(vf, pbp[kk], o[e], 0, 0, 0); } }
        ATT_WAITBAR(0);
        inv = 1.0f / swap_sum(st.l);
        if (mp == 0) {
#pragma unroll
            for (int e = 0; e < 4; ++e)
#pragma unroll
                for (int a = 0; a < 4; ++a) { f32x4 v = {o[e][4 * a] * inv, o[e][4 * a + 1] * inv, o[e][4 * a + 2] * inv, o[e][4 * a + 3] * inv};
                    *(f32x4*)(o1scr + ((size_t)(e * 4 + a) * 512 + tid) * 4) = v; }
        }
    }
#undef ATT_WAITBAR
#undef ATT_DMA
    {
        const float li = lam * inv; float ss = 0.f;
#pragma unroll
        for (int e = 0; e < 4; ++e)
#pragma unroll
            for (int a = 0; a < 4; ++a) { const f32x4 v1 = *(const f32x4*)(o1scr + ((size_t)(e * 4 + a) * 512 + tid) * 4);
#pragma unroll
                for (int k = 0; k < 4; ++k) { const float v = v1[k] - li * o[e][4 * a + k]; o[e][4 * a + k] = v; ss += v * v; } }
        ss = swap_sum(ss);
        const float rs = (1.0f - LAMBDA_INIT) / sqrtf(ss * (1.0f / 128.0f) + RMS_EPS);
        bf16* yp = Y + (tok0 + (size_t)qb * 256 + wid * 32 + r32) * 1024 + h * 128 + 4 * hi;
#pragma unroll
        for (int e = 0; e < 4; ++e)
#pragma unroll
            for (int a = 0; a < 4; ++a) { const f32x4 gg = *(const f32x4*)(gsub + 32 * e + 8 * a + 4 * hi);
                u32x2 w; w.x = pk2(o[e][4 * a] * rs * gg[0], o[e][4 * a + 1] * rs * gg[1]); w.y = pk2(o[e][4 * a + 2] * rs * gg[2], o[e][4 * a + 3] * rs * gg[3]);
                *(u32x2*)(yp + 32 * e + 8 * a) = w; }
    }
}

constexpr int NPHASE = 12;
__global__ void __launch_bounds__(512, 2) fwd_mega(Args a) {
    extern __shared__ __attribute__((aligned(16))) unsigned char lds_raw[];
    LAS unsigned char* lds = (LAS unsigned char*)lds_raw;
    cg::grid_group grid = cg::this_grid();
    const int tid = threadIdx.x, lane = tid & 63, wid = __builtin_amdgcn_readfirstlane(tid >> 6);
    const int G = gridDim.x, bx = blockIdx.x;
    const int lo = a.ph_lo, hi = a.ph_hi;
    const bool fused = (hi - lo) > 1;
    volatile LAS unsigned* MISC = (volatile LAS unsigned*)(lds + 131072 + 512);
    if (tid < 4) MISC[tid] = 0u;
    __syncthreads();
    XcdBarrier xbar; xbar.bar = (unsigned*)(a.ws + WS_BAR); xbar.x = 0; xbar.st = MISC;
    if (fused) xbar = xcd_barrier_post((unsigned*)(a.ws + WS_BAR), MISC);
    if (a.ph_lo < 0) grid.sync();
    unsigned char* ws = a.ws;
    const float* x = a.in[0];
    bf16* Wgu1 = (bf16*)(ws + WS_WGU1); bf16* Wd1 = (bf16*)(ws + WS_WD1); bf16* Win = (bf16*)(ws + WS_WIN); bf16* Wba = (bf16*)(ws + WS_WBA); bf16* Wbp = (bf16*)(ws + WS_WBP);
    bf16* Wout = (bf16*)(ws + WS_WOUT); bf16* Wgu2 = (bf16*)(ws + WS_WGU2); bf16* Wd2 = (bf16*)(ws + WS_WD2);
    float* cosT = (float*)(ws + WS_COS); float* sinT = (float*)(ws + WS_SIN);
    bf16* XB = (bf16*)(ws + WS_XB); bf16* YATT = (bf16*)(ws + WS_YATT); bf16* POOL = (bf16*)(ws + WS_POOL);
    bf16* Y1 = (bf16*)(ws + WS_X1F);
    bf16* X1B = (bf16*)a.out;
    bf16* HB = (bf16*)(ws + WS_R1); bf16* QB = (bf16*)(ws + WS_Q); bf16* KB = (bf16*)(ws + WS_K); bf16* VTB = (bf16*)(ws + WS_VT); bf16* UB = (bf16*)(ws + WS_U);
    bf16* TB = (bf16*)(ws + WS_R1);
    bf16* MG = (bf16*)(ws + WS_R2);
    float* O1S = (float*)(ws + WS_O1S) + (size_t)bx * (512 * 64);
    bf16* GATE = (bf16*)(ws + WS_X1F);
    float* OUT = a.out;
#ifndef PHM
#define PHM 4095
#endif
#define IN_PH(k) ((((PHM) >> (k)) & 1) && lo <= (k) && (k) < hi)
#define REPS(k) (IN_PH(k) ? 1 + ((a.rep_mask >> (k)) & 1) : 0)
#define SEAM(k) do { if (lo <= (k) && (k) + 1 < hi) { xcd_barrier(xbar); } } while (0)
#define WG_HANDOFF() do { asm volatile("s_waitcnt vmcnt(0) lgkmcnt(0)" ::: "memory"); __syncthreads(); __builtin_amdgcn_fence(__ATOMIC_ACQUIRE, "agent"); asm volatile("s_waitcnt vmcnt(0)" ::: "memory"); } while (0)

    if (IN_PH(0)) {
        LAS float* scr = (LAS float*)(lds + wid * 16384);
        const int gw = bx * 8 + wid, NGW = G * 8;
        constexpr int I_GU = (DM / 64) * (DFF / 32), I_DN = (DFF / 64) * (DM / 32), I_IN = (DM / 64) * (4096 / 32), I_BA = (512 / 64) * (DM / 32), I_OUT = (DM / 64) * (DM / 32);
        constexpr int NITEMS = 4 * I_GU + 2 * I_DN + I_IN + I_BA + I_OUT;
        for (int it = gw; it < NITEMS; it += NGW) {
            int r = it;
            if (r < I_GU) { transpose_item(a.in[3], DM, DFF, Wgu1, MapGateUp{0}, scr, r, lane); continue; } r -= I_GU;
            if (r < I_GU) { transpose_item(a.in[4], DM, DFF, Wgu1, MapGateUp{1}, scr, r, lane); continue; } r -= I_GU;
            if (r < I_GU) { transpose_item(a.in[19], DM, DFF, Wgu2, MapGateUp{0}, scr, r, lane); continue; } r -= I_GU;
            if (r < I_GU) { transpose_item(a.in[20], DM, DFF, Wgu2, MapGateUp{1}, scr, r, lane); continue; } r -= I_GU;
            if (r < I_DN) { transpose_item(a.in[5], DFF, DM, Wd1, MapOff{0}, scr, r, lane); continue; } r -= I_DN;
            if (r < I_DN) { transpose_item(a.in[21], DFF, DM, Wd2, MapOff{0}, scr, r, lane); continue; } r -= I_DN;
            if (r < I_IN) { transpose_item(a.in[6], DM, 4096, Win, MapWin{}, scr, r, lane); continue; } r -= I_IN;
            if (r < I_BA) { transpose_item(a.in[14], 512, DM, Wba, MapOff{0}, scr, r, lane, 1024); continue; } r -= I_BA;
            transpose_item(a.in[16], DM, DM, Wout, MapOff{0}, scr, r, lane);
        }
        const size_t gt = (size_t)bx * 512 + tid, NT = (size_t)G * 512;
        { const float* pw = a.in[12]; const float* psc = a.in[13]; const float* wbp = a.in[15];
          for (int w = gw; w < 1024 * 8; w += NGW) { const int n = w & 1023, gc = (w >> 10) * 64 + lane, g = gc >> 7;
              float acc = 0.f;
              for (int d = 0; d < 128; ++d) acc += pw[(size_t)gc * 128 + d] * psc[g * 128 + d] * wbp[(size_t)(g * 128 + d) * 1024 + n];
              Wba[(size_t)n * 1024 + 512 + gc] = (bf16)f2bf(acc); } }
        for (size_t idx = gt; idx < (size_t)SEQ * 32; idx += NT) { const int i = (int)(idx & 31), pos = (int)(idx >> 5);
            const float inv = 1.0f / powf(10000.0f, (float)(2 * i) / 64.0f); const float ang = (float)pos * inv;
            cosT[idx] = cosf(ang); sinT[idx] = sinf(ang); }
#pragma unroll 4
        for (size_t idx = gt; idx < (size_t)NTOK * DM / 8; idx += NT) { const f32x4 v0 = __builtin_nontemporal_load((const f32x4*)(x + idx * 8)), v1 = __builtin_nontemporal_load((const f32x4*)(x + idx * 8 + 4));
            u32x4 w; w.x = pk2(v0[0], v0[1]); w.y = pk2(v0[2], v0[3]); w.z = pk2(v1[0], v1[1]); w.w = pk2(v1[2], v1[3]); *(u32x4*)(XB + idx * 8) = w; }
        __syncthreads();
    }
    SEAM(0);
    if (IN_PH(1)) {
        pg8::Gemm g{XB, Wgu1, NTOK, 2 * DFF, DM}; pg8::StaticOrder S; S.init(NTOK, 2 * DFF, G, bx);
        pg8::EpiSwiglu E{HB, DFF};
        pg8::gemm_phase<pg8::EpiSwiglu, pg8::StaticOrder, true, true>(lds, g, S, E);
    }
    SEAM(1);
    if (IN_PH(2)) {
        pg8::Gemm g{HB, Wd1, NTOK, DM, DFF}; pg8::StaticOrder S; S.init(NTOK, DM, G, bx);
        pg8::EpiResid E{x, Y1, DN_ALPHA, 0.5f};
        pg8::gemm_phase<pg8::EpiResid, pg8::StaticOrder, true, true>(lds, g, S, E);
    }
    SEAM(2);
    if (IN_PH(3)) {
        for (int pm = bx; pm < NPAN; pm += G) ln_panel(Y1, nullptr, X1B, a.in[1], a.in[2], pm, wid, lane);
        __syncthreads();
    }
    SEAM(3);
    if (IN_PH(4)) {
        { pg8::Gemm g{X1B, Win, NTOK, 3584, DM}; pg8::StaticOrder S; S.init(NTOK, 3584, G, bx);
          pg8::EpiWin E{QB, KB, UB, GATE, cosT, sinT, QSCALE};
          pg8::gemm_phase<pg8::EpiWin, pg8::StaticOrder, true, true>(lds, g, S, E); }
        { pg8::Gemm g{Win + (size_t)3584 * DM, X1B, 512, NTOK, DM}; pg8::StaticOrder S; S.init(512, NTOK, G, bx);
          pg8::EpiVT E{VTB};
          pg8::gemm_phase<pg8::EpiVT, pg8::StaticOrder, true, true>(lds, g, S, E); }
    }
    SEAM(4);
    if (IN_PH(5)) {
        for (int item = bx * 512 + tid; item < NBATCH * 64 * 64; item += G * 512) {
            const int c8 = item & 63, seg = (item >> 6) & 63, bb = item >> 12;
            const int ch = c8 * 8, hw = 1 << (ch >> 7);
            const bf16* base = UB + (size_t)bb * SEQ * 512 + ch;
            bf16* obase = XB + (size_t)bb * SEQ * 1024 + 512 + ch;
            const int s0 = seg * 32;
            f32x4 w0 = {0.f, 0.f, 0.f, 0.f}, w1 = {0.f, 0.f, 0.f, 0.f};
            { const int jlo = (s0 - hw) > 0 ? (s0 - hw) : 0, jhi = (s0 + hw) < SEQ ? (s0 + hw) : SEQ;
              for (int j = jlo; j < jhi; ++j) { f32x4 a0, a1; pg8::unpack8(*(const u32x4*)(base + (size_t)j * 512), a0, a1); w0 += a0; w1 += a1; } }
#pragma unroll 4
            for (int s = s0; s < s0 + 32; ++s) {
                f32x4 u0, u1; pg8::unpack8(*(const u32x4*)(base + (size_t)s * 512), u0, u1);
                const int jlo = (s - hw) > 0 ? (s - hw) : 0, jhi = (s + hw) < SEQ ? (s + hw) : SEQ;
                const float rc = 1.0f / (float)(jhi - jlo);
                *(u32x4*)(obase + (size_t)s * 1024) = pg8::pack8(w0 * rc - u0, w1 * rc - u1);
                if (s + hw < SEQ) { f32x4 a0, a1; pg8::unpack8(*(const u32x4*)(base + (size_t)(s + hw) * 512), a0, a1); w0 += a0; w1 += a1; }
                if (s - hw >= 0) { f32x4 a0, a1; pg8::unpack8(*(const u32x4*)(base + (size_t)(s - hw) * 512), a0, a1); w0 -= a0; w1 -= a1; }
            }
        }
        float lam;
        { const float p1 = a.in[7][lane] * a.in[8][lane], p2 = a.in[9][lane] * a.in[10][lane];
          lam = expf(wave_sum(p1)) - expf(wave_sum(p2)) + LAMBDA_INIT; }
        if (G == 256) {
            const int xc = bx & 7, j = bx >> 3;
            for (int i = 0; i < 4; ++i) { const int bh = i * 32 + xc * 4 + (j >> 3), qb = j & 7;
                attn_unit(lds, QB, KB, VTB, YATT, a.in[11], lam, bh >> 2, bh & 3, qb, O1S); }
        } else {
            for (int u = bx; u < 1024; u += G) attn_unit(lds, QB, KB, VTB, YATT, a.in[11], lam, (u >> 3) >> 2, (u >> 3) & 3, u & 7, O1S);
        }
    }
    SEAM(5);
    if (IN_PH(6)) {
        pg8::Gemm g{XB, Wba, NTOK, DM, DM}; pg8::StaticOrder S; S.init(NTOK, DM, G, bx);
        pg8::EpiGateMid E{GATE, MG};
        pg8::gemm_phase<pg8::EpiGateMid, pg8::StaticOrder, true, true>(lds, g, S, E);
    }
    SEAM(6);
    if (IN_PH(7)) {
        pg8::Gemm g{MG, Wout, NTOK, DM, DM}; pg8::StaticOrder S; S.init(NTOK, DM, G, bx);
        pg8::EpiResidB E{X1B, TB, DN_ALPHA, 1.0f};
        pg8::gemm_phase<pg8::EpiResidB, pg8::StaticOrder, true, true>(lds, g, S, E);
    }
    SEAM(7);
    if (IN_PH(8)) {
        for (int pm = bx; pm < NPAN; pm += G) ln_panel(TB, nullptr, MG, a.in[17], a.in[18], pm, wid, lane);
        __syncthreads();
    }
    SEAM(8);
    if (IN_PH(9)) {
        pg8::Gemm g{MG, Wgu2, NTOK, 2 * DFF, DM}; pg8::StaticOrder S; S.init(NTOK, 2 * DFF, G, bx);
        pg8::EpiSwiglu E{HB, DFF};
        pg8::gemm_phase<pg8::EpiSwiglu, pg8::StaticOrder, true, true>(lds, g, S, E);
    }
    SEAM(9);
    if (IN_PH(10)) {
        pg8::Gemm g{HB, Wd2, NTOK, DM, DFF}; pg8::StaticOrder S; S.init(NTOK, DM, G, bx);
        pg8::EpiResidB E{MG, Y1, DN_ALPHA, 0.5f};
        pg8::gemm_phase<pg8::EpiResidB, pg8::StaticOrder, true, true>(lds, g, S, E);
    }
    SEAM(10);
    if (IN_PH(11)) {
        for (int pm = bx; pm < NPAN; pm += G) ln_panel(Y1, OUT, nullptr, a.in[22], a.in[23], pm, wid, lane);
    }
}

#ifndef REP_MASK
#define REP_MASK 0
#endif
#ifndef MK_N_LAUNCHES
#define MK_N_LAUNCHES 1
#endif
extern "C" void kernel_launch(void* const* d_in, const int* in_sizes, int n_in, void* d_out, int out_size, void* d_ws, size_t ws_size, hipStream_t stream) {
    static int grid = 0;
    if (grid == 0) {
        if (n_in != 24 || in_sizes[0] != NTOK * DM || out_size != NTOK * DM || ws_size < WS_END) { fprintf(stderr, "kernel_launch: unexpected shapes (n_in %d, ws %zu)\n", n_in, ws_size); grid = -1; return; }
        int dev = 0, cus = 0, per_cu = 0;
        hipGetDevice(&dev); hipDeviceGetAttribute(&cus, hipDeviceAttributeMultiprocessorCount, dev);
        if (hipFuncSetAttribute((const void*)fwd_mega, hipFuncAttributeMaxDynamicSharedMemorySize, LDS_BYTES) != hipSuccess) { fprintf(stderr, "kernel_launch: hipFuncSetAttribute failed\n"); grid = -1; return; }
        if (hipOccupancyMaxActiveBlocksPerMultiprocessor(&per_cu, (const void*)fwd_mega, 512, LDS_BYTES) != hipSuccess || per_cu < 1) { fprintf(stderr, "kernel_launch: occupancy query says %d\n", per_cu); per_cu = 1; }
        (void)hipGetLastError();
        grid = cus * per_cu;
    }
    if (grid < 0) return;
    Args a{};
    for (int i = 0; i < 24; ++i) a.in[i] = (const float*)d_in[i];
    a.out = (float*)d_out; a.ws = (unsigned char*)d_ws;
    (void)hipMemsetAsync((unsigned char*)d_ws + WS_BAR, 0, 16384, stream);
#if MK_N_LAUNCHES == 1
    a.ph_lo = 0; a.ph_hi = NPHASE; a.rep_mask = REP_MASK;
    void* args[] = {&a};
    hipError_t e = hipLaunchCooperativeKernel((const void*)fwd_mega, dim3(grid), dim3(512), args, LDS_BYTES, stream);
    if (e != hipSuccess) fprintf(stderr, "cooperative launch failed: %s (grid %d)\n", hipGetErrorString(e), grid);
#else
    for (int p = 0; p < NPHASE; ++p) { a.ph_lo = p; a.ph_hi = p + 1; hipLaunchKernelGGL(fwd_mega, dim3(grid), dim3(512), LDS_BYTES, stream, a); }
#endif
}
```

```cpp
#include <hip/hip_runtime.h>
#include <hip/hip_cooperative_groups.h>
#include <cstdio>
#include <cstdint>
namespace cg = cooperative_groups;
namespace pg8 {
#define PG8_LAS __attribute__((address_space(3)))
typedef unsigned short bf16_t;
typedef short bf16x8 __attribute__((ext_vector_type(8)));
typedef float f32x4 __attribute__((ext_vector_type(4)));
typedef unsigned u32x4 __attribute__((ext_vector_type(4)));
constexpr int BM = 256, BK = 64, HALF = 128, HTB = HALF * BK * 2  , STAGE_BYTES = 8 * HTB, NXCD = 8, WGM = 4;

__host__ __device__ __forceinline__ int lds_byte(int r, int c) { const int st = (r >> 4) * 2 + (c >> 5), rr = r & 15, cc = c & 31, ob = rr * 64 + cc * 2; return st * 1024 + (ob ^ (((ob >> 9) & 1) << 5)); }
__host__ __device__ __forceinline__ void stage_rc(int b, int& R, int& C) { const int st = b / 1024, sb = b % 1024, swz = sb ^ (((sb >> 9) & 1) << 5); R = (st >> 1) * 16 + swz / 64; C = (st & 1) * 32 + (swz % 64) / 2; }
__host__ __device__ __forceinline__ int perm32(int rho) { const int n = rho >> 4, i = rho & 15; return 8 * (i >> 2) + 4 * n + (i & 3); }

struct Unit { int pm, pn; };
struct Gemm { const bf16_t* A; const bf16_t* Bt; int M, N, K; };

struct StaticOrder {
    int nM, nN, nwg, G, c;
    __host__ __device__ void init(int M, int N, int G_, int c_) { nM = M / BM; nN = N / BM; nwg = nM * nN; G = G_; c = c_; }
    __host__ __device__ bool next(int i, Unit& u) const {
        const long L = (long)i * G + c; if (L >= nwg) return false;
        int wgid = (int)L; { const int q = nwg / NXCD, r = nwg % NXCD, xcd = wgid % NXCD, off = wgid / NXCD; wgid = (xcd < r ? xcd * (q + 1) : r * (q + 1) + (xcd - r) * q) + off; }
        const int nig = WGM * nN, gid = wgid / nig, fm = gid * WGM, gsz = (nM - fm) < WGM ? (nM - fm) : WGM;
        u.pm = fm + ((wgid % nig) % gsz); u.pn = (wgid % nig) / gsz; return true;
    }
    __device__ __forceinline__ void a_ready(const Unit&) const {}
    __device__ __forceinline__ void done(const Unit&) const {}
};

typedef float cvt_f32x2_t __attribute__((ext_vector_type(2))); typedef __bf16 cvt_bf16x2_t __attribute__((ext_vector_type(2)));
__device__ __forceinline__ unsigned cvt_pk_bf16(float lo, float hi) { cvt_f32x2_t v = {lo, hi}; cvt_bf16x2_t b = __builtin_convertvector(v, cvt_bf16x2_t); return __builtin_bit_cast(unsigned, b); }
typedef float f32x2 __attribute__((ext_vector_type(2)));
struct PanelOrder {
    int pm, npn;
    __device__ __forceinline__ bool next(int i, Unit& u) const { if (i >= npn) return false; int p = pm, q = i; asm volatile("" : "+s"(p), "+s"(q));
        u.pm = p; u.pn = q; return true; }
    __device__ __forceinline__ void a_ready(const Unit&) const {}
    __device__ __forceinline__ void done(const Unit&) const {}
};
__device__ __forceinline__ float fast_sigmoid(float v) { return __builtin_amdgcn_rcpf(1.0f + __builtin_amdgcn_exp2f(v * -1.4426950408889634f)); }
__device__ __forceinline__ u32x4 pack8(const f32x4 a, const f32x4 b) { u32x4 w; w.x = cvt_pk_bf16(a[0], a[1]); w.y = cvt_pk_bf16(a[2], a[3]); w.z = cvt_pk_bf16(b[0], b[1]); w.w = cvt_pk_bf16(b[2], b[3]); return w; }
__device__ __forceinline__ void unpack8(const u32x4 w, f32x4& a, f32x4& b) {
    a[0] = __uint_as_float(w.x << 16); a[1] = __uint_as_float(w.x & 0xffff0000u); a[2] = __uint_as_float(w.y << 16); a[3] = __uint_as_float(w.y & 0xffff0000u);
    b[0] = __uint_as_float(w.z << 16); b[1] = __uint_as_float(w.z & 0xffff0000u); b[2] = __uint_as_float(w.w << 16); b[3] = __uint_as_float(w.w & 0xffff0000u);
}
struct EpiPlain {
    static constexpr bool PERM = true, AFTER_DRAIN = false, MIDHOOK = false;
    bf16_t* O; size_t ldc;
    __device__ __forceinline__ void operator()(const f32x4 (&acc)[2][2][4][2], const Unit& u, int wr, int wc, int fr, int fq) const {
        const int row0 = u.pm * BM + wr * 64 + fr, col0 = u.pn * BM + wc * 32 + 8 * fq;
#pragma unroll
        for (int ai = 0; ai < 2; ++ai)
#pragma unroll
            for (int m = 0; m < 4; ++m) { bf16_t* rowp = O + (size_t)(row0 + ai * HALF + m * 16) * ldc + col0;
#pragma unroll
                for (int bj = 0; bj < 2; ++bj) *(u32x4*)(rowp + bj * HALF) = pack8(acc[ai][bj][m][0], acc[ai][bj][m][1]); }
    }
};
struct EpiSwiglu {
    static constexpr bool PERM = true, AFTER_DRAIN = false, MIDHOOK = false;
    bf16_t* H; int ldh;
    __device__ __forceinline__ void operator()(const f32x4 (&acc)[2][2][4][2], const Unit& u, int wr, int wc, int fr, int fq) const {
        const int row0 = u.pm * BM + wr * 64 + fr, col0 = u.pn * HALF + wc * 32 + 8 * fq;
#pragma unroll
        for (int ai = 0; ai < 2; ++ai)
#pragma unroll
            for (int m = 0; m < 4; ++m) { f32x4 h[2];
#pragma unroll
                for (int n = 0; n < 2; ++n) { const f32x4 g = acc[ai][0][m][n], up = acc[ai][1][m][n];
#pragma unroll
                    for (int e = 0; e < 4; ++e) h[n][e] = g[e] * fast_sigmoid(g[e]) * up[e]; }
                __builtin_nontemporal_store(pack8(h[0], h[1]), (u32x4*)(H + (size_t)(row0 + ai * HALF + m * 16) * ldh + col0)); }
    }
};
struct EpiWin {
    static constexpr bool PERM = true, AFTER_DRAIN = false, MIDHOOK = false;
    bf16_t *Q, *K, *U, *G; const float* cosT; const float* sinT; float qscale;
    __device__ __forceinline__ void operator()(const f32x4 (&acc)[2][2][4][2], const Unit& u, int wr, int wc, int fr, int fq) const {
        const int row0 = u.pm * BM + wr * 64 + fr; const int pn = u.pn;
        if (pn < 4) {
            bf16_t* base = (pn < 2) ? Q : K; const float sc = (pn < 2) ? qscale : 1.0f; const int ct = (pn & 1) * BM + wc * 32 + 8 * fq;
#pragma unroll
            for (int ai = 0; ai < 2; ++ai)
#pragma unroll
                for (int mh = 0; mh < 2; ++mh) {
                    f32x4 cs[2][2], sn[2][2];
#pragma unroll
                    for (int mm = 0; mm < 2; ++mm) { const int pos = (row0 + ai * HALF + (mh * 2 + mm) * 16) & 2047;
#pragma unroll
                        for (int n = 0; n < 2; ++n) { cs[mm][n] = *(const f32x4*)(cosT + pos * 32 + 8 * fq + 4 * n); sn[mm][n] = *(const f32x4*)(sinT + pos * 32 + 8 * fq + 4 * n); } }
#pragma unroll
                    for (int mm = 0; mm < 2; ++mm) { const int m = mh * 2 + mm; const int row = row0 + ai * HALF + m * 16;
                        f32x4 o1[2], o2[2];
#pragma unroll
                        for (int n = 0; n < 2; ++n) { const f32x4 x1 = acc[ai][0][m][n], x2 = acc[ai][1][m][n];
                            o1[n] = (x1 * cs[mm][n] - x2 * sn[mm][n]) * sc; o2[n] = (x1 * sn[mm][n] + x2 * cs[mm][n]) * sc; }
                        bf16_t* rowp = base + (size_t)row * 512 + ct;
                        *(u32x4*)(rowp) = pack8(o1[0], o1[1]); *(u32x4*)(rowp + HALF) = pack8(o2[0], o2[1]); }
                    asm volatile("" ::: "memory"); }
        } else if (pn < 6) {
            const int col0 = (pn - 4) * BM + wc * 32 + 8 * fq;
#pragma unroll
            for (int ai = 0; ai < 2; ++ai)
#pragma unroll
                for (int m = 0; m < 4; ++m) { bf16_t* rowp = U + (size_t)(row0 + ai * HALF + m * 16) * 512 + col0;
#pragma unroll
                    for (int bj = 0; bj < 2; ++bj) *(u32x4*)(rowp + bj * HALF) = pack8(acc[ai][bj][m][0], acc[ai][bj][m][1]); }
        } else {
            const int col0 = (pn - 6) * BM + wc * 32 + 8 * fq;
#pragma unroll
            for (int ai = 0; ai < 2; ++ai)
#pragma unroll
                for (int m = 0; m < 4; ++m) { bf16_t* rowp = G + (size_t)(row0 + ai * HALF + m * 16) * 2048 + col0;
                    f32x4 rt[2], gp[2];
#pragma unroll
                    for (int n = 0; n < 2; ++n)
#pragma unroll
                        for (int e = 0; e < 4; ++e) { const float ea = 1.0f + __builtin_amdgcn_exp2f(acc[ai][0][m][n][e] * -1.4426950408889634f), ep = fminf(1.0f + __builtin_amdgcn_exp2f(acc[ai][1][m][n][e] * -1.4426950408889634f), 1e30f);
                            gp[n][e] = __builtin_amdgcn_rcpf(ep); rt[n][e] = ep * __builtin_amdgcn_rcpf(ea); }
                    *(u32x4*)(rowp) = pack8(rt[0], rt[1]); *(u32x4*)(rowp + HALF) = pack8(gp[0], gp[1]); }
        }
    }
};
struct EpiResid {
    static constexpr bool PERM = true, AFTER_DRAIN = false, MIDHOOK = false;
    const float* X; bf16_t* Y; float alpha, sc;
    __device__ __forceinline__ void operator()(const f32x4 (&acc)[2][2][4][2], const Unit& u, int wr, int wc, int fr, int fq) const {
        const int row0 = u.pm * BM + wr * 64 + fr, col0 = u.pn * BM + wc * 32 + 8 * fq;
#pragma unroll
        for (int ai = 0; ai < 2; ++ai)
#pragma unroll
            for (int mh = 0; mh < 2; ++mh) {
                f32x4 xr[2][2][2];
#pragma unroll
                for (int mm = 0; mm < 2; ++mm)
#pragma unroll
                    for (int bj = 0; bj < 2; ++bj)
#pragma unroll
                        for (int n = 0; n < 2; ++n) xr[mm][bj][n] = *(const f32x4*)(X + (size_t)(row0 + ai * HALF + (mh * 2 + mm) * 16) * 1024 + col0 + bj * HALF + 4 * n);
#pragma unroll
                for (int mm = 0; mm < 2; ++mm) { const int m = mh * 2 + mm; const size_t off = (size_t)(row0 + ai * HALF + m * 16) * 1024 + col0;
#pragma unroll
                    for (int bj = 0; bj < 2; ++bj) *(u32x4*)(Y + off + bj * HALF) = pack8(xr[mm][bj][0] * alpha + acc[ai][bj][m][0] * sc, xr[mm][bj][1] * alpha + acc[ai][bj][m][1] * sc); }
                asm volatile("" ::: "memory"); }
    }
};
struct EpiGate1 {
    static constexpr bool PERM = true, AFTER_DRAIN = false, MIDHOOK = false;
    const bf16_t* G; float* T;
    __device__ __forceinline__ void operator()(const f32x4 (&acc)[2][2][4][2], const Unit& u, int wr, int wc, int fr, int fq) const {
        const int row0 = u.pm * BM + wr * 64 + fr, col0 = u.pn * BM + wc * 32 + 8 * fq;
#pragma unroll
        for (int ai = 0; ai < 2; ++ai)
#pragma unroll
            for (int m = 0; m < 4; ++m) { const size_t row = (size_t)(row0 + ai * HALF + m * 16);
#pragma unroll
                for (int bj = 0; bj < 2; ++bj) { f32x4 ga, gb; unpack8(*(const u32x4*)(G + row * 2048 + col0 + bj * HALF), ga, gb);
                    float* tp = T + row * 1024 + col0 + bj * HALF;
                    *(f32x4*)(tp) = ga * acc[ai][bj][m][0]; *(f32x4*)(tp + 4) = gb * acc[ai][bj][m][1]; }
                asm volatile("" ::: "memory"); }
    }
};
struct EpiGate2 {
    static constexpr bool PERM = true, AFTER_DRAIN = false, MIDHOOK = false;
    const bf16_t* G; const float* T; bf16_t* Mg;
    __device__ __forceinline__ void operator()(const f32x4 (&acc)[2][2][4][2], const Unit& u, int wr, int wc, int fr, int fq) const {
        const int row0 = u.pm * BM + wr * 64 + fr, col0 = u.pn * BM + wc * 32 + 8 * fq;
#pragma unroll
        for (int ai = 0; ai < 2; ++ai)
#pragma unroll
            for (int m = 0; m < 4; ++m) { const size_t row = (size_t)(row0 + ai * HALF + m * 16);
#pragma unroll
                for (int bj = 0; bj < 2; ++bj) { f32x4 ga, gb; unpack8(*(const u32x4*)(G + row * 2048 + 1024 + col0 + bj * HALF), ga, gb);
                    const float* tp = T + row * 1024 + col0 + bj * HALF;
                    const f32x4 t0 = *(const f32x4*)(tp), t1 = *(const f32x4*)(tp + 4);
                    *(u32x4*)(Mg + row * 1024 + col0 + bj * HALF) = pack8(t0 + ga * acc[ai][bj][m][0], t1 + gb * acc[ai][bj][m][1]); }
                asm volatile("" ::: "memory"); }
    }
};
struct EpiVT {
    static constexpr bool PERM = true, AFTER_DRAIN = false, MIDHOOK = false;
    bf16_t* O;
    __device__ __forceinline__ void operator()(const f32x4 (&acc)[2][2][4][2], const Unit& u, int wr, int wc, int fr, int fq) const {
        const int row0 = u.pm * BM + wr * 64 + fr, col0 = u.pn * BM + wc * 32 + 8 * fq;
#pragma unroll
        for (int ai = 0; ai < 2; ++ai)
#pragma unroll
            for (int m = 0; m < 4; ++m) { const int vcol = row0 + ai * HALF + m * 16, h = vcol >> 7, e = vcol & 127;
#pragma unroll
                for (int bj = 0; bj < 2; ++bj) { const int tok = col0 + bj * HALF, b = tok >> 11, sq = tok & 2047, kt = sq >> 6, key = sq & 63;
                    *(u32x4*)(O + ((size_t)(((b * 4 + h) * 32 + kt) * 128 + e)) * 64 + key) = pack8(acc[ai][bj][m][0], acc[ai][bj][m][1]); } }
    }
};
struct EpiGateMid {
    static constexpr bool PERM = true, AFTER_DRAIN = false, MIDHOOK = true;
    const bf16_t* G; bf16_t* Mg;
    __device__ __forceinline__ void mid(f32x4 (&acc)[2][2][4][2], const Unit& u, int wr, int wc, int fr, int fq) const {
        int row0 = u.pm * BM + wr * 64 + fr, gc0 = u.pn * 512 + wc * 32 + 8 * fq;
        asm volatile("" : "+v"(row0), "+v"(gc0));
#pragma unroll
        for (int ai = 0; ai < 2; ++ai) {
            u32x4 rt[4][2];
#pragma unroll
            for (int m = 0; m < 4; ++m)
#pragma unroll
                for (int bj = 0; bj < 2; ++bj) rt[m][bj] = *(const u32x4*)(G + (size_t)(row0 + ai * HALF + m * 16) * 2048 + gc0 + bj * 256);
#pragma unroll
            for (int m = 0; m < 4; ++m)
#pragma unroll
                for (int bj = 0; bj < 2; ++bj) { f32x4 r0, r1; unpack8(rt[m][bj], r0, r1); acc[ai][bj][m][0] *= r0; acc[ai][bj][m][1] *= r1; }
            asm volatile("" ::: "memory"); }
    }
    __device__ __forceinline__ void operator()(const f32x4 (&acc)[2][2][4][2], const Unit& u, int wr, int wc, int fr, int fq) const {
        const int row0 = u.pm * BM + wr * 64 + fr, col0 = u.pn * BM + wc * 32 + 8 * fq, gc0 = u.pn * 512 + wc * 32 + 8 * fq + 128;
#pragma unroll
        for (int ai = 0; ai < 2; ++ai) {
            u32x4 gp[4][2];
#pragma unroll
            for (int m = 0; m < 4; ++m)
#pragma unroll
                for (int bj = 0; bj < 2; ++bj) gp[m][bj] = *(const u32x4*)(G + (size_t)(row0 + ai * HALF + m * 16) * 2048 + gc0 + bj * 256);
#pragma unroll
            for (int m = 0; m < 4; ++m) { const size_t row = (size_t)(row0 + ai * HALF + m * 16);
#pragma unroll
                for (int bj = 0; bj < 2; ++bj) { f32x4 p0, p1; unpack8(gp[m][bj], p0, p1);
                    *(u32x4*)(Mg + row * 1024 + col0 + bj * HALF) = pack8(acc[ai][bj][m][0] * p0, acc[ai][bj][m][1] * p1); } }
            asm volatile("" ::: "memory"); }
    }
};
struct EpiResidB {
    static constexpr bool PERM = true, AFTER_DRAIN = false, MIDHOOK = false;
    const bf16_t* X; bf16_t* Y; float alpha, sc;
    __device__ __forceinline__ void operator()(const f32x4 (&acc)[2][2][4][2], const Unit& u, int wr, int wc, int fr, int fq) const {
        const int row0 = u.pm * BM + wr * 64 + fr, col0 = u.pn * BM + wc * 32 + 8 * fq;
#pragma unroll
        for (int ai = 0; ai < 2; ++ai) {
            u32x4 xr[4][2];
#pragma unroll
            for (int m = 0; m < 4; ++m)
#pragma unroll
                for (int bj = 0; bj < 2; ++bj) xr[m][bj] = *(const u32x4*)(X + (size_t)(row0 + ai * HALF + m * 16) * 1024 + col0 + bj * HALF);
#pragma unroll
            for (int m = 0; m < 4; ++m) { const size_t off = (size_t)(row0 + ai * HALF + m * 16) * 1024 + col0;
#pragma unroll
                for (int bj = 0; bj < 2; ++bj) { f32x4 x0, x1; unpack8(xr[m][bj], x0, x1);
                    *(u32x4*)(Y + off + bj * HALF) = pack8(x0 * alpha + acc[ai][bj][m][0] * sc, x1 * alpha + acc[ai][bj][m][1] * sc); } }
            asm volatile("" ::: "memory"); }
    }
};
template <class Epi, class Sched, bool ALIGN_EPI = false, bool SP2 = false>
__device__ __forceinline__ void gemm_phase(PG8_LAS unsigned char* lds, const Gemm g, const Sched& S, const Epi& E) {
    int tid_ = threadIdx.x; asm volatile("" : "+v"(tid_));
    const int tid = tid_, wid = __builtin_amdgcn_readfirstlane(tid >> 6), lane = tid & 63, wr = wid >> 2, wc = wid & 3, fr = lane & 15, fq = lane >> 4;
    const int K = g.K, nt = K / BK;
    unsigned voffA[2], voffB[2];
#pragma unroll
    for (int i = 0; i < 2; ++i) { int R, C; stage_rc(tid * 16 + i * 8192, R, C); const int Rb = Epi::PERM ? ((R & ~31) + perm32(R & 31)) : R;
        voffA[i] = (unsigned)(R * K + C) * 2u; voffB[i] = (unsigned)(Rb * K + C) * 2u; }
    const size_t kstep = (size_t)(BK * 2);
    const size_t hstep = (size_t)HALF * K * 2;
    const size_t tstep = 2 * hstep;
    const unsigned ldsw = (unsigned)wid * 1024u;
    const int aoff = lds_byte(wr * 64 + fr, fq * 8), boff = lds_byte(wc * 32 + fr, fq * 8);
#define PG8_SA(b, h) (((b) * 2 + (h)) * HTB)
#define PG8_SB(b, h) ((4 + (b) * 2 + (h)) * HTB)
#define PG8_STAGE(bufoff, gbase, voff) do { _Pragma("unroll") for (int _i = 0; _i < 2; ++_i) \
        __builtin_amdgcn_global_load_lds((const unsigned*)((const char*)(gbase) + (voff)[_i]), (PG8_LAS unsigned*)(lds + (bufoff) + ldsw + _i * 8192), 16, 0, 0); } while (0)
#define PG8_LDA(dst, b, h) do { _Pragma("unroll") for (int m = 0; m < 4; ++m) _Pragma("unroll") for (int k = 0; k < 2; ++k) dst[m][k] = *(const PG8_LAS bf16x8*)(lds + PG8_SA(b, h) + aoff + m * 2048 + k * 1024); } while (0)
#define PG8_LDB(dst, b, h) do { _Pragma("unroll") for (int n = 0; n < 2; ++n) _Pragma("unroll") for (int k = 0; k < 2; ++k) dst[n][k] = *(const PG8_LAS bf16x8*)(lds + PG8_SB(b, h) + boff + n * 2048 + k * 1024); } while (0)
#define PG8_MMA(ai, bj, At, Bt) do { __builtin_amdgcn_s_setprio(1); _Pragma("unroll") for (int m = 0; m < 4; ++m) _Pragma("unroll") for (int n = 0; n < 2; ++n) _Pragma("unroll") for (int k = 0; k < 2; ++k) \
        acc[ai][bj][m][n] = __builtin_amdgcn_mfma_f32_16x16x32_bf16(Bt[n][k], At[m][k], acc[ai][bj][m][n], 0, 0, 0); __builtin_amdgcn_s_setprio(0); } while (0)
#define PG8_WAIT_V(n) asm volatile("s_waitcnt vmcnt(" #n ")" ::: "memory")
#define PG8_WAIT_L(n) asm volatile("s_waitcnt lgkmcnt(" #n ")" ::: "memory")
#define PG8_BAR __builtin_amdgcn_s_barrier()
#define PG8_SCHED __builtin_amdgcn_sched_barrier(0)
    Unit cur, nxt; int ui = 0;
    if (!S.next(0, cur)) return;
    f32x4 acc[2][2][4][2];
#pragma unroll
    for (int a = 0; a < 2; ++a)
#pragma unroll
        for (int b = 0; b < 2; ++b)
#pragma unroll
            for (int m = 0; m < 4; ++m)
#pragma unroll
                for (int n = 0; n < 2; ++n) acc[a][b][m][n] = (f32x4){0.f, 0.f, 0.f, 0.f};
    bf16x8 At[4][2], B0[2][2], B1[2][2];
    const char* cA = (const char*)g.A + (size_t)cur.pm * tstep; const char* cB = (const char*)g.Bt + (size_t)cur.pn * tstep;
    S.a_ready(cur);
    if constexpr (SP2) {
        PG8_STAGE(PG8_SB(0, 0), cB, voffB); PG8_STAGE(PG8_SB(0, 1), cB + hstep, voffB); PG8_STAGE(PG8_SA(0, 0), cA, voffA); PG8_STAGE(PG8_SA(0, 1), cA + hstep, voffA);
        if (wr == 1) PG8_BAR;
        PG8_WAIT_V(2); PG8_BAR;
        PG8_STAGE(PG8_SB(1, 0), cB + kstep, voffB); PG8_STAGE(PG8_SA(1, 0), cA + kstep, voffA); PG8_STAGE(PG8_SB(1, 1), cB + hstep + kstep, voffB);
        PG8_WAIT_V(6); PG8_BAR;
    } else {
        PG8_STAGE(PG8_SB(0, 0), cB, voffB); PG8_STAGE(PG8_SA(0, 0), cA, voffA); PG8_STAGE(PG8_SB(0, 1), cB + hstep, voffB); PG8_STAGE(PG8_SA(0, 1), cA + hstep, voffA);
        if (wr == 1) PG8_BAR;
        PG8_WAIT_V(4); PG8_BAR;
        PG8_STAGE(PG8_SB(1, 0), cB + kstep, voffB); PG8_STAGE(PG8_SA(1, 0), cA + kstep, voffA); PG8_STAGE(PG8_SB(1, 1), cB + hstep + kstep, voffB);
        PG8_WAIT_V(6); PG8_BAR;
    }
    for (;;) {
        const bool has_next = S.next(ui + 1, nxt);
        const char* nA = has_next ? (const char*)g.A + (size_t)nxt.pm * tstep : cA; const char* nB = has_next ? (const char*)g.Bt + (size_t)nxt.pn * tstep : cB;
#pragma unroll 1
        for (int t = 0; t < nt; t += 2) {
            if constexpr (Epi::MIDHOOK) { if (t == nt / 2) E.mid(acc, cur, wr, wc, fr, fq); }
            const bool last = (t == nt - 2);
            const char* a1 = cA + (size_t)(t + 1) * kstep;
            const char* a2 = last ? nA : cA + (size_t)(t + 2) * kstep; const char* b2 = last ? nB : cB + (size_t)(t + 2) * kstep;
            const char* a3 = a2 + kstep; const char* b3 = b2 + kstep;
            if (last && has_next) S.a_ready(nxt);
            if constexpr (SP2) {
            PG8_LDB(B0, 0, 0); PG8_LDB(B1, 0, 1); PG8_SCHED; PG8_LDA(At, 0, 0); PG8_STAGE(PG8_SA(1, 1), a1 + hstep, voffA);
            PG8_WAIT_V(8); PG8_WAIT_L(0); PG8_BAR; PG8_MMA(0, 0, At, B0); PG8_MMA(0, 1, At, B1); PG8_BAR; PG8_SCHED;
            PG8_LDA(At, 0, 1); PG8_STAGE(PG8_SB(0, 0), b2, voffB); PG8_STAGE(PG8_SB(0, 1), b2 + hstep, voffB); PG8_STAGE(PG8_SA(0, 0), a2, voffA);
            PG8_WAIT_V(8); PG8_WAIT_L(0); PG8_BAR; PG8_MMA(1, 0, At, B0); PG8_MMA(1, 1, At, B1); PG8_BAR; PG8_SCHED;
            PG8_LDB(B0, 1, 0); PG8_LDB(B1, 1, 1); PG8_SCHED; PG8_LDA(At, 1, 0); PG8_STAGE(PG8_SA(0, 1), a2 + hstep, voffA);
            PG8_WAIT_V(8); PG8_WAIT_L(0); PG8_BAR; PG8_MMA(0, 0, At, B0); PG8_MMA(0, 1, At, B1); PG8_BAR; PG8_SCHED;
            PG8_LDA(At, 1, 1); PG8_STAGE(PG8_SB(1, 0), b3, voffB); PG8_STAGE(PG8_SB(1, 1), b3 + hstep, voffB); PG8_STAGE(PG8_SA(1, 0), a3, voffA);
            PG8_WAIT_V(8); PG8_WAIT_L(0); PG8_BAR; PG8_MMA(1, 0, At, B0); PG8_MMA(1, 1, At, B1); PG8_BAR; PG8_SCHED;
            } else {
            PG8_LDB(B0, 0, 0); PG8_SCHED; PG8_LDA(At, 0, 0); PG8_STAGE(PG8_SA(1, 1), a1 + hstep, voffA);
            PG8_WAIT_L(8); PG8_BAR; PG8_WAIT_L(0); PG8_MMA(0, 0, At, B0); PG8_BAR; PG8_SCHED;
            PG8_LDB(B1, 0, 1); PG8_STAGE(PG8_SB(0, 0), b2, voffB);
            PG8_BAR; PG8_WAIT_L(0); PG8_MMA(0, 1, At, B1); PG8_BAR;
            PG8_LDA(At, 0, 1); PG8_STAGE(PG8_SA(0, 0), a2, voffA);
            PG8_BAR; PG8_WAIT_L(0); PG8_MMA(1, 0, At, B0); PG8_BAR; PG8_SCHED;
            PG8_STAGE(PG8_SB(0, 1), b2 + hstep, voffB);
            PG8_WAIT_V(6); PG8_BAR; PG8_MMA(1, 1, At, B1); PG8_BAR;
            PG8_LDB(B0, 1, 0); PG8_SCHED; PG8_LDA(At, 1, 0); PG8_STAGE(PG8_SA(0, 1), a2 + hstep, voffA);
            PG8_WAIT_L(8); PG8_BAR; PG8_WAIT_L(0); PG8_MMA(0, 0, At, B0); PG8_BAR; PG8_SCHED;
            PG8_LDB(B1, 1, 1); PG8_STAGE(PG8_SB(1, 0), b3, voffB);
            PG8_BAR; PG8_WAIT_L(0); PG8_MMA(0, 1, At, B1); PG8_BAR;
            PG8_LDA(At, 1, 1); PG8_STAGE(PG8_SA(1, 0), a3, voffA);
            PG8_BAR; PG8_WAIT_L(0); PG8_MMA(1, 0, At, B0); PG8_BAR; PG8_SCHED;
            PG8_STAGE(PG8_SB(1, 1), b3 + hstep, voffB);
            PG8_WAIT_V(6); PG8_BAR; PG8_MMA(1, 1, At, B1); PG8_BAR;
            }
        }
        if constexpr (ALIGN_EPI) { if (wr == 0) PG8_BAR; }
        if constexpr (!Epi::AFTER_DRAIN) { E(acc, cur, wr, wc, fr, fq); S.done(cur); }
        if (!has_next) break;
#pragma unroll
        for (int a = 0; a < 2; ++a)
#pragma unroll
            for (int b = 0; b < 2; ++b)
#pragma unroll
                for (int m = 0; m < 4; ++m)
#pragma unroll
                    for (int n = 0; n < 2; ++n) acc[a][b][m][n] = (f32x4){0.f, 0.f, 0.f, 0.f};
        cur = nxt; cA = nA; cB = nB; ++ui;
        if constexpr (ALIGN_EPI) { if (wr == 1) PG8_BAR; }
    }
    PG8_WAIT_V(0);
    if constexpr (!ALIGN_EPI) { if (wr == 0) PG8_BAR; }
    PG8_BAR;
    if constexpr (Epi::AFTER_DRAIN) { E.fused(acc, cur, wr, wc, fr, fq, lds, wid, lane); S.done(cur); }
#undef PG8_SA
#undef PG8_SB
#undef PG8_STAGE
#undef PG8_LDA
#undef PG8_LDB
#undef PG8_MMA
#undef PG8_WAIT_V
#undef PG8_WAIT_L
#undef PG8_BAR
#undef PG8_SCHED
}
}

#define LAS __attribute__((address_space(3)))
typedef unsigned short bf16;
typedef float f32x4 __attribute__((ext_vector_type(4)));
typedef float f32x16 __attribute__((ext_vector_type(16)));
typedef short bf16x8 __attribute__((ext_vector_type(8)));
typedef unsigned u32x4 __attribute__((ext_vector_type(4)));
typedef unsigned u32x2 __attribute__((ext_vector_type(2)));

constexpr int NTOK = 65536, DM = 1024, DFF = 2816, SEQ = 2048, NBATCH = 32;
constexpr int NPAN = NTOK / 256;
constexpr float LN_EPS = 1e-5f, RMS_EPS = 1e-5f;
constexpr float DN_ALPHA = 1.189207115002721f;
constexpr float LAMBDA_INIT = 0.2f;
constexpr float QSCALE = 0.125f * 1.4426950408889634f;

constexpr size_t MiB = 1u << 20;
constexpr size_t WS_WGU1 = 0, WS_WD1 = 11 * MiB, WS_WIN = 17 * MiB, WS_WBA = 25 * MiB, WS_WBP = 26 * MiB, WS_WOUT = 27 * MiB, WS_WGU2 = 29 * MiB, WS_WD2 = 40 * MiB;
constexpr size_t WS_COS = 46 * MiB, WS_SIN = 46 * MiB + 256 * 1024;
constexpr size_t WS_XB = 48 * MiB;
constexpr size_t WS_YATT = WS_XB, WS_POOL = WS_XB + 64 * MiB;
constexpr size_t WS_X1F = 176 * MiB;
constexpr size_t WS_R1 = 432 * MiB;
constexpr size_t WS_Q = WS_R1, WS_K = WS_R1 + 64 * MiB, WS_VT = WS_R1 + 128 * MiB, WS_U = WS_R1 + 192 * MiB;
constexpr size_t WS_R2 = 784 * MiB;
constexpr size_t WS_O1S = 912 * MiB;
constexpr size_t WS_BAR = 944 * MiB;
constexpr size_t WS_END = 976 * MiB;
constexpr int LDS_BYTES = 139264;

__device__ __forceinline__ unsigned f2bf(float f) { unsigned u = __builtin_bit_cast(unsigned, f); return (u + 0x7fffu + ((u >> 16) & 1u)) >> 16; }
__device__ __forceinline__ unsigned pk2(float lo, float hi) { return f2bf(lo) | (f2bf(hi) << 16); }
__device__ __forceinline__ float wave_sum(float v) {
#pragma unroll
    for (int o = 1; o < 64; o <<= 1) v += __shfl_xor(v, o);
    return v;
}
__device__ __forceinline__ float swap_max(float m) { auto rr = __builtin_amdgcn_permlane32_swap(__float_as_uint(m), __float_as_uint(m), false, false); return fmaxf(__uint_as_float(rr[0]), __uint_as_float(rr[1])); }
__device__ __forceinline__ float swap_sum(float m) { auto rr = __builtin_amdgcn_permlane32_swap(__float_as_uint(m), __float_as_uint(m), false, false); return __uint_as_float(rr[0]) + __uint_as_float(rr[1]); }

struct MapOff { int off; __device__ __forceinline__ int operator()(int n) const { return off + n; } };
struct MapGateUp { int half; __device__ __forceinline__ int operator()(int n) const { return 256 * (n >> 7) + (n & 127) + 128 * half; } };
struct MapWin { __device__ __forceinline__ int operator()(int n) const {
    if (n < 1024) { const int t = n >> 8, r = n & 255, s = r >> 6, w = r & 63, hf = w >> 5, i = w & 31; return 256 * t + 128 * hf + 32 * s + i; }
    if (n < 1536) return 3584 + (n - 1024);
    if (n < 2048) return 1024 + (n - 1536);
    { const int c = n - 2048, br = c >> 10, j = c & 1023; return 1536 + 256 * (j >> 7) + 128 * br + (j & 127); } } };
template <class MAP>
__device__ __forceinline__ void transpose_item(const float* __restrict__ W, int K, int N, bf16* __restrict__ WT, const MAP map, LAS float* scr, int item, int lane, int ldw = 0) {
    if (ldw == 0) ldw = K;
    const int nblk = N / 32, kb = item / nblk, nb = item % nblk, k0 = 64 * kb, n0 = 32 * nb;
#pragma unroll 8
    for (int i = 0; i < 32; ++i) { const int kk = 2 * i + (lane >> 5); scr[kk * 33 + (lane & 31)] = __builtin_nontemporal_load(W + (size_t)(k0 + kk) * N + n0 + (lane & 31)); }
    asm volatile("s_waitcnt lgkmcnt(0)" ::: "memory");
    const int c = lane & 7;
#pragma unroll
    for (int j = 0; j < 4; ++j) { const int n = (lane >> 3) + 8 * j; const LAS float* s = scr + (8 * c) * 33 + n;
        u32x4 o; o.x = pk2(s[0 * 33], s[1 * 33]); o.y = pk2(s[2 * 33], s[3 * 33]); o.z = pk2(s[4 * 33], s[5 * 33]); o.w = pk2(s[6 * 33], s[7 * 33]);
        *(u32x4*)(WT + (size_t)map(n0 + n) * ldw + k0 + 8 * c) = o; }
    asm volatile("s_waitcnt lgkmcnt(0)" ::: "memory");
}

#define XB_TMO      128
#define XB_XCNT(j)  (256  + 64 * (j))
#define XB_XSUB(j)  (1280 + 64 * (j))
#define XB_XGEN(j)  (2304 + 64 * (j))
#define XB_TOP      3328
#define XB_TOPGEN   3392
#define XCD_BAR_WORDS 3456
#define XB_SPIN_CAP (1u << 18)

__device__ __forceinline__ unsigned xb_ld(unsigned* p)              { return __hip_atomic_load(p, __ATOMIC_RELAXED, __HIP_MEMORY_SCOPE_AGENT); }
__device__ __forceinline__ unsigned xb_add(unsigned* p, unsigned v) { return __hip_atomic_fetch_add(p, v, __ATOMIC_RELAXED, __HIP_MEMORY_SCOPE_AGENT); }
__device__ __forceinline__ unsigned xb_xcc_id() { return (unsigned)__builtin_amdgcn_s_getreg((3 << 11) | 20) & 0xFu; }
#define XB_SPIN(cond, bar) do { unsigned _sp = 0; while (cond) { __builtin_amdgcn_s_sleep(1); \
    if ((++_sp & 255u) == 0u) { if (xb_ld(&(bar)[XB_TMO])) break; if (_sp > XB_SPIN_CAP) { atomicAdd(&(bar)[XB_TMO], 1u); break; } } } } while (0)

struct XcdBarrier {
    unsigned* bar; unsigned x;
    volatile LAS unsigned* st;
};

__device__ __forceinline__ XcdBarrier xcd_barrier_post(unsigned* bar, volatile LAS unsigned* st) {
    XcdBarrier b; b.bar = bar; b.x = xb_xcc_id(); b.st = st;
    if (threadIdx.x == 0) (void)xb_add(&bar[XB_XCNT(b.x)], 1u);
    return b;
}
__device__ __forceinline__ void xcd_barrier_complete(unsigned* bar, unsigned x, unsigned& nloc, unsigned& nx) {
    const unsigned G = gridDim.x * gridDim.y * gridDim.z;
    unsigned sum, cnt, mine, sp = 0u;
    for (;;) {
        sum = 0u; cnt = 0u; mine = 0u;
#pragma unroll
        for (unsigned j = 0; j < 16; ++j) { const unsigned c = xb_ld(&bar[XB_XCNT(j)]); sum += c; cnt += (c > 0u) ? 1u : 0u; mine = (j == x) ? c : mine; }
        if (sum == G) break;
        __builtin_amdgcn_s_sleep(1);
        if ((++sp & 255u) == 0u) { if (xb_ld(&bar[XB_TMO])) break; if (sp > XB_SPIN_CAP) { atomicAdd(&bar[XB_TMO], 1u); break; } }
    }
    nloc = mine > 0u ? mine : 1u; nx = cnt > 0u ? cnt : 1u;
}

__device__ __forceinline__ void xcd_barrier(const XcdBarrier& b) {
    asm volatile("s_waitcnt vmcnt(0)" ::: "memory");
    __syncthreads();
    if (threadIdx.x == 0) {
        unsigned* bar = b.bar;
        __builtin_amdgcn_s_waitcnt(0);
        unsigned nloc = b.st[0], nx = b.st[1];
        if (nloc == 0u) { xcd_barrier_complete(bar, b.x, nloc, nx); b.st[0] = nloc; b.st[1] = nx; }
        const unsigned old = xb_add(&bar[XB_XSUB(b.x)], 1u);
        const unsigned gen = old / nloc;
        if (old + 1u == (gen + 1u) * nloc) {
            __builtin_amdgcn_fence(__ATOMIC_RELEASE, "agent");
            asm volatile("s_waitcnt vmcnt(0)" ::: "memory");
            const unsigned og = xb_add(&bar[XB_TOP], 1u);
            const unsigned tg = og / nx;
            if (og + 1u == (tg + 1u) * nx) xb_add(&bar[XB_TOPGEN], 1u);
            else XB_SPIN(xb_ld(&bar[XB_TOPGEN]) == tg, bar);
            __builtin_amdgcn_fence(__ATOMIC_ACQUIRE, "agent");
            xb_add(&bar[XB_XGEN(b.x)], 1u);
            asm volatile("s_waitcnt vmcnt(0)" ::: "memory");
        } else {
            XB_SPIN(xb_ld(&bar[XB_XGEN(b.x)]) == gen, bar);
            __builtin_amdgcn_fence(__ATOMIC_ACQUIRE, "agent");
            asm volatile("s_waitcnt vmcnt(0)" ::: "memory");
        }
    }
    __syncthreads();
}

struct Args { const float* in[24]; float* out; unsigned char* ws; int ph_lo, ph_hi, rep_mask, pad; };

__device__ __forceinline__ void ln_panel(const bf16* Y, float* Xf, bf16* Xb, const float* g, const float* bta, int pm, int wid, int lane) {
    asm volatile("" : "+s"(g), "+s"(bta));
    f32x4 gv[4], bv[4];
#pragma unroll
    for (int j = 0; j < 2; ++j)
#pragma unroll
        for (int n = 0; n < 2; ++n) { gv[2 * j + n] = *(const f32x4*)(g + 8 * lane + 512 * j + 4 * n); bv[2 * j + n] = *(const f32x4*)(bta + 8 * lane + 512 * j + 4 * n); }
    constexpr int RB = 4;
#pragma unroll 1
    for (int r = 0; r < 32; r += RB) {
        const size_t row0 = (size_t)pm * 256 + wid * 32 + r;
        u32x4 raw[RB][2]; f32x4 v[RB][4]; float s[RB];
#pragma unroll
        for (int q = 0; q < RB; ++q)
#pragma unroll
            for (int j = 0; j < 2; ++j) raw[q][j] = __builtin_nontemporal_load((const u32x4*)(Y + (row0 + q) * 1024 + 8 * lane + 512 * j));
#pragma unroll
        for (int q = 0; q < RB; ++q) { s[q] = 0.f;
#pragma unroll
            for (int j = 0; j < 2; ++j) pg8::unpack8(raw[q][j], v[q][2 * j], v[q][2 * j + 1]);
#pragma unroll
            for (int j = 0; j < 4; ++j) s[q] += (v[q][j][0] + v[q][j][1]) + (v[q][j][2] + v[q][j][3]); }
#pragma unroll
        for (int o = 1; o < 64; o <<= 1)
#pragma unroll
            for (int q = 0; q < RB; ++q) s[q] += __shfl_xor(s[q], o);
        float s2[RB];
#pragma unroll
        for (int q = 0; q < RB; ++q) { const float mean = s[q] * (1.0f / 1024.0f); s2[q] = 0.f;
#pragma unroll
            for (int j = 0; j < 4; ++j) { v[q][j] = v[q][j] - mean; s2[q] += (v[q][j][0] * v[q][j][0] + v[q][j][1] * v[q][j][1]) + (v[q][j][2] * v[q][j][2] + v[q][j][3] * v[q][j][3]); } }
#pragma unroll
        for (int o = 1; o < 64; o <<= 1)
#pragma unroll
            for (int q = 0; q < RB; ++q) s2[q] += __shfl_xor(s2[q], o);
#pragma unroll
        for (int q = 0; q < RB; ++q) { const float rstd = 1.0f / sqrtf(s2[q] * (1.0f / 1024.0f) + LN_EPS); const size_t row = row0 + q;
#pragma unroll
            for (int j = 0; j < 2; ++j) { const f32x4 o0 = v[q][2 * j] * rstd * gv[2 * j] + bv[2 * j], o1 = v[q][2 * j + 1] * rstd * gv[2 * j + 1] + bv[2 * j + 1];
                if (Xf) { *(f32x4*)(Xf + row * 1024 + 8 * lane + 512 * j) = o0; *(f32x4*)(Xf + row * 1024 + 8 * lane + 512 * j + 4) = o1; }
                if (Xb) *(u32x4*)(Xb + row * 1024 + 8 * lane + 512 * j) = pg8::pack8(o0, o1); } }
    }
}

struct AttnState { float mrun, l; };
#define DSR128(dst, addr, off) asm volatile("ds_read_b128 %0, %1 offset:%2" : "=&v"(dst) : "v"(addr), "i"(off))
template <bool FIRST, bool HAS_PREV>
__device__ __forceinline__ void attn_step(f32x16& c0, f32x16& c1, f32x16 (&o)[4], bf16x8 (&pbp)[4], const bf16x8 (&qr)[4], AttnState& st,
                                          const LAS unsigned char* kfr, const LAS unsigned char* vfr, const int (&kofs)[4], const int (&vofs)[4]) {
    const unsigned kb_ = (unsigned)(unsigned long)kfr, vb_ = (unsigned)(unsigned long)vfr;
    unsigned ka[4], va[4];
#pragma unroll
    for (int k = 0; k < 4; ++k) { ka[k] = kb_ + (unsigned)kofs[k]; va[k] = vb_ + (unsigned)vofs[k]; }
    bf16x8 kf[4], vA[4], vB[4];
    { const float nm = FIRST ? 0.f : -st.mrun;
#pragma unroll
      for (int i = 0; i < 16; ++i) { c0[i] = nm; c1[i] = nm; } }
#pragma unroll
    for (int ks = 0; ks < 2; ++ks) { DSR128(kf[2 * ks], ka[ks], 0); DSR128(kf[2 * ks + 1], ka[ks], 4096); }
    asm volatile("s_waitcnt lgkmcnt(0)" : "+v"(kf[0]), "+v"(kf[1]), "+v"(kf[2]), "+v"(kf[3]));
#pragma unroll
    for (int ks = 0; ks < 2; ++ks) {
        c0 = __builtin_amdgcn_mfma_f32_32x32x16_bf16(kf[2 * ks], qr[ks], c0, 0, 0, 0);
        c1 = __builtin_amdgcn_mfma_f32_32x32x16_bf16(kf[2 * ks + 1], qr[ks], c1, 0, 0, 0);
    }
    __builtin_amdgcn_sched_barrier(0);
    { bf16x8 kg[4];
#pragma unroll
      for (int ks = 0; ks < 2; ++ks) { DSR128(kg[2 * ks], ka[2 + ks], 0); DSR128(kg[2 * ks + 1], ka[2 + ks], 4096); }
      asm volatile("s_waitcnt lgkmcnt(0)" : "+v"(kg[0]), "+v"(kg[1]), "+v"(kg[2]), "+v"(kg[3]));
#pragma unroll
      for (int ks = 0; ks < 2; ++ks) {
          c0 = __builtin_amdgcn_mfma_f32_32x32x16_bf16(kg[2 * ks], qr[2 + ks], c0, 0, 0, 0);
          c1 = __builtin_amdgcn_mfma_f32_32x32x16_bf16(kg[2 * ks + 1], qr[2 + ks], c1, 0, 0, 0);
      } }
    __builtin_amdgcn_sched_barrier(0);
    if (HAS_PREV) {
#pragma unroll
        for (int e = 0; e < 4; ++e) DSR128(vA[e], va[0], e * 4096);
    }
    float mx = fmaxf(c0[0], c1[0]);
#pragma unroll
    for (int i = 1; i < 16; ++i) mx = fmaxf(mx, fmaxf(c0[i], c1[i]));
    mx = swap_max(mx);
    float a = 1.0f;
    { const float dl = FIRST ? mx : ((mx > 8.0f) ? mx : 0.f);
      if (FIRST || __any(dl != 0.f)) {
#pragma unroll
          for (int i = 0; i < 16; ++i) { c0[i] -= dl; c1[i] -= dl; }
          st.mrun += dl; if (!FIRST) a = __builtin_amdgcn_exp2f(-dl);
      } }
    float ps = 0.f;
#define ATT_EXPS(E) do { _Pragma("unroll") for (int j = 0; j < 8; ++j) { const int i = (E) * 8 + j; \
        if (i < 16) { c0[i] = __builtin_amdgcn_exp2f(c0[i]); ps += c0[i]; } else { c1[i - 16] = __builtin_amdgcn_exp2f(c1[i - 16]); ps += c1[i - 16]; } } \
        asm volatile("" : "+v"(c0), "+v"(c1), "+v"(ps)); __builtin_amdgcn_sched_barrier(0); } while (0)
#define ATT_PV(KK, VF) do { _Pragma("unroll") for (int e = 0; e < 4; ++e) o[e] = __builtin_amdgcn_mfma_f32_32x32x16_bf16(VF[e], pbp[KK], o[e], 0, 0, 0); } while (0)
#define ATT_TIE(N, VF) asm volatile("s_waitcnt lgkmcnt(" #N ")" : "+v"(VF[0]), "+v"(VF[1]), "+v"(VF[2]), "+v"(VF[3]))
    if (HAS_PREV) {
        __builtin_amdgcn_sched_barrier(0);
#pragma unroll
        for (int e = 0; e < 4; ++e) DSR128(vB[e], va[1], e * 4096);
        ATT_TIE(4, vA); ATT_PV(0, vA); ATT_EXPS(0);
#pragma unroll
        for (int e = 0; e < 4; ++e) DSR128(vA[e], va[2], e * 4096);
        ATT_TIE(4, vB); ATT_PV(1, vB); ATT_EXPS(1);
#pragma unroll
        for (int e = 0; e < 4; ++e) DSR128(vB[e], va[3], e * 4096);
        ATT_TIE(4, vA); ATT_PV(2, vA); ATT_EXPS(2);
        ATT_TIE(0, vB); ATT_PV(3, vB); ATT_EXPS(3);
    } else {
#pragma unroll
        for (int i = 0; i < 16; ++i) { c0[i] = __builtin_amdgcn_exp2f(c0[i]); ps += c0[i]; c1[i] = __builtin_amdgcn_exp2f(c1[i]); ps += c1[i]; }
    }
#undef ATT_EXPS
#undef ATT_PV
#undef ATT_TIE
    st.l = st.l * a + ps;
    if (!FIRST) { if (__any(a != 1.0f)) {
#pragma unroll
        for (int e = 0; e < 4; ++e)
#pragma unroll
            for (int i = 0; i < 16; ++i) o[e][i] *= a; } }
    { u32x4 w;
      w.x = pg8::cvt_pk_bf16(c0[0], c0[1]); w.y = pg8::cvt_pk_bf16(c0[2], c0[3]); w.z = pg8::cvt_pk_bf16(c0[4], c0[5]); w.w = pg8::cvt_pk_bf16(c0[6], c0[7]); pbp[0] = __builtin_bit_cast(bf16x8, w);
      w.x = pg8::cvt_pk_bf16(c0[8], c0[9]); w.y = pg8::cvt_pk_bf16(c0[10], c0[11]); w.z = pg8::cvt_pk_bf16(c0[12], c0[13]); w.w = pg8::cvt_pk_bf16(c0[14], c0[15]); pbp[1] = __builtin_bit_cast(bf16x8, w);
      w.x = pg8::cvt_pk_bf16(c1[0], c1[1]); w.y = pg8::cvt_pk_bf16(c1[2], c1[3]); w.z = pg8::cvt_pk_bf16(c1[4], c1[5]); w.w = pg8::cvt_pk_bf16(c1[6], c1[7]); pbp[2] = __builtin_bit_cast(bf16x8, w);
      w.x = pg8::cvt_pk_bf16(c1[8], c1[9]); w.y = pg8::cvt_pk_bf16(c1[10], c1[11]); w.z = pg8::cvt_pk_bf16(c1[12], c1[13]); w.w = pg8::cvt_pk_bf16(c1[14], c1[15]); pbp[3] = __builtin_bit_cast(bf16x8, w); }
}
__device__ __forceinline__ void attn_unit(LAS unsigned char* lds, const bf16* __restrict__ Qb, const bf16* __restrict__ Kb, const bf16* __restrict__ VT, bf16* __restrict__ Y,
                                          const float* __restrict__ gsub, float lam, int b, int h, int qb, float* o1scr) {
    int tid_ = threadIdx.x; asm volatile("" : "+v"(tid_));
    const int tid = tid_, lane = tid & 63, wid = __builtin_amdgcn_readfirstlane(tid >> 6), r32 = lane & 31, hi = lane >> 5;
    const size_t tok0 = (size_t)b * SEQ;
    constexpr int KSL = 8192, VSL = 16384, VB0 = 3 * KSL;
    const int kap = 16 * ((r32 >> 4) & 1) + 8 * ((r32 >> 2) & 1) + 4 * ((r32 >> 3) & 1) + (r32 & 3);
    int kofs[4], vofs[4];
#pragma unroll
    for (int k = 0; k < 4; ++k) { kofs[k] = kap * 128 + (((2 * k + hi) ^ ((kap >> 1) & 7)) << 4); vofs[k] = r32 * 128 + (((2 * k + hi) ^ ((r32 >> 1) & 7)) << 4); }
    const int lrow = tid >> 3, lc = (tid & 7) ^ ((lrow >> 1) & 7);
    const int kcol = (lc < 4) ? 8 * lc : 128 + 8 * (lc - 4);
    const unsigned wofs = (unsigned)wid * 1024u;
    f32x16 o[4]; float inv = 0.f;
#define ATT_WAITBAR(N) do { asm volatile("s_waitcnt vmcnt(" #N ") lgkmcnt(0)" ::: "memory"); __builtin_amdgcn_s_barrier(); asm volatile("" ::: "memory"); } while (0)
#define ATT_DMA(src, ldsoff) __builtin_amdgcn_global_load_lds((const unsigned*)(src), (LAS unsigned*)(lds + (ldsoff) + wofs), 16, 0, 0)
#pragma unroll 1
    for (int mp = 0; mp < 2; ++mp) {
        const int c1 = 256 * (h >> 1) + 32 * (2 * (h & 1) + mp);
        const bf16* qp = Qb + (tok0 + (size_t)qb * 256 + wid * 32 + r32) * 512 + c1 + 8 * hi;
        bf16x8 qr[4];
        qr[0] = *(const bf16x8*)(qp); qr[1] = *(const bf16x8*)(qp + 16); qr[2] = *(const bf16x8*)(qp + 128); qr[3] = *(const bf16x8*)(qp + 144);
        const bf16* kp = Kb + (tok0 + lrow) * 512 + c1 + kcol;
        const bf16* vp = VT + ((size_t)((b * 4 + h) * 32) * 128 + lrow) * 64 + lc * 8;
        ATT_DMA(kp, 0); ATT_DMA(vp, VB0); ATT_DMA(vp + 4096, VB0 + 8192); ATT_DMA(kp + (size_t)64 * 512, KSL);
        ATT_WAITBAR(0);
#pragma unroll
        for (int e = 0; e < 4; ++e)
#pragma unroll
            for (int i = 0; i < 16; ++i) o[e][i] = 0.f;
        AttnState st; st.mrun = 0.f; st.l = 0.f;
        bf16x8 pbp[4];
        f32x16 sA, sB;
        int s0 = 0, s1 = 1, s2 = 2;
#define ATT_STEP(T, FIRST, HASP) do { const int t_ = (T); \
        if (t_ + 2 < 32) ATT_DMA(kp + (size_t)(t_ + 2) * 64 * 512, s2 * KSL); \
        if (t_ + 1 < 32) { ATT_DMA(vp + (size_t)(t_ + 1) * 8192, VB0 + s1 * VSL); ATT_DMA(vp + (size_t)(t_ + 1) * 8192 + 4096, VB0 + s1 * VSL + 8192); } \
        attn_step<FIRST, HASP>(sA, sB, o, pbp, qr, st, lds + s0 * KSL, lds + VB0 + s2 * VSL, kofs, vofs); \
        if (t_ + 2 < 32) ATT_WAITBAR(3); else ATT_WAITBAR(0); \
        { const int tmp_ = s0; s0 = s1; s1 = s2; s2 = tmp_; } } while (0)
        ATT_STEP(0, true, false);
#pragma unroll 1
        for (int t = 1; t < 32; ++t) ATT_STEP(t, false, true);
#undef ATT_STEP
        { const LAS unsigned char* vb = lds + VB0 + 1 * VSL;
#pragma unroll
          for (int e = 0; e < 4; ++e)
#pragma unroll
              for (int kk = 0; kk < 4; ++kk) { const bf16x8 vf = *(const LAS bf16x8*)(vb + e * 4096 + vofs[kk]);
                  o[e] = __builtin_amdgcn_mfma_f32_32x32x16_bf16(vf, pbp[kk], o[e], 0, 0, 0); } }
        ATT_WAITBAR(0);
        inv = 1.0f / swap_sum(st.l);
        if (mp == 0) {
#pragma unroll
            for (int e = 0; e < 4; ++e)
#pragma unroll
                for (int a = 0; a < 4; ++a) { f32x4 v = {o[e][4 * a] * inv, o[e][4 * a + 1] * inv, o[e][4 * a + 2] * inv, o[e][4 * a + 3] * inv};
                    *(f32x4*)(o1scr + ((size_t)(e * 4 + a) * 512 + tid) * 4) = v; }
        }
    }
#undef ATT_WAITBAR
#undef ATT_DMA
    {
        const float li = lam * inv; float ss = 0.f;
#pragma unroll
        for (int e = 0; e < 4; ++e)
#pragma unroll
            for (int a = 0; a < 4; ++a) { const f32x4 v1 = *(const f32x4*)(o1scr + ((size_t)(e * 4 + a) * 512 + tid) * 4);
#pragma unroll
                for (int k = 0; k < 4; ++k) { const float v = v1[k] - li * o[e][4 * a + k]; o[e][4 * a + k] = v; ss += v * v; } }
        ss = swap_sum(ss);
        const float rs = (1.0f - LAMBDA_INIT) / sqrtf(ss * (1.0f / 128.0f) + RMS_EPS);
        bf16* yp = Y + (tok0 + (size_t)qb * 256 + wid * 32 + r32) * 1024 + h * 128 + 4 * hi;
#pragma unroll
        for (int e = 0; e < 4; ++e)
#pragma unroll
            for (int a = 0; a < 4; ++a) { const f32x4 gg = *(const f32x4*)(gsub + 32 * e + 8 * a + 4 * hi);
                u32x2 w; w.x = pk2(o[e][4 * a] * rs * gg[0], o[e][4 * a + 1] * rs * gg[1]); w.y = pk2(o[e][4 * a + 2] * rs * gg[2], o[e][4 * a + 3] * rs * gg[3]);
                *(u32x2*)(yp + 32 * e + 8 * a) = w; }
    }
}

constexpr int NPHASE = 12;
__global__ void __launch_bounds__(512, 2) fwd_mega(Args a) {
    extern __shared__ __attribute__((aligned(16))) unsigned char lds_raw[];
    LAS unsigned char* lds = (LAS unsigned char*)lds_raw;
    cg::grid_group grid = cg::this_grid();
    const int tid = threadIdx.x, lane = tid & 63, wid = __builtin_amdgcn_readfirstlane(tid >> 6);
    const int G = gridDim.x, bx = blockIdx.x;
    const int lo = a.ph_lo, hi = a.ph_hi;
    const bool fused = (hi - lo) > 1;
    volatile LAS unsigned* MISC = (volatile LAS unsigned*)(lds + 131072 + 512);
    if (tid < 4) MISC[tid] = 0u;
    __syncthreads();
    XcdBarrier xbar; xbar.bar = (unsigned*)(a.ws + WS_BAR); xbar.x = 0; xbar.st = MISC;
    if (fused) xbar = xcd_barrier_post((unsigned*)(a.ws + WS_BAR), MISC);
    if (a.ph_lo < 0) grid.sync();
    unsigned char* ws = a.ws;
    const float* x = a.in[0];
    bf16* Wgu1 = (bf16*)(ws + WS_WGU1); bf16* Wd1 = (bf16*)(ws + WS_WD1); bf16* Win = (bf16*)(ws + WS_WIN); bf16* Wba = (bf16*)(ws + WS_WBA); bf16* Wbp = (bf16*)(ws + WS_WBP);
    bf16* Wout = (bf16*)(ws + WS_WOUT); bf16* Wgu2 = (bf16*)(ws + WS_WGU2); bf16* Wd2 = (bf16*)(ws + WS_WD2);
    float* cosT = (float*)(ws + WS_COS); float* sinT = (float*)(ws + WS_SIN);
    bf16* XB = (bf16*)(ws + WS_XB); bf16* YATT = (bf16*)(ws + WS_YATT); bf16* POOL = (bf16*)(ws + WS_POOL);
    bf16* Y1 = (bf16*)(ws + WS_X1F);
    bf16* X1B = (bf16*)a.out;
    bf16* HB = (bf16*)(ws + WS_R1); bf16* QB = (bf16*)(ws + WS_Q); bf16* KB = (bf16*)(ws + WS_K); bf16* VTB = (bf16*)(ws + WS_VT); bf16* UB = (bf16*)(ws + WS_U);
    bf16* TB = (bf16*)(ws + WS_R1);
    bf16* MG = (bf16*)(ws + WS_R2);
    float* O1S = (float*)(ws + WS_O1S) + (size_t)bx * (512 * 64);
    bf16* GATE = (bf16*)(ws + WS_X1F);
    float* OUT = a.out;
#ifndef PHM
#define PHM 4095
#endif
#define IN_PH(k) ((((PHM) >> (k)) & 1) && lo <= (k) && (k) < hi)
#define REPS(k) (IN_PH(k) ? 1 + ((a.rep_mask >> (k)) & 1) : 0)
#define SEAM(k) do { if (lo <= (k) && (k) + 1 < hi) { xcd_barrier(xbar); } } while (0)
#define WG_HANDOFF() do { asm volatile("s_waitcnt vmcnt(0) lgkmcnt(0)" ::: "memory"); __syncthreads(); __builtin_amdgcn_fence(__ATOMIC_ACQUIRE, "agent"); asm volatile("s_waitcnt vmcnt(0)" ::: "memory"); } while (0)

    if (IN_PH(0)) {
        LAS float* scr = (LAS float*)(lds + wid * 16384);
        const int gw = bx * 8 + wid, NGW = G * 8;
        constexpr int I_GU = (DM / 64) * (DFF / 32), I_DN = (DFF / 64) * (DM / 32), I_IN = (DM / 64) * (4096 / 32), I_BA = (512 / 64) * (DM / 32), I_OUT = (DM / 64) * (DM / 32);
        constexpr int NITEMS = 4 * I_GU + 2 * I_DN + I_IN + I_BA + I_OUT;
        for (int it = gw; it < NITEMS; it += NGW) {
            int r = it;
            if (r < I_GU) { transpose_item(a.in[3], DM, DFF, Wgu1, MapGateUp{0}, scr, r, lane); continue; } r -= I_GU;
            if (r < I_GU) { transpose_item(a.in[4], DM, DFF, Wgu1, MapGateUp{1}, scr, r, lane); continue; } r -= I_GU;
            if (r < I_GU) { transpose_item(a.in[19], DM, DFF, Wgu2, MapGateUp{0}, scr, r, lane); continue; } r -= I_GU;
            if (r < I_GU) { transpose_item(a.in[20], DM, DFF, Wgu2, MapGateUp{1}, scr, r, lane); continue; } r -= I_GU;
            if (r < I_DN) { transpose_item(a.in[5], DFF, DM, Wd1, MapOff{0}, scr, r, lane); continue; } r -= I_DN;
            if (r < I_DN) { transpose_item(a.in[21], DFF, DM, Wd2, MapOff{0}, scr, r, lane); continue; } r -= I_DN;
            if (r < I_IN) { transpose_item(a.in[6], DM, 4096, Win, MapWin{}, scr, r, lane); continue; } r -= I_IN;
            if (r < I_BA) { transpose_item(a.in[14], 512, DM, Wba, MapOff{0}, scr, r, lane, 1024); continue; } r -= I_BA;
            transpose_item(a.in[16], DM, DM, Wout, MapOff{0}, scr, r, lane);
        }
        const size_t gt = (size_t)bx * 512 + tid, NT = (size_t)G * 512;
        { const float* pw = a.in[12]; const float* psc = a.in[13]; const float* wbp = a.in[15];
          for (int w = gw; w < 1024 * 8; w += NGW) { const int n = w & 1023, gc = (w >> 10) * 64 + lane, g = gc >> 7;
              float acc = 0.f;
              for (int d = 0; d < 128; ++d) acc += pw[(size_t)gc * 128 + d] * psc[g * 128 + d] * wbp[(size_t)(g * 128 + d) * 1024 + n];
              Wba[(size_t)n * 1024 + 512 + gc] = (bf16)f2bf(acc); } }
        for (size_t idx = gt; idx < (size_t)SEQ * 32; idx += NT) { const int i = (int)(idx & 31), pos = (int)(idx >> 5);
            const float inv = 1.0f / powf(10000.0f, (float)(2 * i) / 64.0f); const float ang = (float)pos * inv;
            cosT[idx] = cosf(ang); sinT[idx] = sinf(ang); }
#pragma unroll 4
        for (size_t idx = gt; idx < (size_t)NTOK * DM / 8; idx += NT) { const f32x4 v0 = __builtin_nontemporal_load((const f32x4*)(x + idx * 8)), v1 = __builtin_nontemporal_load((const f32x4*)(x + idx * 8 + 4));
            u32x4 w; w.x = pk2(v0[0], v0[1]); w.y = pk2(v0[2], v0[3]); w.z = pk2(v1[0], v1[1]); w.w = pk2(v1[2], v1[3]); *(u32x4*)(XB + idx * 8) = w; }
        __syncthreads();
    }
    SEAM(0);
    if (IN_PH(1)) {
        pg8::Gemm g{XB, Wgu1, NTOK, 2 * DFF, DM}; pg8::StaticOrder S; S.init(NTOK, 2 * DFF, G, bx);
        pg8::EpiSwiglu E{HB, DFF};
        pg8::gemm_phase<pg8::EpiSwiglu, pg8::StaticOrder, true, true>(lds, g, S, E);
    }
    SEAM(1);
    if (IN_PH(2)) {
        pg8::Gemm g{HB, Wd1, NTOK, DM, DFF}; pg8::StaticOrder S; S.init(NTOK, DM, G, bx);
        pg8::EpiResid E{x, Y1, DN_ALPHA, 0.5f};
        pg8::gemm_phase<pg8::EpiResid, pg8::StaticOrder, true, true>(lds, g, S, E);
    }
    SEAM(2);
    if (IN_PH(3)) {
        for (int pm = bx; pm < NPAN; pm += G) ln_panel(Y1, nullptr, X1B, a.in[1], a.in[2], pm, wid, lane);
        __syncthreads();
    }
    SEAM(3);
    if (IN_PH(4)) {
        { pg8::Gemm g{X1B, Win, NTOK, 3584, DM}; pg8::StaticOrder S; S.init(NTOK, 3584, G, bx);
          pg8::EpiWin E{QB, KB, UB, GATE, cosT, sinT, QSCALE};
          pg8::gemm_phase<pg8::EpiWin, pg8::StaticOrder, true, true>(lds, g, S, E); }
        { pg8::Gemm g{Win + (size_t)3584 * DM, X1B, 512, NTOK, DM}; pg8::StaticOrder S; S.init(512, NTOK, G, bx);
          pg8::EpiVT E{VTB};
          pg8::gemm_phase<pg8::EpiVT, pg8::StaticOrder, true, true>(lds, g, S, E); }
    }
    SEAM(4);
    if (IN_PH(5)) {
        for (int item = bx * 512 + tid; item < NBATCH * 64 * 64; item += G * 512) {
            const int c8 = item & 63, seg = (item >> 6) & 63, bb = item >> 12;
            const int ch = c8 * 8, hw = 1 << (ch >> 7);
            const bf16* base = UB + (size_t)bb * SEQ * 512 + ch;
            bf16* obase = XB + (size_t)bb * SEQ * 1024 + 512 + ch;
            const int s0 = seg * 32;
            f32x4 w0 = {0.f, 0.f, 0.f, 0.f}, w1 = {0.f, 0.f, 0.f, 0.f};
            { const int jlo = (s0 - hw) > 0 ? (s0 - hw) : 0, jhi = (s0 + hw) < SEQ ? (s0 + hw) : SEQ;
              for (int j = jlo; j < jhi; ++j) { f32x4 a0, a1; pg8::unpack8(*(const u32x4*)(base + (size_t)j * 512), a0, a1); w0 += a0; w1 += a1; } }
#pragma unroll 4
            for (int s = s0; s < s0 + 32; ++s) {
                f32x4 u0, u1; pg8::unpack8(*(const u32x4*)(base + (size_t)s * 512), u0, u1);
                const int jlo = (s - hw) > 0 ? (s - hw) : 0, jhi = (s + hw) < SEQ ? (s + hw) : SEQ;
                const float rc = 1.0f / (float)(jhi - jlo);
                *(u32x4*)(obase + (size_t)s * 1024) = pg8::pack8(w0 * rc - u0, w1 * rc - u1);
                if (s + hw < SEQ) { f32x4 a0, a1; pg8::unpack8(*(const u32x4*)(base + (size_t)(s + hw) * 512), a0, a1); w0 += a0; w1 += a1; }
                if (s - hw >= 0) { f32x4 a0, a1; pg8::unpack8(*(const u32x4*)(base + (size_t)(s - hw) * 512), a0, a1); w0 -= a0; w1 -= a1; }
            }
        }
        float lam;
        { const float p1 = a.in[7][lane] * a.in[8][lane], p2 = a.in[9][lane] * a.in[10][lane];
          lam = expf(wave_sum(p1)) - expf(wave_sum(p2)) + LAMBDA_INIT; }
        if (G == 256) {
            const int xc = bx & 7, j = bx >> 3;
            for (int i = 0; i < 4; ++i) { const int bh = i * 32 + xc * 4 + (j >> 3), qb = j & 7;
                attn_unit(lds, QB, KB, VTB, YATT, a.in[11], lam, bh >> 2, bh & 3, qb, O1S); }
        } else {
            for (int u = bx; u < 1024; u += G) attn_unit(lds, QB, KB, VTB, YATT, a.in[11], lam, (u >> 3) >> 2, (u >> 3) & 3, u & 7, O1S);
        }
    }
    SEAM(5);
    if (IN_PH(6)) {
        pg8::Gemm g{XB, Wba, NTOK, DM, DM}; pg8::StaticOrder S; S.init(NTOK, DM, G, bx);
        pg8::EpiGateMid E{GATE, MG};
        pg8::gemm_phase<pg8::EpiGateMid, pg8::StaticOrder, true, true>(lds, g, S, E);
    }
    SEAM(6);
    if (IN_PH(7)) {
        pg8::Gemm g{MG, Wout, NTOK, DM, DM}; pg8::StaticOrder S; S.init(NTOK, DM, G, bx);
        pg8::EpiResidB E{X1B, TB, DN_ALPHA, 1.0f};
        pg8::gemm_phase<pg8::EpiResidB, pg8::StaticOrder, true, true>(lds, g, S, E);
    }
    SEAM(7);
    if (IN_PH(8)) {
        for (int pm = bx; pm < NPAN; pm += G) ln_panel(TB, nullptr, MG, a.in[17], a.in[18], pm, wid, lane);
        __syncthreads();
    }
    SEAM(8);
    if (IN_PH(9)) {
        pg8::Gemm g{MG, Wgu2, NTOK, 2 * DFF, DM}; pg8::StaticOrder S; S.init(NTOK, 2 * DFF, G, bx);
        pg8::EpiSwiglu E{HB, DFF};
        pg8::gemm_phase<pg8::EpiSwiglu, pg8::StaticOrder, true, true>(lds, g, S, E);
    }
    SEAM(9);
    if (IN_PH(10)) {
        pg8::Gemm g{HB, Wd2, NTOK, DM, DFF}; pg8::StaticOrder S; S.init(NTOK, DM, G, bx);
        pg8::EpiResidB E{MG, Y1, DN_ALPHA, 0.5f};
        pg8::gemm_phase<pg8::EpiResidB, pg8::StaticOrder, true, true>(lds, g, S, E);
    }
    SEAM(10);
    if (IN_PH(11)) {
        for (int pm = bx; pm < NPAN; pm += G) ln_panel(Y1, OUT, nullptr, a.in[22], a.in[23], pm, wid, lane);
    }
}

#ifndef REP_MASK
#define REP_MASK 0
#endif
#ifndef MK_N_LAUNCHES
#define MK_N_LAUNCHES 1
#endif
extern "C" void kernel_launch(void* const* d_in, const int* in_sizes, int n_in, void* d_out, int out_size, void* d_ws, size_t ws_size, hipStream_t stream) {
    static int grid = 0;
    if (grid == 0) {
        if (n_in != 24 || in_sizes[0] != NTOK * DM || out_size != NTOK * DM || ws_size < WS_END) { fprintf(stderr, "kernel_launch: unexpected shapes (n_in %d, ws %zu)\n", n_in, ws_size); grid = -1; return; }
        int dev = 0, cus = 0, per_cu = 0;
        hipGetDevice(&dev); hipDeviceGetAttribute(&cus, hipDeviceAttributeMultiprocessorCount, dev);
        if (hipFuncSetAttribute((const void*)fwd_mega, hipFuncAttributeMaxDynamicSharedMemorySize, LDS_BYTES) != hipSuccess) { fprintf(stderr, "kernel_launch: hipFuncSetAttribute failed\n"); grid = -1; return; }
        if (hipOccupancyMaxActiveBlocksPerMultiprocessor(&per_cu, (const void*)fwd_mega, 512, LDS_BYTES) != hipSuccess || per_cu < 1) { fprintf(stderr, "kernel_launch: occupancy query says %d\n", per_cu); per_cu = 1; }
        (void)hipGetLastError();
        grid = cus * per_cu;
    }
    if (grid < 0) return;
    Args a{};
    for (int i = 0; i < 24; ++i) a.in[i] = (const float*)d_in[i];
    a.out = (float*)d_out; a.ws = (unsigned char*)d_ws;
    (void)hipMemsetAsync((unsigned char*)d_ws + WS_BAR, 0, 16384, stream);
#if MK_N_LAUNCHES == 1
    a.ph_lo = 0; a.ph_hi = NPHASE; a.rep_mask = REP_MASK;
    void* args[] = {&a};
    hipError_t e = hipLaunchCooperativeKernel((const void*)fwd_mega, dim3(grid), dim3(512), args, LDS_BYTES, stream);
    if (e != hipSuccess) fprintf(stderr, "cooperative launch failed: %s (grid %d)\n", hipGetErrorString(e), grid);
#else
    for (int p = 0; p < NPHASE; ++p) { a.ph_lo = p; a.ph_hi = p + 1; hipLaunchKernelGGL(fwd_mega, dim3(grid), dim3(512), LDS_BYTES, stream, a); }
#endif
}
```
